# Optimizing an MI355X kernel written in HIP

```python
import jax, jax.numpy as jnp
from jax import lax
import numpy as np

D_MODEL = 2048
BATCH = 1
SEQ = 8192
DEPTH = 1

N_HEADS_ATTN = 8
HEAD_DIM = 128
N_IDX_HEADS = 16
IDX_DIM = 64
TOPK_MAX = 256
Q_BLOCK = 128
N_RET_HEADS = 8
RET_QK_DIM = 128
RET_V_DIM = 256
RET_CHUNK = 128
N_MEM = 256
N_MEM_HEADS = 4
MEM_HEAD_DIM = 256
D_FF = -(-8 * D_MODEL // (3 * 256)) * 256
ROPE_THETA = 10000.0
EPS = 1e-6
N_BRANCHES = 3

A_WIDTH = N_HEADS_ATTN * HEAD_DIM
IDX_Q_WIDTH = N_IDX_HEADS * IDX_DIM
RET_QK_WIDTH = N_RET_HEADS * RET_QK_DIM
RET_V_WIDTH = N_RET_HEADS * RET_V_DIM
MEM_WIDTH = N_MEM_HEADS * MEM_HEAD_DIM
COL_SIZES = (A_WIDTH, A_WIDTH, A_WIDTH, IDX_Q_WIDTH, IDX_DIM, N_IDX_HEADS,
             RET_QK_WIDTH, RET_QK_WIDTH, RET_V_WIDTH, RET_V_WIDTH, MEM_WIDTH, N_BRANCHES * D_MODEL)
COL_SPLITS = tuple(sum(COL_SIZES[:i + 1]) for i in range(len(COL_SIZES) - 1))
IN_COLS = sum(COL_SIZES)

kernel_name = "hybrid_dsa_retention_memory_gated_block"


def rms_norm(x, g):
    xf = x.astype(jnp.float32)
    y = xf * lax.rsqrt(jnp.mean(xf * xf, axis=-1, keepdims=True) + EPS)
    return (y * g.astype(jnp.float32)).astype(x.dtype)


def rope(x, pos):
    d = x.shape[-1]
    freqs = ROPE_THETA ** (-jnp.arange(0, d, 2, dtype=jnp.float32) / d)
    ang = pos.astype(jnp.float32)[..., None] * freqs
    cos = jnp.cos(ang)[:, :, None, :]
    sin = jnp.sin(ang)[:, :, None, :]
    xf = x.astype(jnp.float32)
    x1, x2 = xf[..., : d // 2], xf[..., d // 2:]
    return jnp.concatenate([x1 * cos - x2 * sin, x2 * cos + x1 * sin], axis=-1).astype(x.dtype)


def dsa_attention(q, k, v, q_idx, k_idx, w_idx):
    B, S, H, dh = q.shape
    k_top = min(TOPK_MAX, S // 4)
    nb = S // Q_BLOCK

    def to_blocks(a):
        return jnp.moveaxis(a.reshape(B, nb, Q_BLOCK, *a.shape[2:]), 1, 0)

    t_blk = jnp.arange(S, dtype=jnp.int32).reshape(nb, Q_BLOCK)
    key_pos = jnp.arange(S, dtype=jnp.int32)
    gather = jax.vmap(lambda a, i: a[i])

    def block(args):
        qb, qib, wb, tb = args
        rel = jax.nn.relu(jnp.einsum('bqhd,bsd->bqhs', qib, k_idx))
        score = jnp.einsum('bqhs,bqh->bqs', rel, wb).astype(jnp.float32)
        causal = key_pos[None, None, :] <= tb[None, :, None]
        score = jnp.where(causal, score, -jnp.inf)
        _, idx = lax.top_k(score, k_top)
        valid = idx <= tb[None, :, None]
        ks = gather(k, idx)
        vs = gather(v, idx)
        logits = jnp.einsum('bqhd,bqkhd->bqhk', qb, ks).astype(jnp.float32)
        logits = jnp.where(valid[:, :, None, :], logits, -jnp.inf)
        p = jax.nn.softmax(logits, axis=-1).astype(v.dtype)
        return jnp.einsum('bqhk,bqkhd->bqhd', p, vs)

    out = lax.map(block, (to_blocks(q), to_blocks(q_idx), to_blocks(w_idx), t_blk))
    return jnp.moveaxis(out, 0, 1).reshape(B, S, H * dh)


def retention(q, k, v, g):
    B, S, H, dk = q.shape
    dv = v.shape[-1]
    C = RET_CHUNK
    n = S // C
    dt = v.dtype
    log_gamma = jnp.log1p(-jnp.exp2(-5.0 - jnp.arange(H, dtype=jnp.float32)))
    i = jnp.arange(C, dtype=jnp.float32)
    diff = i[:, None] - i[None, :]
    inner_decay = jnp.where(diff[None] >= 0,
                            jnp.exp(jnp.maximum(diff, 0.0)[None] * log_gamma[:, None, None]), 0.0)
    k_decay = jnp.exp((C - 1 - i)[None, :] * log_gamma[:, None])
    q_decay = jnp.exp((i + 1)[None, :] * log_gamma[:, None])
    chunk_decay = jnp.exp(C * log_gamma)

    qc = q.reshape(B, n, C, H, dk)
    kc = (k * dk ** -0.5).reshape(B, n, C, H, dk)
    vc = v.reshape(B, n, C, H, dv)

    scores = jnp.einsum('bnihd,bnjhd->bnhij', qc, kc) * inner_decay.astype(dt)
    inner = jnp.einsum('bnhij,bnjhe->bnihe', scores, vc)
    kv = jnp.einsum('bnjhd,bnjhe,hj->nbhde', kc, vc, k_decay.astype(dt)).astype(jnp.float32)

    def step(state, kv_n):
        return state * chunk_decay[None, :, None, None] + kv_n, state

    _, prev = lax.scan(step, jnp.zeros((B, H, dk, dv), jnp.float32), kv)
    cross = jnp.einsum('bnihd,nbhde->bnihe', qc, prev.astype(dt)) * \
        jnp.transpose(q_decay)[None, None, :, :, None].astype(dt)
    y = (inner + cross).reshape(B, S, H, dv).astype(jnp.float32)
    mu = jnp.mean(y, axis=-1, keepdims=True)
    var = jnp.mean(jnp.square(y - mu), axis=-1, keepdims=True)
    yn = ((y - mu) * lax.rsqrt(var + EPS)).astype(dt).reshape(B, S, H * dv)
    return jax.nn.silu(g) * yn


def memory_attention(q, k, v):
    B, S, H, d = q.shape
    logits = jnp.einsum('bshd,bmhd->bhsm', q, k).astype(jnp.float32)
    p = jax.nn.softmax(logits, axis=-1).astype(v.dtype)
    return jnp.einsum('bhsm,bmhd->bshd', p, v).reshape(B, S, H * d)


def setup_inputs(seed: int = 0) -> dict:
    key = jax.random.key(seed)
    ks = jax.random.split(key, 16)

    def w(k, fan_in, fan_out):
        return jax.random.normal(k, (DEPTH, fan_in, fan_out), jnp.float32) * fan_in ** -0.5

    def gain(k):
        return 1.0 + 0.05 * jax.random.normal(k, (DEPTH, D_MODEL), jnp.float32)

    return {
        "x": jax.random.normal(ks[0], (BATCH, SEQ, D_MODEL), jnp.float32),
        "mem": jax.random.normal(ks[1], (BATCH, N_MEM, D_MODEL), jnp.float32),
        "positions": jnp.broadcast_to(jnp.arange(SEQ, dtype=jnp.int32), (BATCH, SEQ)),
        "g_pre_mix": gain(ks[2]),
        "g_mem": gain(ks[3]),
        "w_in": w(ks[4], D_MODEL, IN_COLS),
        "w_mem_kv": w(ks[5], D_MODEL, 2 * MEM_WIDTH),
        "w_branch_a": w(ks[6], A_WIDTH, D_MODEL),
        "w_branch_b": w(ks[7], RET_V_WIDTH, D_MODEL),
        "w_branch_c": w(ks[8], MEM_WIDTH, D_MODEL),
        "w_out": w(ks[9], D_MODEL, D_MODEL),
        "g_post_mix": gain(ks[10]),
        "g_pre_ffn": gain(ks[11]),
        "w_ffn_in": w(ks[12], D_MODEL, 2 * D_FF),
        "w_ffn_out": w(ks[13], D_FF, D_MODEL),
        "g_post_ffn": gain(ks[14]),
    }


def reference(x, mem, positions, g_pre_mix, g_mem, w_in, w_mem_kv, w_branch_a, w_branch_b,
              w_branch_c, w_out, g_post_mix, g_pre_ffn, w_ffn_in, w_ffn_out, g_post_ffn):
    B, S, D = x.shape
    M = mem.shape[1]
    for l in range(DEPTH):
        h = rms_norm(x, g_pre_mix[l])
        proj = h @ w_in[l]
        (a_q, a_k, a_v, i_q, i_k, i_w, r_q, r_k, r_v, r_g, m_q, gate_logits) = \
            jnp.split(proj, COL_SPLITS, axis=-1)

        a_q = rope(a_q.reshape(B, S, N_HEADS_ATTN, HEAD_DIM), positions) * HEAD_DIM ** -0.5
        a_k = rope(a_k.reshape(B, S, N_HEADS_ATTN, HEAD_DIM), positions)
        a_v = a_v.reshape(B, S, N_HEADS_ATTN, HEAD_DIM)
        i_q = rope(i_q.reshape(B, S, N_IDX_HEADS, IDX_DIM), positions) * IDX_DIM ** -0.5
        i_k = rope(i_k.reshape(B, S, 1, IDX_DIM), positions)[:, :, 0, :]
        i_w = i_w * N_IDX_HEADS ** -0.5
        o_a = dsa_attention(a_q, a_k, a_v, i_q, i_k, i_w)

        r_q = rope(r_q.reshape(B, S, N_RET_HEADS, RET_QK_DIM), positions)
        r_k = rope(r_k.reshape(B, S, N_RET_HEADS, RET_QK_DIM), positions)
        r_v = r_v.reshape(B, S, N_RET_HEADS, RET_V_DIM)
        o_b = retention(r_q, r_k, r_v, r_g)

        mem_kv = rms_norm(mem, g_mem[l]) @ w_mem_kv[l]
        m_k, m_v = jnp.split(mem_kv, 2, axis=-1)
        m_k = m_k.reshape(B, M, N_MEM_HEADS, MEM_HEAD_DIM)
        m_v = m_v.reshape(B, M, N_MEM_HEADS, MEM_HEAD_DIM)
        m_q = m_q.reshape(B, S, N_MEM_HEADS, MEM_HEAD_DIM) * MEM_HEAD_DIM ** -0.5
        o_c = memory_attention(m_q, m_k, m_v)

        gates = jax.nn.sigmoid(gate_logits).reshape(B, S, N_BRANCHES, D)
        mixed = (gates[:, :, 0] * (o_a @ w_branch_a[l])
                 + gates[:, :, 1] * (o_b @ w_branch_b[l])
                 + gates[:, :, 2] * (o_c @ w_branch_c[l]))
        x = x + rms_norm(mixed @ w_out[l], g_post_mix[l])

        h2 = rms_norm(x, g_pre_ffn[l])
        f_gate, f_up = jnp.split(h2 @ w_ffn_in[l], 2, axis=-1)
        y2 = (jax.nn.silu(f_gate) * f_up) @ w_ffn_out[l]
        x = x + rms_norm(y2, g_post_ffn[l])
    return x
```

```cpp
#include <hip/hip_runtime.h>
#include <stdint.h>

typedef unsigned short bf16_t;
typedef _Float16 f16_t;

constexpr int S = 8192, D = 2048, NMEM = 256;
constexpr int AW = 1024, IQW = 1024, IDXD = 64, NIH = 16, RQK = 1024, RVW = 2048, MW = 1024;
constexpr int INC = 17488, DFF = 5632;
constexpr int C_AQ = 0, C_AK = 1024, C_AV = 2048, C_IQ = 3072, C_IK = 4096, C_IW = 4160, C_RQ = 4176, C_RK = 5200, C_RV = 6224, C_RG = 8272, C_MQ = 10320, C_GT = 11344;
static_assert(C_GT + 3 * D == INC, "cols");
constexpr float EPS = 1e-6f;

constexpr size_t MiB = 1u << 20;
constexpr size_t WS_XN = 0, WS_MEMN = 32 * MiB, WS_ROPE128 = 33 * MiB, WS_ROPE64 = 37 * MiB;
constexpr size_t WS_AQ = 40 * MiB, WS_AK = 56 * MiB, WS_AV = 72 * MiB, WS_IQ = 88 * MiB, WS_RQ = 104 * MiB, WS_RK = 120 * MiB, WS_MQ = 136 * MiB;
constexpr size_t WS_RV = 152 * MiB, WS_RG = 184 * MiB, WS_GATES = 216 * MiB;
constexpr size_t WS_IK = 312 * MiB, WS_IW = 313 * MiB, WS_MEMKV = 314 * MiB, WS_MASK = 316 * MiB;
constexpr size_t WS_OA = 324 * MiB, WS_OB = 340 * MiB, WS_OC = 372 * MiB, WS_KVS = 388 * MiB, WS_PREV = 452 * MiB;
constexpr size_t WS_MIXED = 40 * MiB, WS_MIXEDB = 104 * MiB, WS_Y = 136 * MiB, WS_PART = 200 * MiB, WS_ACT = 216 * MiB;
constexpr size_t WS_END = 516 * MiB;

__device__ __forceinline__ float bf2f(bf16_t b) { return __uint_as_float(((unsigned)b) << 16); }
__device__ __forceinline__ bf16_t f2bf(float f) { unsigned u = __float_as_uint(f); return (bf16_t)((u + 0x7fffu + ((u >> 16) & 1u)) >> 16); }
__device__ __forceinline__ float wave_sum(float v) {
#pragma unroll
    for (int o = 1; o < 64; o <<= 1) v += __shfl_xor(v, o);
    return v;
}
__device__ __forceinline__ float wave_max(float v) {
#pragma unroll
    for (int o = 1; o < 64; o <<= 1) v = fmaxf(v, __shfl_xor(v, o));
    return v;
}
__device__ __forceinline__ float sigmoidf_(float x) { return 1.0f / (1.0f + __expf(-x)); }
__device__ __forceinline__ float siluf_(float x) { return x / (1.0f + __expf(-x)); }

__constant__ double ROPE_FREQ[64] = {1.0, 0.8659643233600653, 0.7498942093324559, 0.6493816315762113, 0.5623413251903491, 0.4869675251658631, 0.4216965034285822, 0.3651741272548377, 0.31622776601683794, 0.27384196342643613, 0.23713737056616552, 0.2053525026457146, 0.1778279410038923, 0.1539926526059492, 0.1333521432163324, 0.11547819846894582, 0.1, 0.08659643233600653, 0.07498942093324558, 0.06493816315762113, 0.05623413251903491, 0.04869675251658631, 0.042169650342858224, 0.03651741272548377, 0.03162277660168379, 0.027384196342643614, 0.023713737056616554, 0.02053525026457146, 0.01778279410038923, 0.01539926526059492, 0.01333521432163324, 0.011547819846894581, 0.01, 0.008659643233600654, 0.007498942093324558, 0.006493816315762113, 0.005623413251903491, 0.004869675251658631, 0.004216965034285823, 0.003651741272548377, 0.0031622776601683794, 0.0027384196342643613, 0.0023713737056616554, 0.002053525026457146, 0.0017782794100389228, 0.001539926526059492, 0.001333521432163324, 0.0011547819846894581, 0.001, 0.0008659643233600654, 0.0007498942093324559, 0.0006493816315762113, 0.0005623413251903491, 0.0004869675251658631, 0.00042169650342858224, 0.0003651741272548377, 0.00031622776601683794, 0.0002738419634264361, 0.00023713737056616554, 0.0002053525026457146, 0.00017782794100389227, 0.0001539926526059492, 0.0001333521432163324, 0.00011547819846894582};

__device__ __forceinline__ void sincos_d(double a, float& s, float& c) {
    const double n = rint(a * 0.63661977236758134308);
    double r = fma(-n, 1.57079632679489655800, a);
    r = fma(-n, 6.12323399573676603587e-17, r);
    const double r2 = r * r;
    double sp = -7.6471637318198164759e-13;
    sp = fma(sp, r2, 1.6059043836821614599e-10);
    sp = fma(sp, r2, -2.5052108385441718775e-08);
    sp = fma(sp, r2, 2.7557319223985890653e-06);
    sp = fma(sp, r2, -1.9841269841269841270e-04);
    sp = fma(sp, r2, 8.3333333333333333333e-03);
    sp = fma(sp, r2, -1.6666666666666666667e-01);
    const double sn = fma(sp * r2, r, r);
    double cp = 4.7794773323873852974e-14;
    cp = fma(cp, r2, -1.1470745597729724714e-11);
    cp = fma(cp, r2, 2.0876756987868098979e-09);
    cp = fma(cp, r2, -2.7557319223985890653e-07);
    cp = fma(cp, r2, 2.4801587301587301587e-05);
    cp = fma(cp, r2, -1.3888888888888888889e-03);
    cp = fma(cp, r2, 4.1666666666666666667e-02);
    cp = fma(cp, r2, -0.5);
    const double cs = fma(cp, r2, 1.0);
    const int q = ((int)n) & 3;
    const double ss = (q == 0) ? sn : (q == 1) ? cs : (q == 2) ? -sn : -cs;
    const double cc = (q == 0) ? cs : (q == 1) ? -sn : (q == 2) ? -cs : sn;
    s = (float)ss; c = (float)cc;
}

__global__ void __launch_bounds__(256) k_prep(const float* __restrict__ x, const float* __restrict__ mem, const int* __restrict__ pos,
                                              const float* __restrict__ g_pre, const float* __restrict__ g_mem,
                                              bf16_t* __restrict__ XN, bf16_t* __restrict__ MEMN, float* __restrict__ R128, float* __restrict__ R64) {
    const int lane = threadIdx.x & 63, gw = (blockIdx.x * 256 + threadIdx.x) >> 6, NGW = (gridDim.x * 256) >> 6;
    for (int r = gw; r < S + NMEM; r += NGW) {
        const float* src = (r < S) ? x + (size_t)r * D : mem + (size_t)(r - S) * D;
        const float* g = (r < S) ? g_pre : g_mem;
        bf16_t* dst = (r < S) ? XN + (size_t)r * D : MEMN + (size_t)(r - S) * D;
        float v[32]; float ss = 0.f;
#pragma unroll
        for (int j = 0; j < 8; ++j) { const float4 t = *(const float4*)(src + j * 256 + lane * 4); v[4 * j] = t.x; v[4 * j + 1] = t.y; v[4 * j + 2] = t.z; v[4 * j + 3] = t.w; ss += t.x * t.x + t.y * t.y + t.z * t.z + t.w * t.w; }
        ss = wave_sum(ss);
        const float rs = rsqrtf(ss * (1.0f / D) + EPS);
#pragma unroll
        for (int j = 0; j < 8; ++j) { const float4 gg = *(const float4*)(g + j * 256 + lane * 4);
            ushort4 o; o.x = f2bf(v[4 * j] * rs * gg.x); o.y = f2bf(v[4 * j + 1] * rs * gg.y); o.z = f2bf(v[4 * j + 2] * rs * gg.z); o.w = f2bf(v[4 * j + 3] * rs * gg.w);
            *(ushort4*)(dst + j * 256 + lane * 4) = o; }
    }
    const int gt = blockIdx.x * 256 + threadIdx.x, NT = gridDim.x * 256;
    for (int i = gt; i < S * 64; i += NT) {
        const int s = i >> 6, j = i & 63;
        const float ang = (float)pos[s] * (float)ROPE_FREQ[j];
        float sn, cs; sincos_d((double)ang, sn, cs);
        R128[2 * i] = cs; R128[2 * i + 1] = sn;
        if ((j & 1) == 0) { const int i2 = s * 32 + (j >> 1); R64[2 * i2] = cs; R64[2 * i2 + 1] = sn; }
    }
}

enum { EP_BF16 = 0, EP_F16 = 1, EP_F32 = 2, EP_SIGMOID = 3, EP_SILU = 4, EP_GATEACC = 5, EP_SILUMUL = 6 };
struct GemmP {
    const bf16_t* A; int lda; const float* B; int ldb; int M, N, K;
    void* Dst; int ldd; float scale; int mode;
    const bf16_t* G; int ldg; int first;
};
__global__ void __launch_bounds__(256) k_gemm(GemmP p) {
    __shared__ float As[16][128 + 4];
    __shared__ float Bs[16][128 + 4];
    const int tid = threadIdx.x, tx = tid & 15, ty = tid >> 4;
    const int m0 = blockIdx.y * 128, n0 = blockIdx.x * 128;
    float acc[8][8];
#pragma unroll
    for (int i = 0; i < 8; ++i)
#pragma unroll
        for (int j = 0; j < 8; ++j) acc[i][j] = 0.f;
    const int ar = tid >> 1, ak = (tid & 1) * 8;
    const int bk = tid >> 4, bc = (tid & 15) * 8;
    for (int k0 = 0; k0 < p.K; k0 += 16) {
        {
            const uint4 raw = *(const uint4*)(p.A + (size_t)(m0 + ar) * p.lda + k0 + ak);
            const unsigned w[4] = {raw.x, raw.y, raw.z, raw.w};
#pragma unroll
            for (int j = 0; j < 4; ++j) { As[ak + 2 * j][ar] = __uint_as_float(w[j] << 16); As[ak + 2 * j + 1][ar] = __uint_as_float(w[j] & 0xffff0000u); }
        }
        {
            const float* bp = p.B + (size_t)(k0 + bk) * p.ldb + n0 + bc;
#pragma unroll
            for (int j = 0; j < 8; ++j) Bs[bk][bc + j] = (n0 + bc + j < p.N) ? bp[j] : 0.f;
        }
        __syncthreads();
#pragma unroll
        for (int kk = 0; kk < 16; ++kk) {
            float a[8], b[8];
#pragma unroll
            for (int i = 0; i < 8; ++i) a[i] = As[kk][ty * 8 + i];
#pragma unroll
            for (int j = 0; j < 8; ++j) b[j] = Bs[kk][tx * 8 + j];
#pragma unroll
            for (int i = 0; i < 8; ++i)
#pragma unroll
                for (int j = 0; j < 8; ++j) acc[i][j] = fmaf(a[i], b[j], acc[i][j]);
        }
        __syncthreads();
    }
#pragma unroll
    for (int i = 0; i < 8; ++i) {
        const int r = m0 + ty * 8 + i;
#pragma unroll
        for (int j = 0; j < 8; ++j) {
            const int c = n0 + tx * 8 + j;
            if (c >= p.N) continue;
            const float v = acc[i][j] * p.scale;
            const size_t o = (size_t)r * p.ldd + c;
            switch (p.mode) {
                case EP_BF16: ((bf16_t*)p.Dst)[o] = f2bf(v); break;
                case EP_F16: ((f16_t*)p.Dst)[o] = (f16_t)v; break;
                case EP_F32: ((float*)p.Dst)[o] = v; break;
                case EP_SIGMOID: ((bf16_t*)p.Dst)[o] = f2bf(sigmoidf_(v)); break;
                case EP_SILU: ((bf16_t*)p.Dst)[o] = f2bf(siluf_(v)); break;
                case EP_GATEACC: { float* F = (float*)p.Dst; const float g = bf2f(p.G[(size_t)r * p.ldg + c]); F[o] = (p.first ? 0.f : F[o]) + g * v; } break;
                case EP_SILUMUL: { bf16_t* Dd = (bf16_t*)p.Dst; Dd[o] = f2bf(siluf_(v) * bf2f(Dd[o])); } break;
            }
        }
    }
}

template <bool F16> __global__ void __launch_bounds__(256) k_rope(void* buf, int nh, int d, const float* __restrict__ tab, float scale) {
    const int half = d >> 1;
    const size_t total = (size_t)S * nh * half;
    for (size_t i = (size_t)blockIdx.x * 256 + threadIdx.x; i < total; i += (size_t)gridDim.x * 256) {
        const int j = (int)(i % half); const size_t t = i / half; const int h = (int)(t % nh); const int s = (int)(t / nh);
        const float cs = tab[((size_t)s * half + j) * 2], sn = tab[((size_t)s * half + j) * 2 + 1];
        const size_t o = ((size_t)s * nh + h) * d + j;
        float x1, x2;
        if (F16) { x1 = (float)((f16_t*)buf)[o]; x2 = (float)((f16_t*)buf)[o + half]; } else { x1 = bf2f(((bf16_t*)buf)[o]); x2 = bf2f(((bf16_t*)buf)[o + half]); }
        const float y1 = (x1 * cs - x2 * sn) * scale, y2 = (x2 * cs + x1 * sn) * scale;
        if (F16) { ((f16_t*)buf)[o] = (f16_t)y1; ((f16_t*)buf)[o + half] = (f16_t)y2; } else { ((bf16_t*)buf)[o] = f2bf(y1); ((bf16_t*)buf)[o + half] = f2bf(y2); }
    }
}

__device__ __forceinline__ unsigned ordkey(float f) { const unsigned u = __float_as_uint(f); return (u & 0x80000000u) ? ~u : (u | 0x80000000u); }
__global__ void __launch_bounds__(256) k_index(const f16_t* __restrict__ IQ, const f16_t* __restrict__ IK, const float* __restrict__ IW, unsigned* __restrict__ MASK) {
    __shared__ float q[NIH * IDXD];
    __shared__ float w[NIH];
    __shared__ unsigned keys[S];
    __shared__ int red[4];
    const int t = blockIdx.x, tid = threadIdx.x, lane = tid & 63, wv = tid >> 6;
    for (int i = tid; i < NIH * IDXD; i += 256) q[i] = (float)IQ[(size_t)t * (NIH * IDXD) + i];
    if (tid < NIH) w[tid] = IW[(size_t)t * NIH + tid];
    __syncthreads();
    const int n = t + 1;
    for (int k = tid; k < n; k += 256) {
        float kk[IDXD];
        const f16_t* kp = IK + (size_t)k * IDXD;
#pragma unroll
        for (int d = 0; d < IDXD; ++d) kk[d] = (float)kp[d];
        float sc = 0.f;
        for (int h = 0; h < NIH; ++h) {
            float x = 0.f;
#pragma unroll
            for (int d = 0; d < IDXD; ++d) x = fmaf(q[h * IDXD + d], kk[d], x);
            sc = fmaf(fmaxf(x, 0.f), w[h], sc);
        }
        keys[k] = ordkey(sc);
    }
    __syncthreads();
    unsigned tau = 0u;
    if (n > 256) {
        for (int b = 31; b >= 0; --b) {
            const unsigned cand = tau | (1u << b);
            int c = 0;
            for (int k = tid; k < n; k += 256) c += (keys[k] >= cand) ? 1 : 0;
#pragma unroll
            for (int o = 1; o < 64; o <<= 1) c += __shfl_xor(c, o);
            __syncthreads();
            if (lane == 0) red[wv] = c;
            __syncthreads();
            const int tot = red[0] + red[1] + red[2] + red[3];
            if (tot >= 256) tau = cand;
        }
    }
    for (int k0 = 0; k0 < S; k0 += 256) {
        const int k = k0 + tid;
        const bool sel = (k < n) && (keys[k] >= tau);
        const unsigned long long b = __ballot(sel);
        if (lane == 0) { MASK[(size_t)t * 256 + (k >> 5)] = (unsigned)b; MASK[(size_t)t * 256 + (k >> 5) + 1] = (unsigned)(b >> 32); }
    }
}

constexpr int MAXSEL = 512;
__global__ void __launch_bounds__(256) k_attn(const bf16_t* __restrict__ AQ, const bf16_t* __restrict__ AK, const bf16_t* __restrict__ AV, const unsigned* __restrict__ MASK, bf16_t* __restrict__ OA) {
    __shared__ float q[AW];
    __shared__ int idx[MAXSEL];
    __shared__ float lg[8][MAXSEL];
    __shared__ int wcnt[256];
    __shared__ int nsel_s;
    const int t = blockIdx.x, tid = threadIdx.x, lane = tid & 63, wv = tid >> 6;
    for (int i = tid; i < AW; i += 256) q[i] = bf2f(AQ[(size_t)t * AW + i]);
    const unsigned mw = MASK[(size_t)t * 256 + tid];
    wcnt[tid] = __popc(mw);
    __syncthreads();
    if (tid == 0) { int a = 0; for (int i = 0; i < 256; ++i) { const int c = wcnt[i]; wcnt[i] = a; a += c; } nsel_s = a; }
    __syncthreads();
    {
        int pos = wcnt[tid]; unsigned m = mw;
        while (m) { const int b = __ffs(m) - 1; m &= m - 1; if (pos < MAXSEL) idx[pos] = tid * 32 + b; ++pos; }
    }
    __syncthreads();
    const int nsel = min(nsel_s, MAXSEL);
    for (int j = tid; j < nsel; j += 256) {
        const bf16_t* kp = AK + (size_t)idx[j] * AW;
        for (int h = 0; h < 8; ++h) {
            float a = 0.f;
            for (int d = 0; d < 128; d += 8) {
                const uint4 raw = *(const uint4*)(kp + h * 128 + d);
                const unsigned ww[4] = {raw.x, raw.y, raw.z, raw.w};
#pragma unroll
                for (int e = 0; e < 4; ++e) { a = fmaf(q[h * 128 + d + 2 * e], __uint_as_float(ww[e] << 16), a); a = fmaf(q[h * 128 + d + 2 * e + 1], __uint_as_float(ww[e] & 0xffff0000u), a); }
            }
            lg[h][j] = a;
        }
    }
    __syncthreads();
    for (int hh = 0; hh < 2; ++hh) {
        const int h = wv * 2 + hh;
        float m = -INFINITY;
        for (int j = lane; j < nsel; j += 64) m = fmaxf(m, lg[h][j]);
        m = wave_max(m);
        float s = 0.f;
        for (int j = lane; j < nsel; j += 64) { const float e = __expf(lg[h][j] - m); lg[h][j] = e; s += e; }
        s = wave_sum(s);
        const float inv = 1.0f / s;
        for (int j = lane; j < nsel; j += 64) lg[h][j] *= inv;
    }
    __syncthreads();
    for (int c = tid; c < AW; c += 256) {
        const int h = c >> 7;
        float a = 0.f;
        for (int j = 0; j < nsel; ++j) a = fmaf(lg[h][j], bf2f(AV[(size_t)idx[j] * AW + c]), a);
        OA[(size_t)t * AW + c] = f2bf(a);
    }
}

__device__ __forceinline__ float ret_loggamma(int h) { return log1pf(-exp2f(-5.0f - (float)h)); }
__global__ void __launch_bounds__(256) k_ret_kv(const bf16_t* __restrict__ RK, const bf16_t* __restrict__ RV, float* __restrict__ KVS) {
    const int nh = blockIdx.x, n = nh >> 3, h = nh & 7, d0 = blockIdx.y * 16, e = threadIdx.x;
    __shared__ float ks[128][16];
    const float lgm = ret_loggamma(h);
    for (int i = threadIdx.x; i < 128 * 16; i += 256) { const int j = i >> 4, dd = i & 15; ks[j][dd] = bf2f(RK[(size_t)(n * 128 + j) * RQK + h * 128 + d0 + dd]) * __expf((float)(127 - j) * lgm); }
    __syncthreads();
    float acc[16];
#pragma unroll
    for (int dd = 0; dd < 16; ++dd) acc[dd] = 0.f;
    for (int j = 0; j < 128; ++j) {
        const float v = bf2f(RV[(size_t)(n * 128 + j) * RVW + h * 256 + e]);
#pragma unroll
        for (int dd = 0; dd < 16; ++dd) acc[dd] = fmaf(ks[j][dd], v, acc[dd]);
    }
#pragma unroll
    for (int dd = 0; dd < 16; ++dd) KVS[(((size_t)n * 8 + h) * 128 + d0 + dd) * 256 + e] = acc[dd];
}
__global__ void __launch_bounds__(256) k_ret_scan(const float* __restrict__ KVS, float* __restrict__ PREV) {
    const int i = blockIdx.x * 256 + threadIdx.x;
    const int h = i >> 15;
    const float cd = __expf(128.0f * ret_loggamma(h));
    float st = 0.f;
    for (int n = 0; n < 64; ++n) { const size_t o = (size_t)n * (8 * 128 * 256) + i; PREV[o] = st; st = st * cd + KVS[o]; }
}
__global__ void __launch_bounds__(256) k_ret_out(const bf16_t* __restrict__ RQ, const bf16_t* __restrict__ RK, const bf16_t* __restrict__ RV, const bf16_t* __restrict__ RG,
                                                 const float* __restrict__ PREV, bf16_t* __restrict__ OB) {
    extern __shared__ float sm[];
    float* sc = sm;
    float* qs = sm + 128 * 128;
    float* red = qs + 128 * 128;
    const int nh = blockIdx.x, n = nh >> 3, h = nh & 7, tid = threadIdx.x, lane = tid & 63, wv = tid >> 6;
    const float lgm = ret_loggamma(h);
    for (int i = tid; i < 128 * 128; i += 256) { const int r = i >> 7, d = i & 127; qs[i] = bf2f(RQ[(size_t)(n * 128 + r) * RQK + h * 128 + d]); }
    __syncthreads();
    for (int idx = tid; idx < 128 * 128; idx += 256) {
        const int i = idx >> 7, j = idx & 127;
        float a = 0.f;
        if (j <= i) {
            const bf16_t* kp = RK + (size_t)(n * 128 + j) * RQK + h * 128;
            for (int d = 0; d < 128; ++d) a = fmaf(qs[i * 128 + d], bf2f(kp[d]), a);
            a *= __expf((float)(i - j) * lgm);
        }
        sc[idx] = a;
    }
    __syncthreads();
    const int e = tid;
    const float* pv = PREV + (((size_t)n * 8 + h) * 128) * 256 + e;
    for (int i = 0; i < 128; ++i) {
        float inner = 0.f;
        for (int j = 0; j <= i; ++j) inner = fmaf(sc[i * 128 + j], bf2f(RV[(size_t)(n * 128 + j) * RVW + h * 256 + e]), inner);
        float cross = 0.f;
        for (int d = 0; d < 128; ++d) cross = fmaf(qs[i * 128 + d], pv[(size_t)d * 256], cross);
        const float y = inner + cross * __expf((float)(i + 1) * lgm);
        float s1 = wave_sum(y);
        __syncthreads();
        if (lane == 0) red[wv] = s1;
        __syncthreads();
        const float mu = (red[0] + red[1] + red[2] + red[3]) * (1.0f / 256.0f);
        const float dv = y - mu;
        float s2 = wave_sum(dv * dv);
        __syncthreads();
        if (lane == 0) red[wv] = s2;
        __syncthreads();
        const float var = (red[0] + red[1] + red[2] + red[3]) * (1.0f / 256.0f);
        const float yn = dv * rsqrtf(var + EPS);
        const size_t o = (size_t)(n * 128 + i) * RVW + h * 256 + e;
        OB[o] = f2bf(bf2f(RG[o]) * yn);
    }
}

__global__ void __launch_bounds__(256) k_memattn(const bf16_t* __restrict__ MQ, const bf16_t* __restrict__ MEMKV, bf16_t* __restrict__ OC) {
    __shared__ float q[MW];
    __shared__ float p[4][256];
    __shared__ float red[4];
    const int t = blockIdx.x, tid = threadIdx.x, lane = tid & 63, wv = tid >> 6;
    for (int i = tid; i < MW; i += 256) q[i] = bf2f(MQ[(size_t)t * MW + i]);
    __syncthreads();
    const bf16_t* kp = MEMKV + (size_t)tid * 2048;
    float lg[4];
    for (int h = 0; h < 4; ++h) { float a = 0.f; for (int d = 0; d < 256; ++d) a = fmaf(q[h * 256 + d], bf2f(kp[h * 256 + d]), a); lg[h] = a; }
    for (int h = 0; h < 4; ++h) {
        float m = wave_max(lg[h]);
        __syncthreads(); if (lane == 0) red[wv] = m; __syncthreads();
        m = fmaxf(fmaxf(red[0], red[1]), fmaxf(red[2], red[3]));
        const float e = __expf(lg[h] - m);
        float s = wave_sum(e);
        __syncthreads(); if (lane == 0) red[wv] = s; __syncthreads();
        s = red[0] + red[1] + red[2] + red[3];
        p[h][tid] = e / s;
    }
    __syncthreads();
    for (int c = tid; c < MW; c += 256) {
        const int h = c >> 8;
        float a = 0.f;
        for (int m = 0; m < 256; ++m) a = fmaf(p[h][m], bf2f(MEMKV[(size_t)m * 2048 + 1024 + c]), a);
        OC[(size_t)t * MW + c] = f2bf(a);
    }
}

__global__ void __launch_bounds__(256) k_f32_to_bf16(const float* __restrict__ src, bf16_t* __restrict__ dst, size_t n) {
    for (size_t i = (size_t)blockIdx.x * 256 + threadIdx.x; i < n; i += (size_t)gridDim.x * 256) dst[i] = f2bf(src[i]);
}
__global__ void __launch_bounds__(256) k_resnorm(const float* xin, const float* __restrict__ y, const float* __restrict__ g1, const float* __restrict__ g2, float* out, bf16_t* __restrict__ h2) {
    const int lane = threadIdx.x & 63, gw = (blockIdx.x * 256 + threadIdx.x) >> 6, NGW = (gridDim.x * 256) >> 6;
    for (int r = gw; r < S; r += NGW) {
        float yv[32], xv[32]; float ss = 0.f;
#pragma unroll
        for (int j = 0; j < 8; ++j) { const float4 t = *(const float4*)(y + (size_t)r * D + j * 256 + lane * 4); yv[4 * j] = t.x; yv[4 * j + 1] = t.y; yv[4 * j + 2] = t.z; yv[4 * j + 3] = t.w; ss += t.x * t.x + t.y * t.y + t.z * t.z + t.w * t.w; }
        ss = wave_sum(ss);
        const float rs = rsqrtf(ss * (1.0f / D) + EPS);
        float s2 = 0.f;
#pragma unroll
        for (int j = 0; j < 8; ++j) {
            const float4 xx = *(const float4*)(xin + (size_t)r * D + j * 256 + lane * 4);
            const float4 gg = *(const float4*)(g1 + j * 256 + lane * 4);
            xv[4 * j] = xx.x + yv[4 * j] * rs * gg.x; xv[4 * j + 1] = xx.y + yv[4 * j + 1] * rs * gg.y; xv[4 * j + 2] = xx.z + yv[4 * j + 2] * rs * gg.z; xv[4 * j + 3] = xx.w + yv[4 * j + 3] * rs * gg.w;
            s2 += xv[4 * j] * xv[4 * j] + xv[4 * j + 1] * xv[4 * j + 1] + xv[4 * j + 2] * xv[4 * j + 2] + xv[4 * j + 3] * xv[4 * j + 3];
            *(float4*)(out + (size_t)r * D + j * 256 + lane * 4) = make_float4(xv[4 * j], xv[4 * j + 1], xv[4 * j + 2], xv[4 * j + 3]);
        }
        if (h2) {
            s2 = wave_sum(s2);
            const float r2 = rsqrtf(s2 * (1.0f / D) + EPS);
#pragma unroll
            for (int j = 0; j < 8; ++j) { const float4 gg = *(const float4*)(g2 + j * 256 + lane * 4);
                ushort4 o; o.x = f2bf(xv[4 * j] * r2 * gg.x); o.y = f2bf(xv[4 * j + 1] * r2 * gg.y); o.z = f2bf(xv[4 * j + 2] * r2 * gg.z); o.w = f2bf(xv[4 * j + 3] * r2 * gg.w);
                *(ushort4*)(h2 + (size_t)r * D + j * 256 + lane * 4) = o; }
        }
    }
}

static void gemm(hipStream_t st, const bf16_t* A, int lda, const float* B, int ldb, int M, int N, int K, void* Dst, int ldd, float scale, int mode,
                 const bf16_t* G = nullptr, int ldg = 0, int first = 0) {
    GemmP p{}; p.A = A; p.lda = lda; p.B = B; p.ldb = ldb; p.M = M; p.N = N; p.K = K; p.Dst = Dst; p.ldd = ldd; p.scale = scale; p.mode = mode; p.G = G; p.ldg = ldg; p.first = first;
    hipLaunchKernelGGL(k_gemm, dim3((N + 127) / 128, M / 128), dim3(256), 0, st, p);
}

extern "C" void kernel_launch(void* const* d_in, const int* in_sizes, int n_in, void* d_out, int out_size, void* d_ws, size_t ws_size, hipStream_t stream) {
    if (n_in != 16 || ws_size < WS_END) return;
    const float* x = (const float*)d_in[0]; const float* mem = (const float*)d_in[1]; const int* pos = (const int*)d_in[2];
    const float* g_pre_mix = (const float*)d_in[3]; const float* g_mem = (const float*)d_in[4]; const float* w_in = (const float*)d_in[5];
    const float* w_mem_kv = (const float*)d_in[6]; const float* w_a = (const float*)d_in[7]; const float* w_b = (const float*)d_in[8]; const float* w_c = (const float*)d_in[9];
    const float* w_out = (const float*)d_in[10]; const float* g_post_mix = (const float*)d_in[11]; const float* g_pre_ffn = (const float*)d_in[12];
    const float* w_ffn_in = (const float*)d_in[13]; const float* w_ffn_out = (const float*)d_in[14]; const float* g_post_ffn = (const float*)d_in[15];
    float* out = (float*)d_out;
    unsigned char* ws = (unsigned char*)d_ws;
    bf16_t* XN = (bf16_t*)(ws + WS_XN); bf16_t* MEMN = (bf16_t*)(ws + WS_MEMN); float* R128 = (float*)(ws + WS_ROPE128); float* R64 = (float*)(ws + WS_ROPE64);
    bf16_t* AQ = (bf16_t*)(ws + WS_AQ); bf16_t* AK = (bf16_t*)(ws + WS_AK); bf16_t* AV = (bf16_t*)(ws + WS_AV); f16_t* IQ = (f16_t*)(ws + WS_IQ);
    bf16_t* RQ = (bf16_t*)(ws + WS_RQ); bf16_t* RK = (bf16_t*)(ws + WS_RK); bf16_t* MQ = (bf16_t*)(ws + WS_MQ); bf16_t* RV = (bf16_t*)(ws + WS_RV); bf16_t* RG = (bf16_t*)(ws + WS_RG);
    bf16_t* GATES = (bf16_t*)(ws + WS_GATES); f16_t* IK = (f16_t*)(ws + WS_IK); float* IW = (float*)(ws + WS_IW); bf16_t* MEMKV = (bf16_t*)(ws + WS_MEMKV); unsigned* MASK = (unsigned*)(ws + WS_MASK);
    bf16_t* OA = (bf16_t*)(ws + WS_OA); bf16_t* OB = (bf16_t*)(ws + WS_OB); bf16_t* OC = (bf16_t*)(ws + WS_OC); float* KVS = (float*)(ws + WS_KVS); float* PREV = (float*)(ws + WS_PREV);
    float* MIXED = (float*)(ws + WS_MIXED); bf16_t* MIXEDB = (bf16_t*)(ws + WS_MIXEDB); float* Y = (float*)(ws + WS_Y); bf16_t* ACT = (bf16_t*)(ws + WS_ACT);

    hipLaunchKernelGGL(k_prep, dim3(1024), dim3(256), 0, stream, x, mem, pos, g_pre_mix, g_mem, XN, MEMN, R128, R64);
    gemm(stream, XN, D, w_in + C_AQ, INC, S, AW, D, AQ, AW, 1.f, EP_BF16);
    gemm(stream, XN, D, w_in + C_AK, INC, S, AW, D, AK, AW, 1.f, EP_BF16);
    gemm(stream, XN, D, w_in + C_AV, INC, S, AW, D, AV, AW, 1.f, EP_BF16);
    gemm(stream, XN, D, w_in + C_IQ, INC, S, IQW, D, IQ, IQW, 1.f, EP_F16);
    gemm(stream, XN, D, w_in + C_IK, INC, S, IDXD, D, IK, IDXD, 1.f, EP_F16);
    gemm(stream, XN, D, w_in + C_IW, INC, S, NIH, D, IW, NIH, 0.25f, EP_F32);
    gemm(stream, XN, D, w_in + C_RQ, INC, S, RQK, D, RQ, RQK, 1.f, EP_BF16);
    gemm(stream, XN, D, w_in + C_RK, INC, S, RQK, D, RK, RQK, 1.f, EP_BF16);
    gemm(stream, XN, D, w_in + C_RV, INC, S, RVW, D, RV, RVW, 1.f, EP_BF16);
    gemm(stream, XN, D, w_in + C_RG, INC, S, RVW, D, RG, RVW, 1.f, EP_SILU);
    gemm(stream, XN, D, w_in + C_MQ, INC, S, MW, D, MQ, MW, 0.0625f, EP_BF16);
    gemm(stream, XN, D, w_in + C_GT, INC, S, 3 * D, D, GATES, 3 * D, 1.f, EP_SIGMOID);
    gemm(stream, MEMN, D, w_mem_kv, 2 * MW, NMEM, 2 * MW, D, MEMKV, 2 * MW, 1.f, EP_BF16);
    hipLaunchKernelGGL(k_rope<false>, dim3(2048), dim3(256), 0, stream, (void*)AQ, 8, 128, R128, 0.08838834764831845f);
    hipLaunchKernelGGL(k_rope<false>, dim3(2048), dim3(256), 0, stream, (void*)AK, 8, 128, R128, 1.0f);
    hipLaunchKernelGGL(k_rope<true>, dim3(2048), dim3(256), 0, stream, (void*)IQ, 16, 64, R64, 0.125f);
    hipLaunchKernelGGL(k_rope<true>, dim3(256), dim3(256), 0, stream, (void*)IK, 1, 64, R64, 1.0f);
    hipLaunchKernelGGL(k_rope<false>, dim3(2048), dim3(256), 0, stream, (void*)RQ, 8, 128, R128, 1.0f);
    hipLaunchKernelGGL(k_rope<false>, dim3(2048), dim3(256), 0, stream, (void*)RK, 8, 128, R128, 0.08838834764831845f);
    hipLaunchKernelGGL(k_index, dim3(S), dim3(256), 0, stream, IQ, IK, IW, MASK);
    hipLaunchKernelGGL(k_attn, dim3(S), dim3(256), 0, stream, AQ, AK, AV, MASK, OA);
    hipLaunchKernelGGL(k_ret_kv, dim3(512, 8), dim3(256), 0, stream, RK, RV, KVS);
    hipLaunchKernelGGL(k_ret_scan, dim3(1024), dim3(256), 0, stream, KVS, PREV);
    static bool attr_done = false;
    if (!attr_done) { (void)hipFuncSetAttribute((const void*)k_ret_out, hipFuncAttributeMaxDynamicSharedMemorySize, (2 * 128 * 128 + 8) * 4); attr_done = true; }
    hipLaunchKernelGGL(k_ret_out, dim3(512), dim3(256), (2 * 128 * 128 + 8) * 4, stream, RQ, RK, RV, RG, PREV, OB);
    hipLaunchKernelGGL(k_memattn, dim3(S), dim3(256), 0, stream, MQ, MEMKV, OC);
    gemm(stream, OA, AW, w_a, D, S, D, AW, MIXED, D, 1.f, EP_GATEACC, GATES, 3 * D, 1);
    gemm(stream, OB, RVW, w_b, D, S, D, RVW, MIXED, D, 1.f, EP_GATEACC, GATES + D, 3 * D, 0);
    gemm(stream, OC, MW, w_c, D, S, D, MW, MIXED, D, 1.f, EP_GATEACC, GATES + 2 * D, 3 * D, 0);
    hipLaunchKernelGGL(k_f32_to_bf16, dim3(2048), dim3(256), 0, stream, MIXED, MIXEDB, (size_t)S * D);
    gemm(stream, MIXEDB, D, w_out, D, S, D, D, Y, D, 1.f, EP_F32);
    hipLaunchKernelGGL(k_resnorm, dim3(1024), dim3(256), 0, stream, x, Y, g_post_mix, g_pre_ffn, out, XN);
    gemm(stream, XN, D, w_ffn_in + DFF, 2 * DFF, S, DFF, D, ACT, DFF, 1.f, EP_BF16);
    gemm(stream, XN, D, w_ffn_in, 2 * DFF, S, DFF, D, ACT, DFF, 1.f, EP_SILUMUL);
    gemm(stream, ACT, DFF, w_ffn_out, D, S, D, DFF, Y, D, 1.f, EP_F32);
    hipLaunchKernelGGL(k_resnorm, dim3(1024), dim3(256), 0, stream, (const float*)out, Y, g_post_ffn, (const float*)nullptr, out, (bf16_t*)nullptr);
}
```

```cpp
#include <hip/hip_runtime.h>
#include <cstdio>
#include <cstdint>


typedef unsigned short bf16_t;
typedef _Float16 f16_t;
#define LAS __attribute__((address_space(3)))
#define GAS __attribute__((address_space(1)))
constexpr int S = 8192, D = 2048, NMEM = 256;
constexpr int AW = 1024, IQW = 1024, IDXD = 64, NIH = 16, RQK = 1024, RVW = 2048, MW = 1024;
constexpr int INC = 17488, DFF = 5632;
constexpr int C_AQ = 0, C_AK = 1024, C_AV = 2048, C_IQ = 3072, C_IK = 4096, C_IW = 4160, C_RQ = 4176, C_RK = 5200, C_RV = 6224, C_RG = 8272, C_MQ = 10320, C_GT = 11344;
static_assert(C_GT + 3 * D == INC, "cols");
constexpr float EPS = 1e-6f;
constexpr int NP_IN = 69 * 256;
constexpr int NWAVES = 8, NT = NWAVES * 64;

constexpr size_t MiB = 1u << 20;
constexpr size_t WS_CTL = 0, CTL_ZERO_BYTES = 1 * MiB;
constexpr size_t WS_WIN = 2 * MiB, WS_WMEMKV = 71 * MiB, WS_WA = 79 * MiB, WS_WB = 83 * MiB, WS_WC = 91 * MiB, WS_WOUT = 95 * MiB, WS_WFFIN = 103 * MiB, WS_WFFOUT = 147 * MiB;
constexpr size_t WS_XN = 169 * MiB, WS_MEMN = 201 * MiB, WS_ROPE128 = 202 * MiB, WS_ROPE64 = 206 * MiB;
constexpr size_t WS_AQ = 208 * MiB, WS_AK = 224 * MiB, WS_AV = 240 * MiB, WS_IQ = 256 * MiB, WS_RQ = 272 * MiB, WS_RK = 288 * MiB, WS_MQ = 304 * MiB;
constexpr size_t WS_RV = 320 * MiB, WS_RG = 352 * MiB, WS_GATES = 384 * MiB;
constexpr size_t WS_IK = 480 * MiB, WS_IW = 481 * MiB, WS_MEMKV = 482 * MiB, WS_MASK = 484 * MiB, WS_PREV = 492 * MiB;
constexpr size_t WS_OA = WS_IQ, WS_OC = WS_MQ, WS_OB = WS_RG;
constexpr size_t WS_KVS = 2 * MiB;
constexpr size_t WS_MIXED = 2 * MiB, WS_MIXEDB = 208 * MiB, WS_Y = 272 * MiB, WS_ACT = 384 * MiB;
constexpr size_t WS_END = 524 * MiB;
static_assert(WS_WIN + (size_t)NP_IN * D * 2 == WS_WMEMKV, "in-proj and mem-kv weight copies must be contiguous");
static_assert(WS_XN + (size_t)S * D * 2 == WS_MEMN, "XN and MEMN must be contiguous");

__device__ __forceinline__ float bf2f(bf16_t b) { return __uint_as_float(((unsigned)b) << 16); }
__device__ __forceinline__ bf16_t f2bf(float f) { unsigned u = __float_as_uint(f); return (bf16_t)((u + 0x7fffu + ((u >> 16) & 1u)) >> 16); }
__device__ __forceinline__ unsigned pk2(float lo, float hi) { return (unsigned)f2bf(lo) | ((unsigned)f2bf(hi) << 16); }
__device__ __forceinline__ unsigned pkh2(float lo, float hi) { const f16_t a = (f16_t)lo, b = (f16_t)hi; return (unsigned)__builtin_bit_cast(unsigned short, a) | ((unsigned)__builtin_bit_cast(unsigned short, b) << 16); }
__device__ __forceinline__ float wave_sum(float v) {
#pragma unroll
    for (int o = 1; o < 64; o <<= 1) v += __shfl_xor(v, o);
    return v;
}
__device__ __forceinline__ float wave_max(float v) {
#pragma unroll
    for (int o = 1; o < 64; o <<= 1) v = fmaxf(v, __shfl_xor(v, o));
    return v;
}
__device__ __forceinline__ float sigmoidf_(float x) { return 1.0f / (1.0f + __expf(-x)); }
__device__ __forceinline__ float siluf_(float x) { return x / (1.0f + __expf(-x)); }

__constant__ double ROPE_FREQ[64] = {1.0, 0.8659643233600653, 0.7498942093324559, 0.6493816315762113, 0.5623413251903491, 0.4869675251658631, 0.4216965034285822, 0.3651741272548377, 0.31622776601683794, 0.27384196342643613, 0.23713737056616552, 0.2053525026457146, 0.1778279410038923, 0.1539926526059492, 0.1333521432163324, 0.11547819846894582, 0.1, 0.08659643233600653, 0.07498942093324558, 0.06493816315762113, 0.05623413251903491, 0.04869675251658631, 0.042169650342858224, 0.03651741272548377, 0.03162277660168379, 0.027384196342643614, 0.023713737056616554, 0.02053525026457146, 0.01778279410038923, 0.01539926526059492, 0.01333521432163324, 0.011547819846894581, 0.01, 0.008659643233600654, 0.007498942093324558, 0.006493816315762113, 0.005623413251903491, 0.004869675251658631, 0.004216965034285823, 0.003651741272548377, 0.0031622776601683794, 0.0027384196342643613, 0.0023713737056616554, 0.002053525026457146, 0.0017782794100389228, 0.001539926526059492, 0.001333521432163324, 0.0011547819846894581, 0.001, 0.0008659643233600654, 0.0007498942093324559, 0.0006493816315762113, 0.0005623413251903491, 0.0004869675251658631, 0.00042169650342858224, 0.0003651741272548377, 0.00031622776601683794, 0.0002738419634264361, 0.00023713737056616554, 0.0002053525026457146, 0.00017782794100389227, 0.0001539926526059492, 0.0001333521432163324, 0.00011547819846894582};

__device__ __forceinline__ void sincos_d(double a, float& s, float& c) {
    const double n = rint(a * 0.63661977236758134308);
    double r = fma(-n, 1.57079632679489655800, a);
    r = fma(-n, 6.12323399573676603587e-17, r);
    const double r2 = r * r;
    double sp = -7.6471637318198164759e-13;
    sp = fma(sp, r2, 1.6059043836821614599e-10); sp = fma(sp, r2, -2.5052108385441718775e-08); sp = fma(sp, r2, 2.7557319223985890653e-06);
    sp = fma(sp, r2, -1.9841269841269841270e-04); sp = fma(sp, r2, 8.3333333333333333333e-03); sp = fma(sp, r2, -1.6666666666666666667e-01);
    const double sn = fma(sp * r2, r, r);
    double cp = 4.7794773323873852974e-14;
    cp = fma(cp, r2, -1.1470745597729724714e-11); cp = fma(cp, r2, 2.0876756987868098979e-09); cp = fma(cp, r2, -2.7557319223985890653e-07);
    cp = fma(cp, r2, 2.4801587301587301587e-05); cp = fma(cp, r2, -1.3888888888888888889e-03); cp = fma(cp, r2, 4.1666666666666666667e-02); cp = fma(cp, r2, -0.5);
    const double cs = fma(cp, r2, 1.0);
    const int q = ((int)n) & 3;
    const double ss = (q == 0) ? sn : (q == 1) ? cs : (q == 2) ? -sn : -cs;
    const double cc = (q == 0) ? cs : (q == 1) ? -sn : (q == 2) ? -cs : sn;
    s = (float)ss; c = (float)cc;
}
namespace pg8 {
#define PG8_LAS __attribute__((address_space(3)))
typedef unsigned short bf16_t;
typedef short bf16x8 __attribute__((ext_vector_type(8)));
typedef float f32x4 __attribute__((ext_vector_type(4)));
typedef unsigned u32x4 __attribute__((ext_vector_type(4)));
constexpr int BM = 256, BK = 64, HALF = 128, HTB = HALF * BK * 2  , STAGE_BYTES = 8 * HTB, NXCD = 8, WGM = 8;

__host__ __device__ __forceinline__ int lds_byte(int r, int c) { const int st = (r >> 4) * 2 + (c >> 5), rr = r & 15, cc = c & 31, ob = rr * 64 + cc * 2; return st * 1024 + (ob ^ (((ob >> 9) & 1) << 5)); }
__host__ __device__ __forceinline__ void stage_rc(int b, int& R, int& C) { const int st = b / 1024, sb = b % 1024, swz = sb ^ (((sb >> 9) & 1) << 5); R = (st >> 1) * 16 + swz / 64; C = (st & 1) * 32 + (swz % 64) / 2; }
__host__ __device__ __forceinline__ int perm32(int rho) { const int n = rho >> 4, i = rho & 15; return 8 * (i >> 2) + 4 * n + (i & 3); }

struct Unit { int pm, pn; };
struct Gemm { const bf16_t* A; const bf16_t* Bt; int M, N, K; };

struct StaticOrder {
    int nM, nN, nwg, G, c;
    __host__ __device__ void init(int M, int N, int G_, int c_) { nM = M / BM; nN = N / BM; nwg = nM * nN; G = G_; c = c_; }
    __host__ __device__ bool next(int i, Unit& u) const {
        const long L = (long)i * G + c; if (L >= nwg) return false;
        int wgid = (int)L; { const int q = nwg / NXCD, r = nwg % NXCD, xcd = wgid % NXCD, off = wgid / NXCD; wgid = (xcd < r ? xcd * (q + 1) : r * (q + 1) + (xcd - r) * q) + off; }
        const int nig = WGM * nN, gid = wgid / nig, fm = gid * WGM, gsz = (nM - fm) < WGM ? (nM - fm) : WGM;
        u.pm = fm + ((wgid % nig) % gsz); u.pn = (wgid % nig) / gsz; return true;
    }
    __device__ __forceinline__ void a_ready(const Unit&) const {}
    __device__ __forceinline__ void done(const Unit&) const {}
};

__device__ __forceinline__ unsigned cvt_pk_bf16(float lo, float hi) { unsigned r; asm volatile("v_cvt_pk_bf16_f32 %0, %1, %2" : "=v"(r) : "v"(lo), "v"(hi)); return r; }
__device__ __forceinline__ unsigned cvt_pk_f16(float lo, float hi) { const _Float16 a = (_Float16)lo, b = (_Float16)hi; return (unsigned)__builtin_bit_cast(unsigned short, a) | ((unsigned)__builtin_bit_cast(unsigned short, b) << 16); }
__device__ __forceinline__ float ep_sigmoid(float x) { return __builtin_amdgcn_rcpf(1.0f + __builtin_amdgcn_exp2f(-1.4426950408889634f * x)); }
__device__ __forceinline__ float ep_silu(float x) { return x * ep_sigmoid(x); }

struct EpiInProj {
    static constexpr bool PERM = true, AFTER_DRAIN = false;
    unsigned char* ws;
    __device__ __forceinline__ void operator()(const f32x4 (&acc)[2][2][4][2], const Unit& u, int wr, int wc, int fr, int fq) const {
        const int pn = u.pn, row0 = u.pm * BM + wr * 64 + fr;
        if (pn < 8 || (pn >= 16 && pn < 24)) {
            const size_t doff = pn < 8 ? WS_AQ + (size_t)(pn >> 2) * (16u << 20) : WS_RQ + (size_t)((pn - 16) >> 2) * (16u << 20);
            bf16_t* dst = (bf16_t*)(ws + doff); const float* R128 = (const float*)(ws + WS_ROPE128);
            const float sc = (pn < 4 || pn >= 20) ? 0.08838834764831845f : 1.0f;
            const int head = (pn & 3) * 2 + (wc >> 1), j0 = 32 * (wc & 1) + 8 * fq;
#pragma unroll
            for (int ai = 0; ai < 2; ++ai)
#pragma unroll
                for (int m = 0; m < 4; ++m) {
                    const int row = row0 + ai * HALF + m * 16;
                    const f32x4* tb = (const f32x4*)(R128 + ((size_t)row * 64 + j0) * 2);
                    const f32x4 t0 = tb[0], t1 = tb[1], t2 = tb[2], t3 = tb[3];
                    const f32x4 a0 = acc[ai][0][m][0], a1 = acc[ai][0][m][1], b0 = acc[ai][1][m][0], b1 = acc[ai][1][m][1];
                    u32x4 w1, w2;
                    w1.x = cvt_pk_bf16((a0[0] * t0[0] - b0[0] * t0[1]) * sc, (a0[1] * t0[2] - b0[1] * t0[3]) * sc);
                    w1.y = cvt_pk_bf16((a0[2] * t1[0] - b0[2] * t1[1]) * sc, (a0[3] * t1[2] - b0[3] * t1[3]) * sc);
                    w1.z = cvt_pk_bf16((a1[0] * t2[0] - b1[0] * t2[1]) * sc, (a1[1] * t2[2] - b1[1] * t2[3]) * sc);
                    w1.w = cvt_pk_bf16((a1[2] * t3[0] - b1[2] * t3[1]) * sc, (a1[3] * t3[2] - b1[3] * t3[3]) * sc);
                    w2.x = cvt_pk_bf16((b0[0] * t0[0] + a0[0] * t0[1]) * sc, (b0[1] * t0[2] + a0[1] * t0[3]) * sc);
                    w2.y = cvt_pk_bf16((b0[2] * t1[0] + a0[2] * t1[1]) * sc, (b0[3] * t1[2] + a0[3] * t1[3]) * sc);
                    w2.z = cvt_pk_bf16((b1[0] * t2[0] + a1[0] * t2[1]) * sc, (b1[1] * t2[2] + a1[1] * t2[3]) * sc);
                    w2.w = cvt_pk_bf16((b1[2] * t3[0] + a1[2] * t3[1]) * sc, (b1[3] * t3[2] + a1[3] * t3[3]) * sc);
                    bf16_t* o = dst + (size_t)row * 1024 + head * 128 + j0;
                    *(u32x4*)o = w1; *(u32x4*)(o + 64) = w2;
                }
        } else if ((pn >= 12 && pn < 16) || pn == 68) {
            const bool isq = pn != 68;
            if (isq || wc == 0) {
                unsigned short* dst = (unsigned short*)(ws + (isq ? WS_IQ : WS_IK)); const float* R64 = (const float*)(ws + WS_ROPE64); const int ld = isq ? 1024 : 64, hoff = isq ? ((pn - 12) * 4 + wc) * 64 : 0, j0 = 8 * fq;
                const float sc = isq ? 0.125f : 1.0f;
#pragma unroll
                for (int ai = 0; ai < 2; ++ai)
#pragma unroll
                    for (int m = 0; m < 4; ++m) {
                        const int row = row0 + ai * HALF + m * 16;
                        const f32x4* tb = (const f32x4*)(R64 + ((size_t)row * 32 + j0) * 2);
                        const f32x4 t0 = tb[0], t1 = tb[1], t2 = tb[2], t3 = tb[3];
                        const f32x4 a0 = acc[ai][0][m][0], a1 = acc[ai][0][m][1], b0 = acc[ai][1][m][0], b1 = acc[ai][1][m][1];
                        u32x4 w1, w2;
                        w1.x = cvt_pk_f16((a0[0] * t0[0] - b0[0] * t0[1]) * sc, (a0[1] * t0[2] - b0[1] * t0[3]) * sc);
                        w1.y = cvt_pk_f16((a0[2] * t1[0] - b0[2] * t1[1]) * sc, (a0[3] * t1[2] - b0[3] * t1[3]) * sc);
                        w1.z = cvt_pk_f16((a1[0] * t2[0] - b1[0] * t2[1]) * sc, (a1[1] * t2[2] - b1[1] * t2[3]) * sc);
                        w1.w = cvt_pk_f16((a1[2] * t3[0] - b1[2] * t3[1]) * sc, (a1[3] * t3[2] - b1[3] * t3[3]) * sc);
                        w2.x = cvt_pk_f16((b0[0] * t0[0] + a0[0] * t0[1]) * sc, (b0[1] * t0[2] + a0[1] * t0[3]) * sc);
                        w2.y = cvt_pk_f16((b0[2] * t1[0] + a0[2] * t1[1]) * sc, (b0[3] * t1[2] + a0[3] * t1[3]) * sc);
                        w2.z = cvt_pk_f16((b1[0] * t2[0] + a1[0] * t2[1]) * sc, (b1[1] * t2[2] + a1[1] * t2[3]) * sc);
                        w2.w = cvt_pk_f16((b1[2] * t3[0] + a1[2] * t3[1]) * sc, (b1[3] * t3[2] + a1[3] * t3[3]) * sc);
                        unsigned short* o = dst + (size_t)row * ld + hoff + j0;
                        *(u32x4*)o = w1; *(u32x4*)(o + 32) = w2;
                    }
            } else if (wc == 1 && fq < 2) {
#pragma unroll
                for (int ai = 0; ai < 2; ++ai)
#pragma unroll
                    for (int m = 0; m < 4; ++m) {
                        const int row = row0 + ai * HALF + m * 16;
                        float* o = (float*)(ws + WS_IW) + (size_t)row * 16 + 8 * fq;
                        *(f32x4*)o = acc[ai][0][m][0] * 0.25f; *(f32x4*)(o + 4) = acc[ai][0][m][1] * 0.25f;
                    }
            }
        } else {
            size_t doff; int ld, pl, act = 0, roff = 0; float sc = 1.0f;
            if (pn < 12) { doff = WS_AV; ld = 1024; pl = pn - 8; }
            else if (pn < 32) { doff = WS_RV; ld = 2048; pl = pn - 24; }
            else if (pn < 40) { doff = WS_RG; ld = 2048; pl = pn - 32; act = 1; }
            else if (pn < 44) { doff = WS_MQ; ld = 1024; pl = pn - 40; sc = 0.0625f; }
            else if (pn < 68) { doff = WS_GATES; ld = 6144; pl = pn - 44; act = 2; }
            else { doff = WS_MEMKV; ld = 2048; pl = pn - 69; roff = S; }
            bf16_t* dst = (bf16_t*)(ws + doff);
            const int col0 = pl * BM + wc * 32 + 8 * fq;
#pragma unroll
            for (int ai = 0; ai < 2; ++ai)
#pragma unroll
                for (int m = 0; m < 4; ++m) {
                    bf16_t* rowp = dst + (size_t)(row0 - roff + ai * HALF + m * 16) * ld + col0;
#pragma unroll
                    for (int bj = 0; bj < 2; ++bj) {
                        f32x4 v0 = acc[ai][bj][m][0], v1 = acc[ai][bj][m][1];
                        if (act == 1) { v0 = (f32x4){ep_silu(v0[0]), ep_silu(v0[1]), ep_silu(v0[2]), ep_silu(v0[3])}; v1 = (f32x4){ep_silu(v1[0]), ep_silu(v1[1]), ep_silu(v1[2]), ep_silu(v1[3])}; }
                        else if (act == 2) { v0 = (f32x4){ep_sigmoid(v0[0]), ep_sigmoid(v0[1]), ep_sigmoid(v0[2]), ep_sigmoid(v0[3])}; v1 = (f32x4){ep_sigmoid(v1[0]), ep_sigmoid(v1[1]), ep_sigmoid(v1[2]), ep_sigmoid(v1[3])}; }
                        else { v0 = v0 * sc; v1 = v1 * sc; }
                        u32x4 w; w.x = cvt_pk_bf16(v0[0], v0[1]); w.y = cvt_pk_bf16(v0[2], v0[3]); w.z = cvt_pk_bf16(v1[0], v1[1]); w.w = cvt_pk_bf16(v1[2], v1[3]);
                        *(u32x4*)(rowp + bj * HALF) = w;
                    }
                }
        }
    }
};

struct EpiGateAcc {
    static constexpr bool PERM = true, AFTER_DRAIN = false;
    float* F; bf16_t* OB; const bf16_t* G; int ldc, ldg, first, last;
    __device__ __forceinline__ void operator()(const f32x4 (&acc)[2][2][4][2], const Unit& u, int wr, int wc, int fr, int fq) const {
        const int row0 = u.pm * BM + wr * 64 + fr, col0 = u.pn * BM + wc * 32 + 8 * fq;
#pragma unroll
        for (int ai = 0; ai < 2; ++ai)
#pragma unroll
            for (int m = 0; m < 4; ++m) {
                const int row = row0 + ai * HALF + m * 16;
#pragma unroll
                for (int bj = 0; bj < 2; ++bj) {
                    const int col = col0 + bj * HALF;
                    const u32x4 gw = *(const u32x4*)(G + (size_t)row * ldg + col);
                    f32x4 g0, g1;
                    g0[0] = __uint_as_float(gw.x << 16); g0[1] = __uint_as_float(gw.x & 0xffff0000u); g0[2] = __uint_as_float(gw.y << 16); g0[3] = __uint_as_float(gw.y & 0xffff0000u);
                    g1[0] = __uint_as_float(gw.z << 16); g1[1] = __uint_as_float(gw.z & 0xffff0000u); g1[2] = __uint_as_float(gw.w << 16); g1[3] = __uint_as_float(gw.w & 0xffff0000u);
                    f32x4 v0 = acc[ai][bj][m][0] * g0, v1 = acc[ai][bj][m][1] * g1;
                    float* fp = F + (size_t)row * ldc + col;
                    if (!first) { v0 += *(const f32x4*)fp; v1 += *(const f32x4*)(fp + 4); }
                    if (last) { u32x4 w; w.x = cvt_pk_bf16(v0[0], v0[1]); w.y = cvt_pk_bf16(v0[2], v0[3]); w.z = cvt_pk_bf16(v1[0], v1[1]); w.w = cvt_pk_bf16(v1[2], v1[3]); *(u32x4*)(OB + (size_t)row * ldc + col) = w; }
                    else { *(f32x4*)fp = v0; *(f32x4*)(fp + 4) = v1; }
                }
            }
    }
};

struct EpiF32 {
    static constexpr bool PERM = true, AFTER_DRAIN = false;
    float* O; int ldc;
    __device__ __forceinline__ void operator()(const f32x4 (&acc)[2][2][4][2], const Unit& u, int wr, int wc, int fr, int fq) const {
        const int row0 = u.pm * BM + wr * 64 + fr, col0 = u.pn * BM + wc * 32 + 8 * fq;
#pragma unroll
        for (int ai = 0; ai < 2; ++ai)
#pragma unroll
            for (int m = 0; m < 4; ++m)
#pragma unroll
                for (int bj = 0; bj < 2; ++bj) { float* fp = O + (size_t)(row0 + ai * HALF + m * 16) * ldc + col0 + bj * HALF; *(f32x4*)fp = acc[ai][bj][m][0]; *(f32x4*)(fp + 4) = acc[ai][bj][m][1]; }
    }
};

struct EpiSwiGLU {
    static constexpr bool PERM = true, AFTER_DRAIN = false;
    bf16_t* O; int ldc;
    __device__ __forceinline__ void operator()(const f32x4 (&acc)[2][2][4][2], const Unit& u, int wr, int wc, int fr, int fq) const {
        const int row0 = u.pm * BM + wr * 64 + fr, col0 = u.pn * HALF + wc * 32 + 8 * fq;
#pragma unroll
        for (int ai = 0; ai < 2; ++ai)
#pragma unroll
            for (int m = 0; m < 4; ++m) {
                const f32x4 g0 = acc[ai][0][m][0], g1 = acc[ai][0][m][1], u0 = acc[ai][1][m][0], u1 = acc[ai][1][m][1];
                u32x4 w;
                w.x = cvt_pk_bf16(ep_silu(g0[0]) * u0[0], ep_silu(g0[1]) * u0[1]); w.y = cvt_pk_bf16(ep_silu(g0[2]) * u0[2], ep_silu(g0[3]) * u0[3]);
                w.z = cvt_pk_bf16(ep_silu(g1[0]) * u1[0], ep_silu(g1[1]) * u1[1]); w.w = cvt_pk_bf16(ep_silu(g1[2]) * u1[2], ep_silu(g1[3]) * u1[3]);
                *(u32x4*)(O + (size_t)(row0 + ai * HALF + m * 16) * ldc + col0) = w;
            }
    }
};

struct InProjOrder {
    StaticOrder so; int G, c;
    __device__ void init(int G_, int c_) { so.init(8192, 69 * 256, G_, c_); G = G_; c = c_; }
    __device__ bool next(int i, Unit& u) const {
        const long L = (long)i * G + c;
        if (L < so.nwg) return so.next(i, u);
        if (L < so.nwg + 8) { u.pm = 32; u.pn = 69 + (int)(L - so.nwg); return true; }
        return false;
    }
    __device__ __forceinline__ void a_ready(const Unit&) const {}
    __device__ __forceinline__ void done(const Unit&) const {}
};

template <class Epi, class Sched, bool ALIGN_EPI = false, bool SP2 = false>
__device__ __forceinline__ void gemm_phase(PG8_LAS unsigned char* lds, const Gemm g, const Sched& S, const Epi& E) {
    const int tid = threadIdx.x, wid = __builtin_amdgcn_readfirstlane(tid >> 6), lane = tid & 63, wr = wid >> 2, wc = wid & 3, fr = lane & 15, fq = lane >> 4;
    const int K = g.K, nt = K / BK;
    unsigned voffA[2], voffB[2];
#pragma unroll
    for (int i = 0; i < 2; ++i) { int R, C; stage_rc(tid * 16 + i * 8192, R, C); const int Rb = Epi::PERM ? ((R & ~31) + perm32(R & 31)) : R;
        voffA[i] = (unsigned)(R * K + C) * 2u; voffB[i] = (unsigned)(Rb * K + C) * 2u; }
    const size_t kstep = (size_t)(BK * 2);
    const size_t hstep = (size_t)HALF * K * 2;
    const size_t tstep = 2 * hstep;
    const unsigned ldsw = (unsigned)wid * 1024u;
    const int aoff = lds_byte(wr * 64 + fr, fq * 8), boff = lds_byte(wc * 32 + fr, fq * 8);
#define PG8_SA(b, h) (((b) * 2 + (h)) * HTB)
#define PG8_SB(b, h) ((4 + (b) * 2 + (h)) * HTB)
#define PG8_STAGE(bufoff, gbase, voff) do { _Pragma("unroll") for (int _i = 0; _i < 2; ++_i) \
        __builtin_amdgcn_global_load_lds((const unsigned*)((const char*)(gbase) + (voff)[_i]), (PG8_LAS unsigned*)(lds + (bufoff) + ldsw + _i * 8192), 16, 0, 0); } while (0)
#define PG8_LDA(dst, b, h) do { _Pragma("unroll") for (int m = 0; m < 4; ++m) _Pragma("unroll") for (int k = 0; k < 2; ++k) dst[m][k] = *(const PG8_LAS bf16x8*)(lds + PG8_SA(b, h) + aoff + m * 2048 + k * 1024); } while (0)
#define PG8_LDB(dst, b, h) do { _Pragma("unroll") for (int n = 0; n < 2; ++n) _Pragma("unroll") for (int k = 0; k < 2; ++k) dst[n][k] = *(const PG8_LAS bf16x8*)(lds + PG8_SB(b, h) + boff + n * 2048 + k * 1024); } while (0)
#define PG8_MMA(ai, bj, At, Bt) do { __builtin_amdgcn_s_setprio(1); _Pragma("unroll") for (int m = 0; m < 4; ++m) _Pragma("unroll") for (int n = 0; n < 2; ++n) _Pragma("unroll") for (int k = 0; k < 2; ++k) \
        acc[ai][bj][m][n] = __builtin_amdgcn_mfma_f32_16x16x32_bf16(Bt[n][k], At[m][k], acc[ai][bj][m][n], 0, 0, 0); __builtin_amdgcn_s_setprio(0); } while (0)
#define PG8_WAIT_V(n) asm volatile("s_waitcnt vmcnt(" #n ")" ::: "memory")
#define PG8_WAIT_L(n) asm volatile("s_waitcnt lgkmcnt(" #n ")" ::: "memory")
#define PG8_BAR __builtin_amdgcn_s_barrier()
#define PG8_SCHED __builtin_amdgcn_sched_barrier(0)
    Unit cur, nxt; int ui = 0;
    if (!S.next(0, cur)) return;
    f32x4 acc[2][2][4][2];
#pragma unroll
    for (int a = 0; a < 2; ++a)
#pragma unroll
        for (int b = 0; b < 2; ++b)
#pragma unroll
            for (int m = 0; m < 4; ++m)
#pragma unroll
                for (int n = 0; n < 2; ++n) acc[a][b][m][n] = (f32x4){0.f, 0.f, 0.f, 0.f};
    bf16x8 At[4][2], B0[2][2], B1[2][2];
    const char* cA = (const char*)g.A + (size_t)cur.pm * tstep; const char* cB = (const char*)g.Bt + (size_t)cur.pn * tstep;
    S.a_ready(cur);
    if constexpr (SP2) {
        PG8_STAGE(PG8_SB(0, 0), cB, voffB); PG8_STAGE(PG8_SB(0, 1), cB + hstep, voffB); PG8_STAGE(PG8_SA(0, 0), cA, voffA); PG8_STAGE(PG8_SA(0, 1), cA + hstep, voffA);
        if (wr == 1) PG8_BAR;
        PG8_WAIT_V(2); PG8_BAR;
        PG8_STAGE(PG8_SB(1, 0), cB + kstep, voffB); PG8_STAGE(PG8_SA(1, 0), cA + kstep, voffA); PG8_STAGE(PG8_SB(1, 1), cB + hstep + kstep, voffB);
        PG8_WAIT_V(6); PG8_BAR;
    } else {
        PG8_STAGE(PG8_SB(0, 0), cB, voffB); PG8_STAGE(PG8_SA(0, 0), cA, voffA); PG8_STAGE(PG8_SB(0, 1), cB + hstep, voffB); PG8_STAGE(PG8_SA(0, 1), cA + hstep, voffA);
        if (wr == 1) PG8_BAR;
        PG8_WAIT_V(4); PG8_BAR;
        PG8_STAGE(PG8_SB(1, 0), cB + kstep, voffB); PG8_STAGE(PG8_SA(1, 0), cA + kstep, voffA); PG8_STAGE(PG8_SB(1, 1), cB + hstep + kstep, voffB);
        PG8_WAIT_V(6); PG8_BAR;
    }
    for (;;) {
        const bool has_next = S.next(ui + 1, nxt);
        const char* nA = has_next ? (const char*)g.A + (size_t)nxt.pm * tstep : cA; const char* nB = has_next ? (const char*)g.Bt + (size_t)nxt.pn * tstep : cB;
        for (int t = 0; t < nt; t += 2) {
            const bool last = (t == nt - 2);
            const char* a1 = cA + (size_t)(t + 1) * kstep;
            const char* a2 = last ? nA : cA + (size_t)(t + 2) * kstep; const char* b2 = last ? nB : cB + (size_t)(t + 2) * kstep;
            const char* a3 = a2 + kstep; const char* b3 = b2 + kstep;
            if (last && has_next) S.a_ready(nxt);
            if constexpr (SP2) {
            PG8_LDB(B0, 0, 0); PG8_LDB(B1, 0, 1); PG8_SCHED; PG8_LDA(At, 0, 0); PG8_STAGE(PG8_SA(1, 1), a1 + hstep, voffA);
            PG8_WAIT_V(8); PG8_WAIT_L(0); PG8_BAR; PG8_MMA(0, 0, At, B0); PG8_MMA(0, 1, At, B1); PG8_BAR; PG8_SCHED;
            PG8_LDA(At, 0, 1); PG8_STAGE(PG8_SB(0, 0), b2, voffB); PG8_STAGE(PG8_SB(0, 1), b2 + hstep, voffB); PG8_STAGE(PG8_SA(0, 0), a2, voffA);
            PG8_WAIT_V(8); PG8_WAIT_L(0); PG8_BAR; PG8_MMA(1, 0, At, B0); PG8_MMA(1, 1, At, B1); PG8_BAR; PG8_SCHED;
            PG8_LDB(B0, 1, 0); PG8_LDB(B1, 1, 1); PG8_SCHED; PG8_LDA(At, 1, 0); PG8_STAGE(PG8_SA(0, 1), a2 + hstep, voffA);
            PG8_WAIT_V(8); PG8_WAIT_L(0); PG8_BAR; PG8_MMA(0, 0, At, B0); PG8_MMA(0, 1, At, B1); PG8_BAR; PG8_SCHED;
            PG8_LDA(At, 1, 1); PG8_STAGE(PG8_SB(1, 0), b3, voffB); PG8_STAGE(PG8_SB(1, 1), b3 + hstep, voffB); PG8_STAGE(PG8_SA(1, 0), a3, voffA);
            PG8_WAIT_V(8); PG8_WAIT_L(0); PG8_BAR; PG8_MMA(1, 0, At, B0); PG8_MMA(1, 1, At, B1); PG8_BAR; PG8_SCHED;
            } else {
            PG8_LDB(B0, 0, 0); PG8_SCHED; PG8_LDA(At, 0, 0); PG8_STAGE(PG8_SA(1, 1), a1 + hstep, voffA);
            PG8_WAIT_L(8); PG8_BAR; PG8_WAIT_L(0); PG8_MMA(0, 0, At, B0); PG8_BAR; PG8_SCHED;
            PG8_LDB(B1, 0, 1); PG8_STAGE(PG8_SB(0, 0), b2, voffB);
            PG8_BAR; PG8_WAIT_L(0); PG8_MMA(0, 1, At, B1); PG8_BAR;
            PG8_LDA(At, 0, 1); PG8_STAGE(PG8_SA(0, 0), a2, voffA);
            PG8_BAR; PG8_WAIT_L(0); PG8_MMA(1, 0, At, B0); PG8_BAR; PG8_SCHED;
            PG8_STAGE(PG8_SB(0, 1), b2 + hstep, voffB);
            PG8_WAIT_V(6); PG8_BAR; PG8_MMA(1, 1, At, B1); PG8_BAR;
            PG8_LDB(B0, 1, 0); PG8_SCHED; PG8_LDA(At, 1, 0); PG8_STAGE(PG8_SA(0, 1), a2 + hstep, voffA);
            PG8_WAIT_L(8); PG8_BAR; PG8_WAIT_L(0); PG8_MMA(0, 0, At, B0); PG8_BAR; PG8_SCHED;
            PG8_LDB(B1, 1, 1); PG8_STAGE(PG8_SB(1, 0), b3, voffB);
            PG8_BAR; PG8_WAIT_L(0); PG8_MMA(0, 1, At, B1); PG8_BAR;
            PG8_LDA(At, 1, 1); PG8_STAGE(PG8_SA(1, 0), a3, voffA);
            PG8_BAR; PG8_WAIT_L(0); PG8_MMA(1, 0, At, B0); PG8_BAR; PG8_SCHED;
            PG8_STAGE(PG8_SB(1, 1), b3 + hstep, voffB);
            PG8_WAIT_V(6); PG8_BAR; PG8_MMA(1, 1, At, B1); PG8_BAR;
            }
        }
        if constexpr (ALIGN_EPI) { if (wr == 0) PG8_BAR; }
        if constexpr (!Epi::AFTER_DRAIN) { E(acc, cur, wr, wc, fr, fq); S.done(cur); }
        if (!has_next) break;
#pragma unroll
        for (int a = 0; a < 2; ++a)
#pragma unroll
            for (int b = 0; b < 2; ++b)
#pragma unroll
                for (int m = 0; m < 4; ++m)
#pragma unroll
                    for (int n = 0; n < 2; ++n) acc[a][b][m][n] = (f32x4){0.f, 0.f, 0.f, 0.f};
        cur = nxt; cA = nA; cB = nB; ++ui;
        if constexpr (ALIGN_EPI) { if (wr == 1) PG8_BAR; }
    }
    PG8_WAIT_V(0);
    if constexpr (!ALIGN_EPI) { if (wr == 0) PG8_BAR; }
    PG8_BAR;
    if constexpr (Epi::AFTER_DRAIN) { E.fused(acc, cur, wr, wc, fr, fq, lds, wid, lane); S.done(cur); }
#undef PG8_SA
#undef PG8_SB
#undef PG8_STAGE
#undef PG8_LDA
#undef PG8_LDB
#undef PG8_MMA
#undef PG8_WAIT_V
#undef PG8_WAIT_L
#undef PG8_BAR
#undef PG8_SCHED
}
}

constexpr int RING_OFF = 0, RING_BYTES = 131072;
constexpr int LDSCTL_OFF = RING_BYTES, MISC_OFF = LDSCTL_OFF + 320;
constexpr int LDS_BYTES = 147456;
constexpr int CW_BAR = 4096;

typedef GAS unsigned gu32;
#define LDS_WAIT() asm volatile("s_waitcnt lgkmcnt(0)" ::: "memory")
#define XB_TMO      128
#define XB_XCNT(j)  (256  + 64 * (j))
#define XB_XSUB(j)  (1280 + 64 * (j))
#define XB_XGEN(j)  (2304 + 64 * (j))
#define XB_TOP      3328
#define XB_TOPGEN   3392
#define XCD_BAR_WORDS 3456
#define XB_SPIN_CAP (1u << 18)

__device__ __forceinline__ unsigned xb_ld(unsigned* p)              { return __hip_atomic_load(p, __ATOMIC_RELAXED, __HIP_MEMORY_SCOPE_AGENT); }
__device__ __forceinline__ unsigned xb_add(unsigned* p, unsigned v) { return __hip_atomic_fetch_add(p, v, __ATOMIC_RELAXED, __HIP_MEMORY_SCOPE_AGENT); }
__device__ __forceinline__ unsigned xb_xcc_id() { return (unsigned)__builtin_amdgcn_s_getreg((3 << 11) | 20) & 0xFu; }
#define XB_SPIN(cond, bar) do { unsigned _sp = 0; while (cond) { __builtin_amdgcn_s_sleep(1); \
    if ((++_sp & 255u) == 0u) { if (xb_ld(&(bar)[XB_TMO])) break; if (_sp > XB_SPIN_CAP) { atomicAdd(&(bar)[XB_TMO], 1u); break; } } } } while (0)

struct XcdBarrier {
    unsigned* bar; unsigned x;
    volatile LAS unsigned* st;
};

__device__ __forceinline__ XcdBarrier xcd_barrier_post(unsigned* bar, volatile LAS unsigned* st) {
    XcdBarrier b; b.bar = bar; b.x = xb_xcc_id(); b.st = st;
    if (threadIdx.x == 0) (void)xb_add(&bar[XB_XCNT(b.x)], 1u);
    return b;
}
__device__ __forceinline__ void xcd_barrier_complete(unsigned* bar, unsigned x, unsigned& nloc, unsigned& nx) {
    const unsigned G = gridDim.x * gridDim.y * gridDim.z;
    unsigned sum, cnt, mine, sp = 0u;
    for (;;) {
        sum = 0u; cnt = 0u; mine = 0u;
#pragma unroll
        for (unsigned j = 0; j < 16; ++j) { const unsigned c = xb_ld(&bar[XB_XCNT(j)]); sum += c; cnt += (c > 0u) ? 1u : 0u; mine = (j == x) ? c : mine; }
        if (sum == G) break;
        __builtin_amdgcn_s_sleep(1);
        if ((++sp & 255u) == 0u) { if (xb_ld(&bar[XB_TMO])) break; if (sp > XB_SPIN_CAP) { atomicAdd(&bar[XB_TMO], 1u); break; } }
    }
    nloc = mine > 0u ? mine : 1u; nx = cnt > 0u ? cnt : 1u;
}

__device__ __forceinline__ void xcd_barrier(const XcdBarrier& b) {
    asm volatile("s_waitcnt vmcnt(0)" ::: "memory");
    __syncthreads();
    if (threadIdx.x == 0) {
        unsigned* bar = b.bar;
        __builtin_amdgcn_s_waitcnt(0);
        unsigned nloc = b.st[0], nx = b.st[1];
        if (nloc == 0u) { xcd_barrier_complete(bar, b.x, nloc, nx); b.st[0] = nloc; b.st[1] = nx; }
        const unsigned old = xb_add(&bar[XB_XSUB(b.x)], 1u);
        const unsigned gen = old / nloc;
        if (old + 1u == (gen + 1u) * nloc) {
            __builtin_amdgcn_fence(__ATOMIC_RELEASE, "agent");
            asm volatile("s_waitcnt vmcnt(0)" ::: "memory");
            const unsigned og = xb_add(&bar[XB_TOP], 1u);
            const unsigned tg = og / nx;
            if (og + 1u == (tg + 1u) * nx) xb_add(&bar[XB_TOPGEN], 1u);
            else XB_SPIN(xb_ld(&bar[XB_TOPGEN]) == tg, bar);
            __builtin_amdgcn_fence(__ATOMIC_ACQUIRE, "agent");
            xb_add(&bar[XB_XGEN(b.x)], 1u);
            asm volatile("s_waitcnt vmcnt(0)" ::: "memory");
        } else {
            XB_SPIN(xb_ld(&bar[XB_XGEN(b.x)]) == gen, bar);
            __builtin_amdgcn_fence(__ATOMIC_ACQUIRE, "agent");
            asm volatile("s_waitcnt vmcnt(0)" ::: "memory");
        }
    }
    __syncthreads();
}

__device__ __forceinline__ int map_inproj(int np) {
    const int pn = np >> 8, p = np & 255, bj = p >> 7, q = p & 127;
    if (pn < 8 || (pn >= 16 && pn < 24)) { const int base = pn < 4 ? C_AQ : pn < 8 ? C_AK : pn < 20 ? C_RQ : C_RK; return base + ((pn & 3) * 2 + (q >> 6)) * 128 + bj * 64 + (q & 63); }
    if (pn >= 12 && pn < 16) return C_IQ + ((pn - 12) * 4 + (q >> 5)) * 64 + bj * 32 + (q & 31);
    if (pn == 68) { if (p < 32) return C_IK + p; if (p < 48) return C_IW + (p - 32); if (p >= 128 && p < 160) return C_IK + 32 + (p - 128); return -1; }
    int base, pl;
    if (pn < 12) { base = C_AV; pl = pn - 8; } else if (pn < 32) { base = C_RV; pl = pn - 24; } else if (pn < 40) { base = C_RG; pl = pn - 32; } else if (pn < 44) { base = C_MQ; pl = pn - 40; } else { base = C_GT; pl = pn - 44; }
    return base + pl * 256 + p;
}
__device__ __forceinline__ int map_ffin(int np) { return ((np >> 7) & 1) * DFF + (np >> 8) * 128 + (np & 127); }
template <int MAP> __device__ __forceinline__ void p0_transpose_item(const float* W, int K, int Nsrc, int Ndst, bf16_t* WT, LAS float* scr, int item, int lane) {
    const int nblk = Ndst / 32, kb = item / nblk, nb = item % nblk, k0 = 64 * kb, n0 = 32 * nb;
    const int np = n0 + (lane & 31);
    const int sc = MAP == 0 ? np : MAP == 1 ? map_inproj(np) : map_ffin(np);
#pragma unroll 8
    for (int i = 0; i < 32; ++i) { const int kk = 2 * i + (lane >> 5); scr[kk * 33 + (lane & 31)] = sc >= 0 ? W[(size_t)(k0 + kk) * Nsrc + sc] : 0.f; }
    LDS_WAIT(); asm volatile("" ::: "memory");
    const int c = lane & 7;
#pragma unroll
    for (int j = 0; j < 4; ++j) { const int n = (lane >> 3) + 8 * j; const LAS float* s = scr + (8 * c) * 33 + n;
        uint4 o; o.x = pk2(s[0 * 33], s[1 * 33]); o.y = pk2(s[2 * 33], s[3 * 33]); o.z = pk2(s[4 * 33], s[5 * 33]); o.w = pk2(s[6 * 33], s[7 * 33]);
        *(uint4*)(WT + (size_t)(n0 + n) * K + k0 + 8 * c) = o; }
    LDS_WAIT(); asm volatile("" ::: "memory");
}
__device__ __forceinline__ void rms_row_to_bf16(const float* src, const float* g, bf16_t* dst, int lane) {
    float v[32]; float ss = 0.f;
#pragma unroll
    for (int j = 0; j < 8; ++j) { const float4 t = *(const float4*)(src + j * 256 + lane * 4); v[4 * j] = t.x; v[4 * j + 1] = t.y; v[4 * j + 2] = t.z; v[4 * j + 3] = t.w; ss += t.x * t.x + t.y * t.y + t.z * t.z + t.w * t.w; }
    ss = wave_sum(ss);
    const float rs = rsqrtf(ss * (1.0f / D) + EPS);
#pragma unroll
    for (int j = 0; j < 8; ++j) { const float4 gg = *(const float4*)(g + j * 256 + lane * 4);
        uint2 o; o.x = pk2(v[4 * j] * rs * gg.x, v[4 * j + 1] * rs * gg.y); o.y = pk2(v[4 * j + 2] * rs * gg.z, v[4 * j + 3] * rs * gg.w);
        *(uint2*)(dst + j * 256 + lane * 4) = o; }
}

struct Ptrs {
    const float *x, *mem; const int* pos; const float *g_pre_mix, *g_mem, *w_in, *w_mem_kv, *w_a, *w_b, *w_c, *w_out, *g_post_mix, *g_pre_ffn, *w_ffn_in, *w_ffn_out, *g_post_ffn;
    float* out; unsigned char* ws;
};

__device__ __forceinline__ void p0_prologue(const Ptrs& P, LAS unsigned char* lds, int G) {
    const int tid = threadIdx.x, lane = tid & 63, wave = __builtin_amdgcn_readfirstlane(tid >> 6);
    LAS float* scr = (LAS float*)(lds + RING_OFF + wave * 16384);
    const int gw = blockIdx.x * NWAVES + wave, NGW = G * NWAVES;
    unsigned char* ws = P.ws;
    constexpr int I_IN = (D / 64) * (NP_IN / 32), I_MK = (D / 64) * (2048 / 32), I_A = (AW / 64) * (D / 32), I_B = (RVW / 64) * (D / 32), I_C = (MW / 64) * (D / 32), I_O = (D / 64) * (D / 32),
                  I_FI = (D / 64) * (2 * DFF / 32), I_FO = (DFF / 64) * (D / 32);
    constexpr int NITEMS = I_IN + I_MK + I_A + I_B + I_C + I_O + I_FI + I_FO;
    for (int it = gw; it < NITEMS; it += NGW) {
        int r = it;
        if (r < I_IN) { p0_transpose_item<1>(P.w_in, D, INC, NP_IN, (bf16_t*)(ws + WS_WIN), scr, r, lane); continue; } r -= I_IN;
        if (r < I_MK) { p0_transpose_item<0>(P.w_mem_kv, D, 2048, 2048, (bf16_t*)(ws + WS_WMEMKV), scr, r, lane); continue; } r -= I_MK;
        if (r < I_A) { p0_transpose_item<0>(P.w_a, AW, D, D, (bf16_t*)(ws + WS_WA), scr, r, lane); continue; } r -= I_A;
        if (r < I_B) { p0_transpose_item<0>(P.w_b, RVW, D, D, (bf16_t*)(ws + WS_WB), scr, r, lane); continue; } r -= I_B;
        if (r < I_C) { p0_transpose_item<0>(P.w_c, MW, D, D, (bf16_t*)(ws + WS_WC), scr, r, lane); continue; } r -= I_C;
        if (r < I_O) { p0_transpose_item<0>(P.w_out, D, D, D, (bf16_t*)(ws + WS_WOUT), scr, r, lane); continue; } r -= I_O;
        if (r < I_FI) { p0_transpose_item<2>(P.w_ffn_in, D, 2 * DFF, 2 * DFF, (bf16_t*)(ws + WS_WFFIN), scr, r, lane); continue; } r -= I_FI;
        p0_transpose_item<0>(P.w_ffn_out, DFF, D, D, (bf16_t*)(ws + WS_WFFOUT), scr, r, lane);
    }
    for (int r = gw; r < S + NMEM; r += NGW) {
        if (r < S) rms_row_to_bf16(P.x + (size_t)r * D, P.g_pre_mix, (bf16_t*)(ws + WS_XN) + (size_t)r * D, lane);
        else rms_row_to_bf16(P.mem + (size_t)(r - S) * D, P.g_mem, (bf16_t*)(ws + WS_MEMN) + (size_t)(r - S) * D, lane);
    }
    float* R128 = (float*)(ws + WS_ROPE128); float* R64 = (float*)(ws + WS_ROPE64);
    for (int i = blockIdx.x * NT + tid; i < S * 64; i += G * NT) {
        const int s = i >> 6, j = i & 63;
        const float ang = (float)P.pos[s] * (float)ROPE_FREQ[j];
        float sn, cs; sincos_d((double)ang, sn, cs);
        *(float2*)(R128 + 2 * i) = make_float2(cs, sn);
        if ((j & 1) == 0) { const int i2 = s * 32 + (j >> 1); *(float2*)(R64 + 2 * i2) = make_float2(cs, sn); }
    }
}

__device__ __forceinline__ unsigned ordkey(float f) { const unsigned u = __float_as_uint(f); return (u & 0x80000000u) ? ~u : (u | 0x80000000u); }
__device__ __forceinline__ float ret_loggamma(int h) { return log1pf(-exp2f(-5.0f - (float)h)); }

__device__ __forceinline__ void naive_index(const Ptrs& P, unsigned char* lds, int t) {
    float* q = (float*)lds; float* w = q + NIH * IDXD; unsigned* keys = (unsigned*)(w + 16); int* red = (int*)(keys + S);
    const f16_t* IQ = (const f16_t*)(P.ws + WS_IQ); const f16_t* IK = (const f16_t*)(P.ws + WS_IK); const float* IW = (const float*)(P.ws + WS_IW); unsigned* MASK = (unsigned*)(P.ws + WS_MASK);
    const int tid = threadIdx.x, lane = tid & 63, wv = tid >> 6;
    __syncthreads();
    for (int i = tid; i < NIH * IDXD; i += NT) q[i] = (float)IQ[(size_t)t * (NIH * IDXD) + i];
    if (tid < NIH) w[tid] = IW[(size_t)t * NIH + tid];
    __syncthreads();
    const int n = t + 1;
    for (int k = tid; k < n; k += NT) {
        float kk[IDXD];
        const f16_t* kp = IK + (size_t)k * IDXD;
#pragma unroll
        for (int d = 0; d < IDXD; ++d) kk[d] = (float)kp[d];
        float sc = 0.f;
        for (int h = 0; h < NIH; ++h) {
            float x = 0.f;
#pragma unroll
            for (int d = 0; d < IDXD; ++d) x = fmaf(q[h * IDXD + d], kk[d], x);
            sc = fmaf(fmaxf(x, 0.f), w[h], sc);
        }
        keys[k] = ordkey(sc);
    }
    __syncthreads();
    unsigned tau = 0u;
    if (n > 256) {
        for (int b = 31; b >= 0; --b) {
            const unsigned cand = tau | (1u << b);
            int c = 0;
            for (int k = tid; k < n; k += NT) c += (keys[k] >= cand) ? 1 : 0;
#pragma unroll
            for (int o = 1; o < 64; o <<= 1) c += __shfl_xor(c, o);
            __syncthreads();
            if (lane == 0) red[wv] = c;
            __syncthreads();
            int tot = 0;
#pragma unroll
            for (int i = 0; i < NWAVES; ++i) tot += red[i];
            if (tot >= 256) tau = cand;
        }
    }
    for (int k0 = 0; k0 < S; k0 += NT) {
        const int k = k0 + tid;
        const bool sel = (k < n) && (keys[k] >= tau);
        const unsigned long long b = __ballot(sel);
        if (lane == 0) { MASK[(size_t)t * 256 + (k >> 5)] = (unsigned)b; MASK[(size_t)t * 256 + (k >> 5) + 1] = (unsigned)(b >> 32); }
    }
}

constexpr int MAXSEL = 512;
__device__ __forceinline__ void naive_attn(const Ptrs& P, unsigned char* lds, int t) {
    float* q = (float*)lds; int* idx = (int*)(q + AW); float* lg = (float*)(idx + MAXSEL); int* wcnt = (int*)(lg + 8 * MAXSEL); int* nsel_s = wcnt + 256;
    const bf16_t* AQ = (const bf16_t*)(P.ws + WS_AQ); const bf16_t* AK = (const bf16_t*)(P.ws + WS_AK); const bf16_t* AV = (const bf16_t*)(P.ws + WS_AV);
    const unsigned* MASK = (const unsigned*)(P.ws + WS_MASK); bf16_t* OA = (bf16_t*)(P.ws + WS_OA);
    const int tid = threadIdx.x, lane = tid & 63, wv = tid >> 6;
    __syncthreads();
    for (int i = tid; i < AW; i += NT) q[i] = bf2f(AQ[(size_t)t * AW + i]);
    unsigned mw = 0u;
    if (tid < 256) { mw = MASK[(size_t)t * 256 + tid]; wcnt[tid] = __popc(mw); }
    __syncthreads();
    if (tid == 0) { int a = 0; for (int i = 0; i < 256; ++i) { const int c = wcnt[i]; wcnt[i] = a; a += c; } nsel_s[0] = a; }
    __syncthreads();
    if (tid < 256) { int pos = wcnt[tid]; unsigned m = mw; while (m) { const int b = __ffs(m) - 1; m &= m - 1; if (pos < MAXSEL) idx[pos] = tid * 32 + b; ++pos; } }
    __syncthreads();
    const int nsel = min(nsel_s[0], MAXSEL);
    for (int j = tid; j < nsel; j += NT) {
        const bf16_t* kp = AK + (size_t)idx[j] * AW;
        for (int h = 0; h < 8; ++h) {
            float a = 0.f;
            for (int d = 0; d < 128; d += 8) {
                const uint4 raw = *(const uint4*)(kp + h * 128 + d);
                const unsigned ww[4] = {raw.x, raw.y, raw.z, raw.w};
#pragma unroll
                for (int e = 0; e < 4; ++e) { a = fmaf(q[h * 128 + d + 2 * e], __uint_as_float(ww[e] << 16), a); a = fmaf(q[h * 128 + d + 2 * e + 1], __uint_as_float(ww[e] & 0xffff0000u), a); }
            }
            lg[h * MAXSEL + j] = a;
        }
    }
    __syncthreads();
    {
        const int h = wv;
        float m = -INFINITY;
        for (int j = lane; j < nsel; j += 64) m = fmaxf(m, lg[h * MAXSEL + j]);
        m = wave_max(m);
        float s = 0.f;
        for (int j = lane; j < nsel; j += 64) { const float e = __expf(lg[h * MAXSEL + j] - m); lg[h * MAXSEL + j] = e; s += e; }
        s = wave_sum(s);
        const float inv = 1.0f / s;
        for (int j = lane; j < nsel; j += 64) lg[h * MAXSEL + j] *= inv;
    }
    __syncthreads();
    for (int c = tid; c < AW; c += NT) {
        const int h = c >> 7;
        float a = 0.f;
        for (int j = 0; j < nsel; ++j) a = fmaf(lg[h * MAXSEL + j], bf2f(AV[(size_t)idx[j] * AW + c]), a);
        OA[(size_t)t * AW + c] = f2bf(a);
    }
}

__device__ __forceinline__ void naive_ret_kv(const Ptrs& P, unsigned char* lds, int task) {
    float* ks = (float*)lds;
    const bf16_t* RK = (const bf16_t*)(P.ws + WS_RK); const bf16_t* RV = (const bf16_t*)(P.ws + WS_RV); float* KVS = (float*)(P.ws + WS_KVS);
    const int tid = threadIdx.x, nh = task >> 2, blk = task & 3, n = nh >> 3, h = nh & 7, e = tid & 255, dsub = tid >> 8;
    const float lgm = ret_loggamma(h);
    __syncthreads();
    for (int i = tid; i < 2 * 128 * 16; i += NT) { const int ds = i >> 11, j = (i >> 4) & 127, dd = i & 15; ks[i] = bf2f(RK[(size_t)(n * 128 + j) * RQK + h * 128 + (blk * 2 + ds) * 16 + dd]) * __expf((float)(127 - j) * lgm); }
    __syncthreads();
    float acc[16];
#pragma unroll
    for (int dd = 0; dd < 16; ++dd) acc[dd] = 0.f;
    const float* kss = ks + dsub * 2048;
    for (int j = 0; j < 128; ++j) {
        const float v = bf2f(RV[(size_t)(n * 128 + j) * RVW + h * 256 + e]);
#pragma unroll
        for (int dd = 0; dd < 16; ++dd) acc[dd] = fmaf(kss[j * 16 + dd], v, acc[dd]);
    }
    const int d0 = (blk * 2 + dsub) * 16;
#pragma unroll
    for (int dd = 0; dd < 16; ++dd) KVS[(((size_t)n * 8 + h) * 128 + d0 + dd) * 256 + e] = acc[dd];
}
__device__ __forceinline__ void naive_ret_scan(const Ptrs& P, int task) {
    const float* KVS = (const float*)(P.ws + WS_KVS); bf16_t* PREV = (bf16_t*)(P.ws + WS_PREV);
    const int i = task * NT + threadIdx.x, h = i >> 15;
    const float cd = __expf(128.0f * ret_loggamma(h));
    float st = 0.f;
    for (int n = 0; n < 64; ++n) { const size_t o = (size_t)n * (8 * 128 * 256) + i; PREV[o] = f2bf(st); st = st * cd + KVS[o]; }
}
__device__ __forceinline__ void naive_ret_out(const Ptrs& P, unsigned char* lds, int nh) {
    float* sc = (float*)lds; float* qs = sc + 128 * 128; float* red = qs + 128 * 128;
    const bf16_t* RQ = (const bf16_t*)(P.ws + WS_RQ); const bf16_t* RK = (const bf16_t*)(P.ws + WS_RK); const bf16_t* RV = (const bf16_t*)(P.ws + WS_RV); const bf16_t* RG = (const bf16_t*)(P.ws + WS_RG);
    const bf16_t* PREV = (const bf16_t*)(P.ws + WS_PREV); bf16_t* OB = (bf16_t*)(P.ws + WS_OB);
    const int tid = threadIdx.x, lane = tid & 63, wv = (tid >> 6) & 3, hf = tid >> 8, e = tid & 255, n = nh >> 3, h = nh & 7;
    const float lgm = ret_loggamma(h);
    __syncthreads();
    for (int i = tid; i < 128 * 128; i += NT) { const int r = i >> 7, d = i & 127; qs[i] = bf2f(RQ[(size_t)(n * 128 + r) * RQK + h * 128 + d]); }
    __syncthreads();
    for (int idx = tid; idx < 128 * 128; idx += NT) {
        const int i = idx >> 7, j = idx & 127;
        float a = 0.f;
        if (j <= i) {
            const bf16_t* kp = RK + (size_t)(n * 128 + j) * RQK + h * 128;
            for (int d = 0; d < 128; ++d) a = fmaf(qs[i * 128 + d], bf2f(kp[d]), a);
            a *= __expf((float)(i - j) * lgm);
        }
        sc[idx] = a;
    }
    __syncthreads();
    const bf16_t* pv = PREV + (((size_t)n * 8 + h) * 128) * 256 + e;
    for (int ii = 0; ii < 64; ++ii) {
        const int i = 2 * ii + hf;
        float inner = 0.f;
        for (int j = 0; j <= i; ++j) inner = fmaf(sc[i * 128 + j], bf2f(RV[(size_t)(n * 128 + j) * RVW + h * 256 + e]), inner);
        float cross = 0.f;
        for (int d = 0; d < 128; ++d) cross = fmaf(qs[i * 128 + d], bf2f(pv[(size_t)d * 256]), cross);
        const float y = inner + cross * __expf((float)(i + 1) * lgm);
        const float s1 = wave_sum(y);
        __syncthreads();
        if (lane == 0) red[hf * 4 + wv] = s1;
        __syncthreads();
        const float mu = (red[hf * 4] + red[hf * 4 + 1] + red[hf * 4 + 2] + red[hf * 4 + 3]) * (1.0f / 256.0f);
        const float dv = y - mu;
        const float s2 = wave_sum(dv * dv);
        __syncthreads();
        if (lane == 0) red[hf * 4 + wv] = s2;
        __syncthreads();
        const float var = (red[hf * 4] + red[hf * 4 + 1] + red[hf * 4 + 2] + red[hf * 4 + 3]) * (1.0f / 256.0f);
        const float yn = dv * rsqrtf(var + EPS);
        const size_t o = (size_t)(n * 128 + i) * RVW + h * 256 + e;
        OB[o] = f2bf(bf2f(RG[o]) * yn);
    }
}
__device__ __forceinline__ void naive_memattn(const Ptrs& P, unsigned char* lds, int task) {
    float* q = (float*)lds; float* p = q + 2 * MW; float* red = p + 2 * 4 * 256;
    const bf16_t* MQ = (const bf16_t*)(P.ws + WS_MQ); const bf16_t* MEMKV = (const bf16_t*)(P.ws + WS_MEMKV); bf16_t* OC = (bf16_t*)(P.ws + WS_OC);
    const int tid = threadIdx.x, lane = tid & 63, wv = (tid >> 6) & 3, hf = tid >> 8, m_ = tid & 255, t = 2 * task + hf;
    __syncthreads();
    for (int i = m_; i < MW; i += 256) q[hf * MW + i] = bf2f(MQ[(size_t)t * MW + i]);
    __syncthreads();
    const bf16_t* kp = MEMKV + (size_t)m_ * 2048;
    float lg[4];
    for (int h = 0; h < 4; ++h) { float a = 0.f; for (int d = 0; d < 256; ++d) a = fmaf(q[hf * MW + h * 256 + d], bf2f(kp[h * 256 + d]), a); lg[h] = a; }
    for (int h = 0; h < 4; ++h) {
        float m = wave_max(lg[h]);
        __syncthreads(); if (lane == 0) red[hf * 4 + wv] = m; __syncthreads();
        m = fmaxf(fmaxf(red[hf * 4], red[hf * 4 + 1]), fmaxf(red[hf * 4 + 2], red[hf * 4 + 3]));
        const float ex = __expf(lg[h] - m);
        float s = wave_sum(ex);
        __syncthreads(); if (lane == 0) red[hf * 4 + wv] = s; __syncthreads();
        s = red[hf * 4] + red[hf * 4 + 1] + red[hf * 4 + 2] + red[hf * 4 + 3];
        p[(hf * 4 + h) * 256 + m_] = ex / s;
    }
    __syncthreads();
    for (int c = m_; c < MW; c += 256) {
        const int h = c >> 8;
        float a = 0.f;
        for (int m = 0; m < 256; ++m) a = fmaf(p[(hf * 4 + h) * 256 + m], bf2f(MEMKV[(size_t)m * 2048 + 1024 + c]), a);
        OC[(size_t)t * MW + c] = f2bf(a);
    }
}
__device__ __forceinline__ void resnorm_row(const float* xin, const float* y, const float* g1, const float* g2, float* out, bf16_t* h2, int r, int lane) {
    float yv[32], xv[32]; float ss = 0.f;
#pragma unroll
    for (int j = 0; j < 8; ++j) { const float4 t = *(const float4*)(y + (size_t)r * D + j * 256 + lane * 4); yv[4 * j] = t.x; yv[4 * j + 1] = t.y; yv[4 * j + 2] = t.z; yv[4 * j + 3] = t.w; ss += t.x * t.x + t.y * t.y + t.z * t.z + t.w * t.w; }
    ss = wave_sum(ss);
    const float rs = rsqrtf(ss * (1.0f / D) + EPS);
    float s2 = 0.f;
#pragma unroll
    for (int j = 0; j < 8; ++j) {
        const float4 xx = *(const float4*)(xin + (size_t)r * D + j * 256 + lane * 4);
        const float4 gg = *(const float4*)(g1 + j * 256 + lane * 4);
        xv[4 * j] = xx.x + yv[4 * j] * rs * gg.x; xv[4 * j + 1] = xx.y + yv[4 * j + 1] * rs * gg.y; xv[4 * j + 2] = xx.z + yv[4 * j + 2] * rs * gg.z; xv[4 * j + 3] = xx.w + yv[4 * j + 3] * rs * gg.w;
        s2 += xv[4 * j] * xv[4 * j] + xv[4 * j + 1] * xv[4 * j + 1] + xv[4 * j + 2] * xv[4 * j + 2] + xv[4 * j + 3] * xv[4 * j + 3];
        *(float4*)(out + (size_t)r * D + j * 256 + lane * 4) = make_float4(xv[4 * j], xv[4 * j + 1], xv[4 * j + 2], xv[4 * j + 3]);
    }
    if (h2) {
        s2 = wave_sum(s2);
        const float r2 = rsqrtf(s2 * (1.0f / D) + EPS);
#pragma unroll
        for (int j = 0; j < 8; ++j) { const float4 gg = *(const float4*)(g2 + j * 256 + lane * 4);
            uint2 o; o.x = pk2(xv[4 * j] * r2 * gg.x, xv[4 * j + 1] * r2 * gg.y); o.y = pk2(xv[4 * j + 2] * r2 * gg.z, xv[4 * j + 3] * r2 * gg.w);
            *(uint2*)(h2 + (size_t)r * D + j * 256 + lane * 4) = o; }
    }
}

#ifndef MK_PER_PHASE
#define MK_PER_PHASE 0
#endif
constexpr int N_PHASES = 11;
struct Args { Ptrs p; int ph_lo, ph_hi; };
__global__ void __launch_bounds__(NT, 2) mk_fwd(Args args) {
    extern __shared__ __attribute__((aligned(16))) unsigned char lds_raw[];
    LAS unsigned char* lds = (LAS unsigned char*)lds_raw;
    const Ptrs& P = args.p;
    const int tid = threadIdx.x, lane = tid & 63, wave = __builtin_amdgcn_readfirstlane(tid >> 6), G = gridDim.x;
    unsigned char* ws = P.ws;
    for (int u = tid; u < (LDS_BYTES - LDSCTL_OFF) / 4; u += NT) ((LAS unsigned*)(lds + LDSCTL_OFF))[u] = 0u;
    __syncthreads();
    XcdBarrier bar; bar.bar = (unsigned*)(ws + WS_CTL) + CW_BAR; bar.x = 0; bar.st = nullptr;
    if (!MK_PER_PHASE) bar = xcd_barrier_post((unsigned*)(ws + WS_CTL) + CW_BAR, (volatile LAS unsigned*)(lds + MISC_OFF) + 8);
    const int lo = args.ph_lo, hi = args.ph_hi;
#define IN(k) (lo <= (k) && (k) < hi)
#define SEAM(k) do { if (IN(k) && IN((k) + 1)) xcd_barrier(bar); } while (0)
    bf16_t* XN = (bf16_t*)(ws + WS_XN);

    if (IN(0)) { p0_prologue(P, lds, G); }
    SEAM(0);
    if (IN(1)) {
        pg8::Gemm g{XN, (const bf16_t*)(ws + WS_WIN), S + NMEM, NP_IN + 2048, D}; pg8::InProjOrder O; O.init(G, (int)blockIdx.x);
        pg8::EpiInProj E{ws};
        pg8::gemm_phase<pg8::EpiInProj, pg8::InProjOrder, true, true>(lds + RING_OFF, g, O, E);
    }
    SEAM(1);
    if (IN(2)) {
        const int NTASK = S + 2048 + S / 2;
        for (int task = blockIdx.x; task < NTASK; task += G) {
            if (task < S) naive_index(P, lds_raw, S - 1 - task);
            else if (task < S + 2048) naive_ret_kv(P, lds_raw, task - S);
            else naive_memattn(P, lds_raw, task - S - 2048);
        }
    }
    SEAM(2);
    if (IN(3)) {
        const int NTASK = S + 512;
        for (int task = blockIdx.x; task < NTASK; task += G) {
            if (task < S) naive_attn(P, lds_raw, S - 1 - task);
            else naive_ret_scan(P, task - S);
        }
    }
    SEAM(3);
    if (IN(4)) { for (int task = blockIdx.x; task < 512; task += G) naive_ret_out(P, lds_raw, task); }
    SEAM(4);
    if (IN(5)) {
        __syncthreads();
        pg8::StaticOrder O; O.init(S, D, G, (int)blockIdx.x);
        { pg8::Gemm g{(const bf16_t*)(ws + WS_OB), (const bf16_t*)(ws + WS_WB), S, D, RVW};
          pg8::EpiGateAcc E{(float*)(ws + WS_MIXED), (bf16_t*)(ws + WS_MIXEDB), (const bf16_t*)(ws + WS_GATES) + D, D, 3 * D, 1, 0};
          pg8::gemm_phase<pg8::EpiGateAcc, pg8::StaticOrder, false, true>(lds + RING_OFF, g, O, E); }
        { pg8::Gemm g{(const bf16_t*)(ws + WS_OA), (const bf16_t*)(ws + WS_WA), S, D, AW};
          pg8::EpiGateAcc E{(float*)(ws + WS_MIXED), (bf16_t*)(ws + WS_MIXEDB), (const bf16_t*)(ws + WS_GATES), D, 3 * D, 0, 0};
          pg8::gemm_phase<pg8::EpiGateAcc, pg8::StaticOrder, false, true>(lds + RING_OFF, g, O, E); }
        { pg8::Gemm g{(const bf16_t*)(ws + WS_OC), (const bf16_t*)(ws + WS_WC), S, D, MW};
          pg8::EpiGateAcc E{(float*)(ws + WS_MIXED), (bf16_t*)(ws + WS_MIXEDB), (const bf16_t*)(ws + WS_GATES) + 2 * D, D, 3 * D, 0, 1};
          pg8::gemm_phase<pg8::EpiGateAcc, pg8::StaticOrder, false, true>(lds + RING_OFF, g, O, E); }
    }
    SEAM(5);
    if (IN(6)) {
        pg8::Gemm g{(const bf16_t*)(ws + WS_MIXEDB), (const bf16_t*)(ws + WS_WOUT), S, D, D}; pg8::StaticOrder O; O.init(S, D, G, (int)blockIdx.x);
        pg8::EpiF32 E{(float*)(ws + WS_Y), D};
        pg8::gemm_phase<pg8::EpiF32, pg8::StaticOrder, false, true>(lds + RING_OFF, g, O, E);
    }
    SEAM(6);
    if (IN(7)) { for (int r = blockIdx.x * NWAVES + wave; r < S; r += G * NWAVES) resnorm_row(P.x, (const float*)(ws + WS_Y), P.g_post_mix, P.g_pre_ffn, P.out, XN, r, lane); }
    SEAM(7);
    if (IN(8)) {
        pg8::Gemm g{XN, (const bf16_t*)(ws + WS_WFFIN), S, 2 * DFF, D}; pg8::StaticOrder O; O.init(S, 2 * DFF, G, (int)blockIdx.x);
        pg8::EpiSwiGLU E{(bf16_t*)(ws + WS_ACT), DFF};
        pg8::gemm_phase<pg8::EpiSwiGLU, pg8::StaticOrder, true, true>(lds + RING_OFF, g, O, E);
    }
    SEAM(8);
    if (IN(9)) {
        pg8::Gemm g{(const bf16_t*)(ws + WS_ACT), (const bf16_t*)(ws + WS_WFFOUT), S, D, DFF}; pg8::StaticOrder O; O.init(S, D, G, (int)blockIdx.x);
        pg8::EpiF32 E{(float*)(ws + WS_Y), D};
        pg8::gemm_phase<pg8::EpiF32, pg8::StaticOrder, false, true>(lds + RING_OFF, g, O, E);
    }
    SEAM(9);
    if (IN(10)) { for (int r = blockIdx.x * NWAVES + wave; r < S; r += G * NWAVES) resnorm_row(P.out, (const float*)(ws + WS_Y), P.g_post_ffn, nullptr, P.out, nullptr, r, lane); }
#undef IN
#undef SEAM
}

extern "C" void kernel_launch(void* const* d_in, const int* in_sizes, int n_in, void* d_out, int out_size, void* d_ws, size_t ws_size, hipStream_t stream) {
    static int grid = 0;
    if (grid == 0) {
        if (n_in != 16 || in_sizes[0] != S * D || out_size != S * D || ws_size < WS_END) { fprintf(stderr, "kernel_launch: unexpected shapes (n_in %d, ws %zu); nothing launched\n", n_in, ws_size); grid = -1; return; }
        int dev = 0, cus = 0, per_cu = 0;
        if (hipGetDevice(&dev) != hipSuccess || hipDeviceGetAttribute(&cus, hipDeviceAttributeMultiprocessorCount, dev) != hipSuccess) { grid = -1; return; }
        if (hipFuncSetAttribute((const void*)mk_fwd, hipFuncAttributeMaxDynamicSharedMemorySize, LDS_BYTES) != hipSuccess) { fprintf(stderr, "kernel_launch: hipFuncSetAttribute failed\n"); grid = -1; return; }
        if (hipOccupancyMaxActiveBlocksPerMultiprocessor(&per_cu, (const void*)mk_fwd, NT, LDS_BYTES) != hipSuccess || per_cu < 1) { fprintf(stderr, "kernel_launch: occupancy query says %d blocks per CU; nothing launched\n", per_cu); grid = -1; return; }
        (void)hipGetLastError();
        grid = cus;
    }
    if (grid < 0) return;
    if (hipMemsetAsync((char*)d_ws + WS_CTL, 0, CTL_ZERO_BYTES, stream) != hipSuccess) return;
    Args a{};
    a.p.x = (const float*)d_in[0]; a.p.mem = (const float*)d_in[1]; a.p.pos = (const int*)d_in[2]; a.p.g_pre_mix = (const float*)d_in[3]; a.p.g_mem = (const float*)d_in[4];
    a.p.w_in = (const float*)d_in[5]; a.p.w_mem_kv = (const float*)d_in[6]; a.p.w_a = (const float*)d_in[7]; a.p.w_b = (const float*)d_in[8]; a.p.w_c = (const float*)d_in[9];
    a.p.w_out = (const float*)d_in[10]; a.p.g_post_mix = (const float*)d_in[11]; a.p.g_pre_ffn = (const float*)d_in[12]; a.p.w_ffn_in = (const float*)d_in[13]; a.p.w_ffn_out = (const float*)d_in[14];
    a.p.g_post_ffn = (const float*)d_in[15]; a.p.out = (float*)d_out; a.p.ws = (unsigned char*)d_ws;
#if MK_PER_PHASE
    for (int ph = 0; ph < N_PHASES; ++ph) { a.ph_lo = ph; a.ph_hi = ph + 1; hipLaunchKernelGGL(mk_fwd, dim3(grid), dim3(NT), LDS_BYTES, stream, a); }
#else
    a.ph_lo = 0; a.ph_hi = N_PHASES;
    hipLaunchKernelGGL(mk_fwd, dim3(grid), dim3(NT), LDS_BYTES, stream, a);
#endif
}
```

```cpp
#include <hip/hip_runtime.h>
#include <cstdio>
#include <cstdint>


typedef unsigned short bf16_t;
typedef _Float16 f16_t;
#define LAS __attribute__((address_space(3)))
#define GAS __attribute__((address_space(1)))
constexpr int S = 8192, D = 2048, NMEM = 256;
constexpr int AW = 1024, IQW = 1024, IDXD = 64, NIH = 16, RQK = 1024, RVW = 2048, MW = 1024;
constexpr int INC = 17488, DFF = 5632;
constexpr int C_AQ = 0, C_AK = 1024, C_AV = 2048, C_IQ = 3072, C_IK = 4096, C_IW = 4160, C_RQ = 4176, C_RK = 5200, C_RV = 6224, C_RG = 8272, C_MQ = 10320, C_GT = 11344;
static_assert(C_GT + 3 * D == INC, "cols");
constexpr float EPS = 1e-6f;
constexpr int NP_IN = 69 * 256;
constexpr int NWAVES = 8, NT = NWAVES * 64;

constexpr size_t MiB = 1u << 20;
constexpr size_t WS_CTL = 0, CTL_ZERO_BYTES = 1 * MiB;
constexpr size_t WS_WIN = 2 * MiB, WS_WMEMKV = 71 * MiB, WS_WA = 79 * MiB, WS_WB = 83 * MiB, WS_WC = 91 * MiB, WS_WOUT = 95 * MiB, WS_WFFIN = 103 * MiB, WS_WFFOUT = 147 * MiB;
constexpr size_t WS_XN = 169 * MiB, WS_MEMN = 201 * MiB, WS_ROPE128 = 202 * MiB, WS_ROPE64 = 206 * MiB;
constexpr size_t WS_AQ = 208 * MiB, WS_AK = 224 * MiB, WS_AV = 240 * MiB, WS_IQ = 256 * MiB, WS_RQ = 272 * MiB, WS_RK = 288 * MiB, WS_MQ = 304 * MiB;
constexpr size_t WS_RV = 320 * MiB, WS_RG = 352 * MiB, WS_GATES = 384 * MiB;
constexpr size_t WS_IK = 480 * MiB, WS_IW = 481 * MiB, WS_MEMK = 482 * MiB, WS_MVT = 483 * MiB, WS_MASK = 484 * MiB, WS_PREV = 492 * MiB, WS_RKT = 524 * MiB;
constexpr size_t WS_AVT = 240 * MiB;
constexpr size_t WS_RVT = 320 * MiB;
constexpr size_t WS_OA = WS_IQ, WS_OC = WS_MQ, WS_OB = WS_RG;
constexpr size_t WS_KVS = 2 * MiB;
constexpr size_t WS_MIXED = 2 * MiB, WS_MIXEDB = 208 * MiB, WS_Y = 272 * MiB, WS_ACT = 384 * MiB;
constexpr size_t WS_END = 540 * MiB;
static_assert(WS_WIN + (size_t)NP_IN * D * 2 == WS_WMEMKV, "in-proj and mem-kv weight copies must be contiguous");
static_assert(WS_XN + (size_t)S * D * 2 == WS_MEMN, "XN and MEMN must be contiguous");

__device__ __forceinline__ float bf2f(bf16_t b) { return __uint_as_float(((unsigned)b) << 16); }
__device__ __forceinline__ bf16_t f2bf(float f) { unsigned u = __float_as_uint(f); return (bf16_t)((u + 0x7fffu + ((u >> 16) & 1u)) >> 16); }
__device__ __forceinline__ unsigned pk2(float lo, float hi) { return (unsigned)f2bf(lo) | ((unsigned)f2bf(hi) << 16); }
__device__ __forceinline__ unsigned pkh2(float lo, float hi) { const f16_t a = (f16_t)lo, b = (f16_t)hi; return (unsigned)__builtin_bit_cast(unsigned short, a) | ((unsigned)__builtin_bit_cast(unsigned short, b) << 16); }
__device__ __forceinline__ float wave_sum(float v) {
#pragma unroll
    for (int o = 1; o < 64; o <<= 1) v += __shfl_xor(v, o);
    return v;
}
__device__ __forceinline__ float wave_max(float v) {
#pragma unroll
    for (int o = 1; o < 64; o <<= 1) v = fmaxf(v, __shfl_xor(v, o));
    return v;
}
__device__ __forceinline__ float sigmoidf_(float x) { return 1.0f / (1.0f + __expf(-x)); }
__device__ __forceinline__ float siluf_(float x) { return x / (1.0f + __expf(-x)); }

__constant__ double ROPE_FREQ[64] = {1.0, 0.8659643233600653, 0.7498942093324559, 0.6493816315762113, 0.5623413251903491, 0.4869675251658631, 0.4216965034285822, 0.3651741272548377, 0.31622776601683794, 0.27384196342643613, 0.23713737056616552, 0.2053525026457146, 0.1778279410038923, 0.1539926526059492, 0.1333521432163324, 0.11547819846894582, 0.1, 0.08659643233600653, 0.07498942093324558, 0.06493816315762113, 0.05623413251903491, 0.04869675251658631, 0.042169650342858224, 0.03651741272548377, 0.03162277660168379, 0.027384196342643614, 0.023713737056616554, 0.02053525026457146, 0.01778279410038923, 0.01539926526059492, 0.01333521432163324, 0.011547819846894581, 0.01, 0.008659643233600654, 0.007498942093324558, 0.006493816315762113, 0.005623413251903491, 0.004869675251658631, 0.004216965034285823, 0.003651741272548377, 0.0031622776601683794, 0.0027384196342643613, 0.0023713737056616554, 0.002053525026457146, 0.0017782794100389228, 0.001539926526059492, 0.001333521432163324, 0.0011547819846894581, 0.001, 0.0008659643233600654, 0.0007498942093324559, 0.0006493816315762113, 0.0005623413251903491, 0.0004869675251658631, 0.00042169650342858224, 0.0003651741272548377, 0.00031622776601683794, 0.0002738419634264361, 0.00023713737056616554, 0.0002053525026457146, 0.00017782794100389227, 0.0001539926526059492, 0.0001333521432163324, 0.00011547819846894582};

__device__ __forceinline__ void sincos_d(double a, float& s, float& c) {
    const double n = rint(a * 0.63661977236758134308);
    double r = fma(-n, 1.57079632679489655800, a);
    r = fma(-n, 6.12323399573676603587e-17, r);
    const double r2 = r * r;
    double sp = -7.6471637318198164759e-13;
    sp = fma(sp, r2, 1.6059043836821614599e-10); sp = fma(sp, r2, -2.5052108385441718775e-08); sp = fma(sp, r2, 2.7557319223985890653e-06);
    sp = fma(sp, r2, -1.9841269841269841270e-04); sp = fma(sp, r2, 8.3333333333333333333e-03); sp = fma(sp, r2, -1.6666666666666666667e-01);
    const double sn = fma(sp * r2, r, r);
    double cp = 4.7794773323873852974e-14;
    cp = fma(cp, r2, -1.1470745597729724714e-11); cp = fma(cp, r2, 2.0876756987868098979e-09); cp = fma(cp, r2, -2.7557319223985890653e-07);
    cp = fma(cp, r2, 2.4801587301587301587e-05); cp = fma(cp, r2, -1.3888888888888888889e-03); cp = fma(cp, r2, 4.1666666666666666667e-02); cp = fma(cp, r2, -0.5);
    const double cs = fma(cp, r2, 1.0);
    const int q = ((int)n) & 3;
    const double ss = (q == 0) ? sn : (q == 1) ? cs : (q == 2) ? -sn : -cs;
    const double cc = (q == 0) ? cs : (q == 1) ? -sn : (q == 2) ? -cs : sn;
    s = (float)ss; c = (float)cc;
}
namespace pg8 {
#define PG8_LAS __attribute__((address_space(3)))
typedef unsigned short bf16_t;
typedef short bf16x8 __attribute__((ext_vector_type(8)));
typedef float f32x4 __attribute__((ext_vector_type(4)));
typedef unsigned u32x4 __attribute__((ext_vector_type(4)));
constexpr int BM = 256, BK = 64, HALF = 128, HTB = HALF * BK * 2  , STAGE_BYTES = 8 * HTB, NXCD = 8, WGM = 8;

__host__ __device__ __forceinline__ int lds_byte(int r, int c) { const int st = (r >> 4) * 2 + (c >> 5), rr = r & 15, cc = c & 31, ob = rr * 64 + cc * 2; return st * 1024 + (ob ^ (((ob >> 9) & 1) << 5)); }
__host__ __device__ __forceinline__ void stage_rc(int b, int& R, int& C) { const int st = b / 1024, sb = b % 1024, swz = sb ^ (((sb >> 9) & 1) << 5); R = (st >> 1) * 16 + swz / 64; C = (st & 1) * 32 + (swz % 64) / 2; }
__host__ __device__ __forceinline__ int perm32(int rho) { const int n = rho >> 4, i = rho & 15; return 8 * (i >> 2) + 4 * n + (i & 3); }

struct Unit { int pm, pn; };
struct Gemm { const bf16_t* A; const bf16_t* Bt; int M, N, K; };

struct StaticOrder {
    int nM, nN, nwg, G, c;
    __host__ __device__ void init(int M, int N, int G_, int c_) { nM = M / BM; nN = N / BM; nwg = nM * nN; G = G_; c = c_; }
    __host__ __device__ bool next(int i, Unit& u) const {
        const long L = (long)i * G + c; if (L >= nwg) return false;
        int wgid = (int)L; { const int q = nwg / NXCD, r = nwg % NXCD, xcd = wgid % NXCD, off = wgid / NXCD; wgid = (xcd < r ? xcd * (q + 1) : r * (q + 1) + (xcd - r) * q) + off; }
        const int nig = WGM * nN, gid = wgid / nig, fm = gid * WGM, gsz = (nM - fm) < WGM ? (nM - fm) : WGM;
        u.pm = fm + ((wgid % nig) % gsz); u.pn = (wgid % nig) / gsz; return true;
    }
    __device__ __forceinline__ void a_ready(const Unit&) const {}
    __device__ __forceinline__ void done(const Unit&) const {}
};

__device__ __forceinline__ unsigned cvt_pk_bf16(float lo, float hi) { unsigned r; asm volatile("v_cvt_pk_bf16_f32 %0, %1, %2" : "=v"(r) : "v"(lo), "v"(hi)); return r; }
__device__ __forceinline__ unsigned cvt_pk_f16(float lo, float hi) { const _Float16 a = (_Float16)lo, b = (_Float16)hi; return (unsigned)__builtin_bit_cast(unsigned short, a) | ((unsigned)__builtin_bit_cast(unsigned short, b) << 16); }
__device__ __forceinline__ bf16_t f2bf_dev(float f) { unsigned u = __float_as_uint(f); return (bf16_t)((u + 0x7fffu + ((u >> 16) & 1u)) >> 16); }
__device__ __forceinline__ int tokperm(int s) { return (s & ~12) | ((s & 4) << 1) | ((s & 8) >> 1); }
__device__ __forceinline__ float ret_l2gamma(int h) { return log1pf(-exp2f(-5.0f - (float)h)) * 1.4426950408889634f; }
__device__ __forceinline__ float ep_sigmoid(float x) { return __builtin_amdgcn_rcpf(1.0f + __builtin_amdgcn_exp2f(-1.4426950408889634f * x)); }
__device__ __forceinline__ float ep_silu(float x) { return x * ep_sigmoid(x); }

struct EpiInProj {
    static constexpr bool PERM = true, AFTER_DRAIN = false;
    unsigned char* ws;
    __device__ __forceinline__ void operator()(const f32x4 (&acc)[2][2][4][2], const Unit& u, int wr, int wc, int fr, int fq) const {
        const int pn = u.pn, row0 = u.pm * BM + wr * 64 + fr;
        if (pn < 8 || (pn >= 16 && pn < 24)) {
            const size_t doff = pn < 8 ? WS_AQ + (size_t)(pn >> 2) * (16u << 20) : WS_RQ + (size_t)((pn - 16) >> 2) * (16u << 20);
            bf16_t* dst = (bf16_t*)(ws + doff); const float* R128 = (const float*)(ws + WS_ROPE128);
            const float sc0 = pn < 4 ? 0.08838834764831845f * 1.4426950408889634f : pn >= 20 ? 0.08838834764831845f : 1.0f;
            const int head = (pn & 3) * 2 + (wc >> 1), j0 = 32 * (wc & 1) + 8 * fq;
            const bool isrq = pn >= 16 && pn < 20, isrk = pn >= 20;
            const float l2g = ret_l2gamma(head);
#pragma unroll
            for (int ai = 0; ai < 2; ++ai)
#pragma unroll
                for (int m = 0; m < 4; ++m) {
                    const int row = row0 + ai * HALF + m * 16;
                    const f32x4* tb = (const f32x4*)(R128 + ((size_t)row * 64 + j0) * 2);
                    const f32x4 t0 = tb[0], t1 = tb[1], t2 = tb[2], t3 = tb[3];
                    const f32x4 a0 = acc[ai][0][m][0], a1 = acc[ai][0][m][1], b0 = acc[ai][1][m][0], b1 = acc[ai][1][m][1];
                    float y1[8], y2[8];
                    y1[0] = a0[0] * t0[0] - b0[0] * t0[1]; y1[1] = a0[1] * t0[2] - b0[1] * t0[3]; y1[2] = a0[2] * t1[0] - b0[2] * t1[1]; y1[3] = a0[3] * t1[2] - b0[3] * t1[3];
                    y1[4] = a1[0] * t2[0] - b1[0] * t2[1]; y1[5] = a1[1] * t2[2] - b1[1] * t2[3]; y1[6] = a1[2] * t3[0] - b1[2] * t3[1]; y1[7] = a1[3] * t3[2] - b1[3] * t3[3];
                    y2[0] = b0[0] * t0[0] + a0[0] * t0[1]; y2[1] = b0[1] * t0[2] + a0[1] * t0[3]; y2[2] = b0[2] * t1[0] + a0[2] * t1[1]; y2[3] = b0[3] * t1[2] + a0[3] * t1[3];
                    y2[4] = b1[0] * t2[0] + a1[0] * t2[1]; y2[5] = b1[1] * t2[2] + a1[1] * t2[3]; y2[6] = b1[2] * t3[0] + a1[2] * t3[1]; y2[7] = b1[3] * t3[2] + a1[3] * t3[3];
                    const float fi = (float)(row & 127);
                    const float sc = isrq ? __builtin_amdgcn_exp2f(fi * l2g) : isrk ? sc0 * __builtin_amdgcn_exp2f(-fi * l2g) : sc0;
                    u32x4 w1, w2;
                    w1.x = cvt_pk_bf16(y1[0] * sc, y1[1] * sc); w1.y = cvt_pk_bf16(y1[2] * sc, y1[3] * sc); w1.z = cvt_pk_bf16(y1[4] * sc, y1[5] * sc); w1.w = cvt_pk_bf16(y1[6] * sc, y1[7] * sc);
                    w2.x = cvt_pk_bf16(y2[0] * sc, y2[1] * sc); w2.y = cvt_pk_bf16(y2[2] * sc, y2[3] * sc); w2.z = cvt_pk_bf16(y2[4] * sc, y2[5] * sc); w2.w = cvt_pk_bf16(y2[6] * sc, y2[7] * sc);
                    bf16_t* o = dst + (size_t)row * 1024 + head * 128 + j0;
                    *(u32x4*)o = w1; *(u32x4*)(o + 64) = w2;
                    if (isrk) {
                        const float kt = sc0 * __builtin_amdgcn_exp2f((127.0f - fi) * l2g);
                        bf16_t* tp = (bf16_t*)(ws + WS_RKT) + ((size_t)head * 128 + j0) * S + tokperm(row);
#pragma unroll
                        for (int e = 0; e < 8; ++e) { tp[(size_t)e * S] = f2bf_dev(y1[e] * kt); tp[(size_t)(64 + e) * S] = f2bf_dev(y2[e] * kt); }
                    }
                }
        } else if ((pn >= 12 && pn < 16) || pn == 68) {
            const bool isq = pn != 68;
            if (isq || wc == 0) {
                unsigned short* dst = (unsigned short*)(ws + (isq ? WS_IQ : WS_IK)); const float* R64 = (const float*)(ws + WS_ROPE64); const int ld = isq ? 1024 : 64, hoff = isq ? ((pn - 12) * 4 + wc) * 64 : 0, j0 = 8 * fq;
                const float sc = isq ? 0.125f : 1.0f;
#pragma unroll
                for (int ai = 0; ai < 2; ++ai)
#pragma unroll
                    for (int m = 0; m < 4; ++m) {
                        const int row = row0 + ai * HALF + m * 16;
                        const f32x4* tb = (const f32x4*)(R64 + ((size_t)row * 32 + j0) * 2);
                        const f32x4 t0 = tb[0], t1 = tb[1], t2 = tb[2], t3 = tb[3];
                        const f32x4 a0 = acc[ai][0][m][0], a1 = acc[ai][0][m][1], b0 = acc[ai][1][m][0], b1 = acc[ai][1][m][1];
                        u32x4 w1, w2;
                        w1.x = cvt_pk_f16((a0[0] * t0[0] - b0[0] * t0[1]) * sc, (a0[1] * t0[2] - b0[1] * t0[3]) * sc);
                        w1.y = cvt_pk_f16((a0[2] * t1[0] - b0[2] * t1[1]) * sc, (a0[3] * t1[2] - b0[3] * t1[3]) * sc);
                        w1.z = cvt_pk_f16((a1[0] * t2[0] - b1[0] * t2[1]) * sc, (a1[1] * t2[2] - b1[1] * t2[3]) * sc);
                        w1.w = cvt_pk_f16((a1[2] * t3[0] - b1[2] * t3[1]) * sc, (a1[3] * t3[2] - b1[3] * t3[3]) * sc);
                        w2.x = cvt_pk_f16((b0[0] * t0[0] + a0[0] * t0[1]) * sc, (b0[1] * t0[2] + a0[1] * t0[3]) * sc);
                        w2.y = cvt_pk_f16((b0[2] * t1[0] + a0[2] * t1[1]) * sc, (b0[3] * t1[2] + a0[3] * t1[3]) * sc);
                        w2.z = cvt_pk_f16((b1[0] * t2[0] + a1[0] * t2[1]) * sc, (b1[1] * t2[2] + a1[1] * t2[3]) * sc);
                        w2.w = cvt_pk_f16((b1[2] * t3[0] + a1[2] * t3[1]) * sc, (b1[3] * t3[2] + a1[3] * t3[3]) * sc);
                        unsigned short* o = dst + (size_t)row * ld + hoff + j0;
                        *(u32x4*)o = w1; *(u32x4*)(o + 32) = w2;
                    }
            } else if (wc == 1 && fq < 2) {
#pragma unroll
                for (int ai = 0; ai < 2; ++ai)
#pragma unroll
                    for (int m = 0; m < 4; ++m) {
                        const int row = row0 + ai * HALF + m * 16;
                        float* o = (float*)(ws + WS_IW) + (size_t)row * 16 + 8 * fq;
                        *(f32x4*)o = acc[ai][0][m][0] * 0.25f; *(f32x4*)(o + 4) = acc[ai][0][m][1] * 0.25f;
                    }
            }
        } else {
            size_t doff; int ld, pl, act = 0, roff = 0, tr = 0, tld = S; float sc = 1.0f;
            if (pn < 12) { doff = WS_AVT; ld = 1024; pl = pn - 8; tr = 1; }
            else if (pn < 32) { doff = WS_RVT; ld = 2048; pl = pn - 24; tr = 1; }
            else if (pn < 40) { doff = WS_RG; ld = 2048; pl = pn - 32; act = 1; }
            else if (pn < 44) { doff = WS_MQ; ld = 1024; pl = pn - 40; sc = 0.0625f * 1.4426950408889634f; }
            else if (pn < 68) { doff = WS_GATES; ld = 6144; pl = pn - 44; act = 2; }
            else if (pn < 73) { doff = WS_MEMK; ld = 1024; pl = pn - 69; roff = S; }
            else { doff = WS_MVT; ld = 1024; pl = pn - 73; roff = S; tr = 1; tld = NMEM; }
            bf16_t* dst = (bf16_t*)(ws + doff);
            const int col0 = pl * BM + wc * 32 + 8 * fq;
            if (tr) {
#pragma unroll
                for (int ai = 0; ai < 2; ++ai)
#pragma unroll
                    for (int m = 0; m < 4; ++m) {
                        const int row = row0 - roff + ai * HALF + m * 16;
                        bf16_t* tp = dst + (size_t)col0 * tld + tokperm(row);
#pragma unroll
                        for (int bj = 0; bj < 2; ++bj) {
                            const f32x4 v0 = acc[ai][bj][m][0], v1 = acc[ai][bj][m][1];
#pragma unroll
                            for (int e = 0; e < 4; ++e) { tp[(size_t)(bj * HALF + e) * tld] = f2bf_dev(v0[e]); tp[(size_t)(bj * HALF + 4 + e) * tld] = f2bf_dev(v1[e]); }
                        }
                    }
                return;
            }
#pragma unroll
            for (int ai = 0; ai < 2; ++ai)
#pragma unroll
                for (int m = 0; m < 4; ++m) {
                    bf16_t* rowp = dst + (size_t)(row0 - roff + ai * HALF + m * 16) * ld + col0;
#pragma unroll
                    for (int bj = 0; bj < 2; ++bj) {
                        f32x4 v0 = acc[ai][bj][m][0], v1 = acc[ai][bj][m][1];
                        if (act == 1) { v0 = (f32x4){ep_silu(v0[0]), ep_silu(v0[1]), ep_silu(v0[2]), ep_silu(v0[3])}; v1 = (f32x4){ep_silu(v1[0]), ep_silu(v1[1]), ep_silu(v1[2]), ep_silu(v1[3])}; }
                        else if (act == 2) { v0 = (f32x4){ep_sigmoid(v0[0]), ep_sigmoid(v0[1]), ep_sigmoid(v0[2]), ep_sigmoid(v0[3])}; v1 = (f32x4){ep_sigmoid(v1[0]), ep_sigmoid(v1[1]), ep_sigmoid(v1[2]), ep_sigmoid(v1[3])}; }
                        else { v0 = v0 * sc; v1 = v1 * sc; }
                        u32x4 w; w.x = cvt_pk_bf16(v0[0], v0[1]); w.y = cvt_pk_bf16(v0[2], v0[3]); w.z = cvt_pk_bf16(v1[0], v1[1]); w.w = cvt_pk_bf16(v1[2], v1[3]);
                        *(u32x4*)(rowp + bj * HALF) = w;
                    }
                }
        }
    }
};

struct EpiGateAcc {
    static constexpr bool PERM = true, AFTER_DRAIN = false;
    float* F; bf16_t* OB; const bf16_t* G; int ldc, ldg, first, last;
    __device__ __forceinline__ void operator()(const f32x4 (&acc)[2][2][4][2], const Unit& u, int wr, int wc, int fr, int fq) const {
        const int row0 = u.pm * BM + wr * 64 + fr, col0 = u.pn * BM + wc * 32 + 8 * fq;
#pragma unroll
        for (int ai = 0; ai < 2; ++ai)
#pragma unroll
            for (int m = 0; m < 4; ++m) {
                const int row = row0 + ai * HALF + m * 16;
#pragma unroll
                for (int bj = 0; bj < 2; ++bj) {
                    const int col = col0 + bj * HALF;
                    const u32x4 gw = *(const u32x4*)(G + (size_t)row * ldg + col);
                    f32x4 g0, g1;
                    g0[0] = __uint_as_float(gw.x << 16); g0[1] = __uint_as_float(gw.x & 0xffff0000u); g0[2] = __uint_as_float(gw.y << 16); g0[3] = __uint_as_float(gw.y & 0xffff0000u);
                    g1[0] = __uint_as_float(gw.z << 16); g1[1] = __uint_as_float(gw.z & 0xffff0000u); g1[2] = __uint_as_float(gw.w << 16); g1[3] = __uint_as_float(gw.w & 0xffff0000u);
                    f32x4 v0 = acc[ai][bj][m][0] * g0, v1 = acc[ai][bj][m][1] * g1;
                    float* fp = F + (size_t)row * ldc + col;
                    if (!first) { v0 += *(const f32x4*)fp; v1 += *(const f32x4*)(fp + 4); }
                    if (last) { u32x4 w; w.x = cvt_pk_bf16(v0[0], v0[1]); w.y = cvt_pk_bf16(v0[2], v0[3]); w.z = cvt_pk_bf16(v1[0], v1[1]); w.w = cvt_pk_bf16(v1[2], v1[3]); *(u32x4*)(OB + (size_t)row * ldc + col) = w; }
                    else { *(f32x4*)fp = v0; *(f32x4*)(fp + 4) = v1; }
                }
            }
    }
};

struct EpiF32 {
    static constexpr bool PERM = true, AFTER_DRAIN = false;
    float* O; int ldc;
    __device__ __forceinline__ void operator()(const f32x4 (&acc)[2][2][4][2], const Unit& u, int wr, int wc, int fr, int fq) const {
        const int row0 = u.pm * BM + wr * 64 + fr, col0 = u.pn * BM + wc * 32 + 8 * fq;
#pragma unroll
        for (int ai = 0; ai < 2; ++ai)
#pragma unroll
            for (int m = 0; m < 4; ++m)
#pragma unroll
                for (int bj = 0; bj < 2; ++bj) { float* fp = O + (size_t)(row0 + ai * HALF + m * 16) * ldc + col0 + bj * HALF; *(f32x4*)fp = acc[ai][bj][m][0]; *(f32x4*)(fp + 4) = acc[ai][bj][m][1]; }
    }
};

struct EpiSwiGLU {
    static constexpr bool PERM = true, AFTER_DRAIN = false;
    bf16_t* O; int ldc;
    __device__ __forceinline__ void operator()(const f32x4 (&acc)[2][2][4][2], const Unit& u, int wr, int wc, int fr, int fq) const {
        const int row0 = u.pm * BM + wr * 64 + fr, col0 = u.pn * HALF + wc * 32 + 8 * fq;
#pragma unroll
        for (int ai = 0; ai < 2; ++ai)
#pragma unroll
            for (int m = 0; m < 4; ++m) {
                const f32x4 g0 = acc[ai][0][m][0], g1 = acc[ai][0][m][1], u0 = acc[ai][1][m][0], u1 = acc[ai][1][m][1];
                u32x4 w;
                w.x = cvt_pk_bf16(ep_silu(g0[0]) * u0[0], ep_silu(g0[1]) * u0[1]); w.y = cvt_pk_bf16(ep_silu(g0[2]) * u0[2], ep_silu(g0[3]) * u0[3]);
                w.z = cvt_pk_bf16(ep_silu(g1[0]) * u1[0], ep_silu(g1[1]) * u1[1]); w.w = cvt_pk_bf16(ep_silu(g1[2]) * u1[2], ep_silu(g1[3]) * u1[3]);
                *(u32x4*)(O + (size_t)(row0 + ai * HALF + m * 16) * ldc + col0) = w;
            }
    }
};

struct InProjOrder {
    StaticOrder so; int G, c;
    __device__ void init(int G_, int c_) { so.init(8192, 69 * 256, G_, c_); G = G_; c = c_; }
    __device__ bool next(int i, Unit& u) const {
        const long L = (long)i * G + c;
        if (L < so.nwg) return so.next(i, u);
        if (L < so.nwg + 8) { u.pm = 32; u.pn = 69 + (int)(L - so.nwg); return true; }
        return false;
    }
    __device__ __forceinline__ void a_ready(const Unit&) const {}
    __device__ __forceinline__ void done(const Unit&) const {}
};

template <class Epi, class Sched, bool ALIGN_EPI = false, bool SP2 = false>
__device__ __forceinline__ void gemm_phase(PG8_LAS unsigned char* lds, const Gemm g, const Sched& S, const Epi& E) {
    const int tid = threadIdx.x, wid = __builtin_amdgcn_readfirstlane(tid >> 6), lane = tid & 63, wr = wid >> 2, wc = wid & 3, fr = lane & 15, fq = lane >> 4;
    const int K = g.K, nt = K / BK;
    unsigned voffA[2], voffB[2];
#pragma unroll
    for (int i = 0; i < 2; ++i) { int R, C; stage_rc(tid * 16 + i * 8192, R, C); const int Rb = Epi::PERM ? ((R & ~31) + perm32(R & 31)) : R;
        voffA[i] = (unsigned)(R * K + C) * 2u; voffB[i] = (unsigned)(Rb * K + C) * 2u; }
    const size_t kstep = (size_t)(BK * 2);
    const size_t hstep = (size_t)HALF * K * 2;
    const size_t tstep = 2 * hstep;
    const unsigned ldsw = (unsigned)wid * 1024u;
    const int aoff = lds_byte(wr * 64 + fr, fq * 8), boff = lds_byte(wc * 32 + fr, fq * 8);
#define PG8_SA(b, h) (((b) * 2 + (h)) * HTB)
#define PG8_SB(b, h) ((4 + (b) * 2 + (h)) * HTB)
#define PG8_STAGE(bufoff, gbase, voff) do { _Pragma("unroll") for (int _i = 0; _i < 2; ++_i) \
        __builtin_amdgcn_global_load_lds((const unsigned*)((const char*)(gbase) + (voff)[_i]), (PG8_LAS unsigned*)(lds + (bufoff) + ldsw + _i * 8192), 16, 0, 0); } while (0)
#define PG8_LDA(dst, b, h) do { _Pragma("unroll") for (int m = 0; m < 4; ++m) _Pragma("unroll") for (int k = 0; k < 2; ++k) dst[m][k] = *(const PG8_LAS bf16x8*)(lds + PG8_SA(b, h) + aoff + m * 2048 + k * 1024); } while (0)
#define PG8_LDB(dst, b, h) do { _Pragma("unroll") for (int n = 0; n < 2; ++n) _Pragma("unroll") for (int k = 0; k < 2; ++k) dst[n][k] = *(const PG8_LAS bf16x8*)(lds + PG8_SB(b, h) + boff + n * 2048 + k * 1024); } while (0)
#define PG8_MMA(ai, bj, At, Bt) do { __builtin_amdgcn_s_setprio(1); _Pragma("unroll") for (int m = 0; m < 4; ++m) _Pragma("unroll") for (int n = 0; n < 2; ++n) _Pragma("unroll") for (int k = 0; k < 2; ++k) \
        acc[ai][bj][m][n] = __builtin_amdgcn_mfma_f32_16x16x32_bf16(Bt[n][k], At[m][k], acc[ai][bj][m][n], 0, 0, 0); __builtin_amdgcn_s_setprio(0); } while (0)
#define PG8_WAIT_V(n) asm volatile("s_waitcnt vmcnt(" #n ")" ::: "memory")
#define PG8_WAIT_L(n) asm volatile("s_waitcnt lgkmcnt(" #n ")" ::: "memory")
#define PG8_BAR __builtin_amdgcn_s_barrier()
#define PG8_SCHED __builtin_amdgcn_sched_barrier(0)
    Unit cur, nxt; int ui = 0;
    if (!S.next(0, cur)) return;
    f32x4 acc[2][2][4][2];
#pragma unroll
    for (int a = 0; a < 2; ++a)
#pragma unroll
        for (int b = 0; b < 2; ++b)
#pragma unroll
            for (int m = 0; m < 4; ++m)
#pragma unroll
                for (int n = 0; n < 2; ++n) acc[a][b][m][n] = (f32x4){0.f, 0.f, 0.f, 0.f};
    bf16x8 At[4][2], B0[2][2], B1[2][2];
    const char* cA = (const char*)g.A + (size_t)cur.pm * tstep; const char* cB = (const char*)g.Bt + (size_t)cur.pn * tstep;
    S.a_ready(cur);
    if constexpr (SP2) {
        PG8_STAGE(PG8_SB(0, 0), cB, voffB); PG8_STAGE(PG8_SB(0, 1), cB + hstep, voffB); PG8_STAGE(PG8_SA(0, 0), cA, voffA); PG8_STAGE(PG8_SA(0, 1), cA + hstep, voffA);
        if (wr == 1) PG8_BAR;
        PG8_WAIT_V(2); PG8_BAR;
        PG8_STAGE(PG8_SB(1, 0), cB + kstep, voffB); PG8_STAGE(PG8_SA(1, 0), cA + kstep, voffA); PG8_STAGE(PG8_SB(1, 1), cB + hstep + kstep, voffB);
        PG8_WAIT_V(6); PG8_BAR;
    } else {
        PG8_STAGE(PG8_SB(0, 0), cB, voffB); PG8_STAGE(PG8_SA(0, 0), cA, voffA); PG8_STAGE(PG8_SB(0, 1), cB + hstep, voffB); PG8_STAGE(PG8_SA(0, 1), cA + hstep, voffA);
        if (wr == 1) PG8_BAR;
        PG8_WAIT_V(4); PG8_BAR;
        PG8_STAGE(PG8_SB(1, 0), cB + kstep, voffB); PG8_STAGE(PG8_SA(1, 0), cA + kstep, voffA); PG8_STAGE(PG8_SB(1, 1), cB + hstep + kstep, voffB);
        PG8_WAIT_V(6); PG8_BAR;
    }
    for (;;) {
        const bool has_next = S.next(ui + 1, nxt);
        const char* nA = has_next ? (const char*)g.A + (size_t)nxt.pm * tstep : cA; const char* nB = has_next ? (const char*)g.Bt + (size_t)nxt.pn * tstep : cB;
        for (int t = 0; t < nt; t += 2) {
            const bool last = (t == nt - 2);
            const char* a1 = cA + (size_t)(t + 1) * kstep;
            const char* a2 = last ? nA : cA + (size_t)(t + 2) * kstep; const char* b2 = last ? nB : cB + (size_t)(t + 2) * kstep;
            const char* a3 = a2 + kstep; const char* b3 = b2 + kstep;
            if (last && has_next) S.a_ready(nxt);
            if constexpr (SP2) {
            PG8_LDB(B0, 0, 0); PG8_LDB(B1, 0, 1); PG8_SCHED; PG8_LDA(At, 0, 0); PG8_STAGE(PG8_SA(1, 1), a1 + hstep, voffA);
            PG8_WAIT_V(8); PG8_WAIT_L(0); PG8_BAR; PG8_MMA(0, 0, At, B0); PG8_MMA(0, 1, At, B1); PG8_BAR; PG8_SCHED;
            PG8_LDA(At, 0, 1); PG8_STAGE(PG8_SB(0, 0), b2, voffB); PG8_STAGE(PG8_SB(0, 1), b2 + hstep, voffB); PG8_STAGE(PG8_SA(0, 0), a2, voffA);
            PG8_WAIT_V(8); PG8_WAIT_L(0); PG8_BAR; PG8_MMA(1, 0, At, B0); PG8_MMA(1, 1, At, B1); PG8_BAR; PG8_SCHED;
            PG8_LDB(B0, 1, 0); PG8_LDB(B1, 1, 1); PG8_SCHED; PG8_LDA(At, 1, 0); PG8_STAGE(PG8_SA(0, 1), a2 + hstep, voffA);
            PG8_WAIT_V(8); PG8_WAIT_L(0); PG8_BAR; PG8_MMA(0, 0, At, B0); PG8_MMA(0, 1, At, B1); PG8_BAR; PG8_SCHED;
            PG8_LDA(At, 1, 1); PG8_STAGE(PG8_SB(1, 0), b3, voffB); PG8_STAGE(PG8_SB(1, 1), b3 + hstep, voffB); PG8_STAGE(PG8_SA(1, 0), a3, voffA);
            PG8_WAIT_V(8); PG8_WAIT_L(0); PG8_BAR; PG8_MMA(1, 0, At, B0); PG8_MMA(1, 1, At, B1); PG8_BAR; PG8_SCHED;
            } else {
            PG8_LDB(B0, 0, 0); PG8_SCHED; PG8_LDA(At, 0, 0); PG8_STAGE(PG8_SA(1, 1), a1 + hstep, voffA);
            PG8_WAIT_L(8); PG8_BAR; PG8_WAIT_L(0); PG8_MMA(0, 0, At, B0); PG8_BAR; PG8_SCHED;
            PG8_LDB(B1, 0, 1); PG8_STAGE(PG8_SB(0, 0), b2, voffB);
            PG8_BAR; PG8_WAIT_L(0); PG8_MMA(0, 1, At, B1); PG8_BAR;
            PG8_LDA(At, 0, 1); PG8_STAGE(PG8_SA(0, 0), a2, voffA);
            PG8_BAR; PG8_WAIT_L(0); PG8_MMA(1, 0, At, B0); PG8_BAR; PG8_SCHED;
            PG8_STAGE(PG8_SB(0, 1), b2 + hstep, voffB);
            PG8_WAIT_V(6); PG8_BAR; PG8_MMA(1, 1, At, B1); PG8_BAR;
            PG8_LDB(B0, 1, 0); PG8_SCHED; PG8_LDA(At, 1, 0); PG8_STAGE(PG8_SA(0, 1), a2 + hstep, voffA);
            PG8_WAIT_L(8); PG8_BAR; PG8_WAIT_L(0); PG8_MMA(0, 0, At, B0); PG8_BAR; PG8_SCHED;
            PG8_LDB(B1, 1, 1); PG8_STAGE(PG8_SB(1, 0), b3, voffB);
            PG8_BAR; PG8_WAIT_L(0); PG8_MMA(0, 1, At, B1); PG8_BAR;
            PG8_LDA(At, 1, 1); PG8_STAGE(PG8_SA(1, 0), a3, voffA);
            PG8_BAR; PG8_WAIT_L(0); PG8_MMA(1, 0, At, B0); PG8_BAR; PG8_SCHED;
            PG8_STAGE(PG8_SB(1, 1), b3 + hstep, voffB);
            PG8_WAIT_V(6); PG8_BAR; PG8_MMA(1, 1, At, B1); PG8_BAR;
            }
        }
        if constexpr (ALIGN_EPI) { if (wr == 0) PG8_BAR; }
        if constexpr (!Epi::AFTER_DRAIN) { E(acc, cur, wr, wc, fr, fq); S.done(cur); }
        if (!has_next) break;
#pragma unroll
        for (int a = 0; a < 2; ++a)
#pragma unroll
            for (int b = 0; b < 2; ++b)
#pragma unroll
                for (int m = 0; m < 4; ++m)
#pragma unroll
                    for (int n = 0; n < 2; ++n) acc[a][b][m][n] = (f32x4){0.f, 0.f, 0.f, 0.f};
        cur = nxt; cA = nA; cB = nB; ++ui;
        if constexpr (ALIGN_EPI) { if (wr == 1) PG8_BAR; }
    }
    PG8_WAIT_V(0);
    if constexpr (!ALIGN_EPI) { if (wr == 0) PG8_BAR; }
    PG8_BAR;
    if constexpr (Epi::AFTER_DRAIN) { E.fused(acc, cur, wr, wc, fr, fq, lds, wid, lane); S.done(cur); }
#undef PG8_SA
#undef PG8_SB
#undef PG8_STAGE
#undef PG8_LDA
#undef PG8_LDB
#undef PG8_MMA
#undef PG8_WAIT_V
#undef PG8_WAIT_L
#undef PG8_BAR
#undef PG8_SCHED
}
}

constexpr int RING_OFF = 0, RING_BYTES = 131072;
constexpr int LDSCTL_OFF = RING_BYTES, MISC_OFF = LDSCTL_OFF + 320;
constexpr int LDS_BYTES = 147456;
constexpr int CW_BAR = 4096;

typedef GAS unsigned gu32;
#define LDS_WAIT() asm volatile("s_waitcnt lgkmcnt(0)" ::: "memory")
#define XB_TMO      128
#define XB_XCNT(j)  (256  + 64 * (j))
#define XB_XSUB(j)  (1280 + 64 * (j))
#define XB_XGEN(j)  (2304 + 64 * (j))
#define XB_TOP      3328
#define XB_TOPGEN   3392
#define XCD_BAR_WORDS 3456
#define XB_SPIN_CAP (1u << 18)

__device__ __forceinline__ unsigned xb_ld(unsigned* p)              { return __hip_atomic_load(p, __ATOMIC_RELAXED, __HIP_MEMORY_SCOPE_AGENT); }
__device__ __forceinline__ unsigned xb_add(unsigned* p, unsigned v) { return __hip_atomic_fetch_add(p, v, __ATOMIC_RELAXED, __HIP_MEMORY_SCOPE_AGENT); }
__device__ __forceinline__ unsigned xb_xcc_id() { return (unsigned)__builtin_amdgcn_s_getreg((3 << 11) | 20) & 0xFu; }
#define XB_SPIN(cond, bar) do { unsigned _sp = 0; while (cond) { __builtin_amdgcn_s_sleep(1); \
    if ((++_sp & 255u) == 0u) { if (xb_ld(&(bar)[XB_TMO])) break; if (_sp > XB_SPIN_CAP) { atomicAdd(&(bar)[XB_TMO], 1u); break; } } } } while (0)

struct XcdBarrier {
    unsigned* bar; unsigned x;
    volatile LAS unsigned* st;
};

__device__ __forceinline__ XcdBarrier xcd_barrier_post(unsigned* bar, volatile LAS unsigned* st) {
    XcdBarrier b; b.bar = bar; b.x = xb_xcc_id(); b.st = st;
    if (threadIdx.x == 0) (void)xb_add(&bar[XB_XCNT(b.x)], 1u);
    return b;
}
__device__ __forceinline__ void xcd_barrier_complete(unsigned* bar, unsigned x, unsigned& nloc, unsigned& nx) {
    const unsigned G = gridDim.x * gridDim.y * gridDim.z;
    unsigned sum, cnt, mine, sp = 0u;
    for (;;) {
        sum = 0u; cnt = 0u; mine = 0u;
#pragma unroll
        for (unsigned j = 0; j < 16; ++j) { const unsigned c = xb_ld(&bar[XB_XCNT(j)]); sum += c; cnt += (c > 0u) ? 1u : 0u; mine = (j == x) ? c : mine; }
        if (sum == G) break;
        __builtin_amdgcn_s_sleep(1);
        if ((++sp & 255u) == 0u) { if (xb_ld(&bar[XB_TMO])) break; if (sp > XB_SPIN_CAP) { atomicAdd(&bar[XB_TMO], 1u); break; } }
    }
    nloc = mine > 0u ? mine : 1u; nx = cnt > 0u ? cnt : 1u;
}

__device__ __forceinline__ void xcd_barrier(const XcdBarrier& b) {
    asm volatile("s_waitcnt vmcnt(0)" ::: "memory");
    __syncthreads();
    if (threadIdx.x == 0) {
        unsigned* bar = b.bar;
        __builtin_amdgcn_s_waitcnt(0);
        unsigned nloc = b.st[0], nx = b.st[1];
        if (nloc == 0u) { xcd_barrier_complete(bar, b.x, nloc, nx); b.st[0] = nloc; b.st[1] = nx; }
        const unsigned old = xb_add(&bar[XB_XSUB(b.x)], 1u);
        const unsigned gen = old / nloc;
        if (old + 1u == (gen + 1u) * nloc) {
            __builtin_amdgcn_fence(__ATOMIC_RELEASE, "agent");
            asm volatile("s_waitcnt vmcnt(0)" ::: "memory");
            const unsigned og = xb_add(&bar[XB_TOP], 1u);
            const unsigned tg = og / nx;
            if (og + 1u == (tg + 1u) * nx) xb_add(&bar[XB_TOPGEN], 1u);
            else XB_SPIN(xb_ld(&bar[XB_TOPGEN]) == tg, bar);
            __builtin_amdgcn_fence(__ATOMIC_ACQUIRE, "agent");
            xb_add(&bar[XB_XGEN(b.x)], 1u);
            asm volatile("s_waitcnt vmcnt(0)" ::: "memory");
        } else {
            XB_SPIN(xb_ld(&bar[XB_XGEN(b.x)]) == gen, bar);
            __builtin_amdgcn_fence(__ATOMIC_ACQUIRE, "agent");
            asm volatile("s_waitcnt vmcnt(0)" ::: "memory");
        }
    }
    __syncthreads();
}

__device__ __forceinline__ int map_inproj(int np) {
    const int pn = np >> 8, p = np & 255, bj = p >> 7, q = p & 127;
    if (pn < 8 || (pn >= 16 && pn < 24)) { const int base = pn < 4 ? C_AQ : pn < 8 ? C_AK : pn < 20 ? C_RQ : C_RK; return base + ((pn & 3) * 2 + (q >> 6)) * 128 + bj * 64 + (q & 63); }
    if (pn >= 12 && pn < 16) return C_IQ + ((pn - 12) * 4 + (q >> 5)) * 64 + bj * 32 + (q & 31);
    if (pn == 68) { if (p < 32) return C_IK + p; if (p < 48) return C_IW + (p - 32); if (p >= 128 && p < 160) return C_IK + 32 + (p - 128); return -1; }
    int base, pl;
    if (pn < 12) { base = C_AV; pl = pn - 8; } else if (pn < 32) { base = C_RV; pl = pn - 24; } else if (pn < 40) { base = C_RG; pl = pn - 32; } else if (pn < 44) { base = C_MQ; pl = pn - 40; } else { base = C_GT; pl = pn - 44; }
    return base + pl * 256 + p;
}
__device__ __forceinline__ int map_ffin(int np) { return ((np >> 7) & 1) * DFF + (np >> 8) * 128 + (np & 127); }
template <int MAP> __device__ __forceinline__ void p0_transpose_item(const float* W, int K, int Nsrc, int Ndst, bf16_t* WT, LAS float* scr, int item, int lane) {
    const int nblk = Ndst / 32, kb = item / nblk, nb = item % nblk, k0 = 64 * kb, n0 = 32 * nb;
    const int np = n0 + (lane & 31);
    const int sc = MAP == 0 ? np : MAP == 1 ? map_inproj(np) : map_ffin(np);
#pragma unroll 8
    for (int i = 0; i < 32; ++i) { const int kk = 2 * i + (lane >> 5); scr[kk * 33 + (lane & 31)] = sc >= 0 ? W[(size_t)(k0 + kk) * Nsrc + sc] : 0.f; }
    LDS_WAIT(); asm volatile("" ::: "memory");
    const int c = lane & 7;
#pragma unroll
    for (int j = 0; j < 4; ++j) { const int n = (lane >> 3) + 8 * j; const LAS float* s = scr + (8 * c) * 33 + n;
        uint4 o; o.x = pk2(s[0 * 33], s[1 * 33]); o.y = pk2(s[2 * 33], s[3 * 33]); o.z = pk2(s[4 * 33], s[5 * 33]); o.w = pk2(s[6 * 33], s[7 * 33]);
        *(uint4*)(WT + (size_t)(n0 + n) * K + k0 + 8 * c) = o; }
    LDS_WAIT(); asm volatile("" ::: "memory");
}
__device__ __forceinline__ void rms_row_to_bf16(const float* src, const float* g, bf16_t* dst, int lane) {
    float v[32]; float ss = 0.f;
#pragma unroll
    for (int j = 0; j < 8; ++j) { const float4 t = *(const float4*)(src + j * 256 + lane * 4); v[4 * j] = t.x; v[4 * j + 1] = t.y; v[4 * j + 2] = t.z; v[4 * j + 3] = t.w; ss += t.x * t.x + t.y * t.y + t.z * t.z + t.w * t.w; }
    ss = wave_sum(ss);
    const float rs = rsqrtf(ss * (1.0f / D) + EPS);
#pragma unroll
    for (int j = 0; j < 8; ++j) { const float4 gg = *(const float4*)(g + j * 256 + lane * 4);
        uint2 o; o.x = pk2(v[4 * j] * rs * gg.x, v[4 * j + 1] * rs * gg.y); o.y = pk2(v[4 * j + 2] * rs * gg.z, v[4 * j + 3] * rs * gg.w);
        *(uint2*)(dst + j * 256 + lane * 4) = o; }
}

struct Ptrs {
    const float *x, *mem; const int* pos; const float *g_pre_mix, *g_mem, *w_in, *w_mem_kv, *w_a, *w_b, *w_c, *w_out, *g_post_mix, *g_pre_ffn, *w_ffn_in, *w_ffn_out, *g_post_ffn;
    float* out; unsigned char* ws;
};

__device__ __forceinline__ void p0_prologue(const Ptrs& P, LAS unsigned char* lds, int G) {
    const int tid = threadIdx.x, lane = tid & 63, wave = __builtin_amdgcn_readfirstlane(tid >> 6);
    LAS float* scr = (LAS float*)(lds + RING_OFF + wave * 16384);
    const int gw = blockIdx.x * NWAVES + wave, NGW = G * NWAVES;
    unsigned char* ws = P.ws;
    constexpr int I_IN = (D / 64) * (NP_IN / 32), I_MK = (D / 64) * (2048 / 32), I_A = (AW / 64) * (D / 32), I_B = (RVW / 64) * (D / 32), I_C = (MW / 64) * (D / 32), I_O = (D / 64) * (D / 32),
                  I_FI = (D / 64) * (2 * DFF / 32), I_FO = (DFF / 64) * (D / 32);
    constexpr int NITEMS = I_IN + I_MK + I_A + I_B + I_C + I_O + I_FI + I_FO;
    for (int it = gw; it < NITEMS; it += NGW) {
        int r = it;
        if (r < I_IN) { p0_transpose_item<1>(P.w_in, D, INC, NP_IN, (bf16_t*)(ws + WS_WIN), scr, r, lane); continue; } r -= I_IN;
        if (r < I_MK) { p0_transpose_item<0>(P.w_mem_kv, D, 2048, 2048, (bf16_t*)(ws + WS_WMEMKV), scr, r, lane); continue; } r -= I_MK;
        if (r < I_A) { p0_transpose_item<0>(P.w_a, AW, D, D, (bf16_t*)(ws + WS_WA), scr, r, lane); continue; } r -= I_A;
        if (r < I_B) { p0_transpose_item<0>(P.w_b, RVW, D, D, (bf16_t*)(ws + WS_WB), scr, r, lane); continue; } r -= I_B;
        if (r < I_C) { p0_transpose_item<0>(P.w_c, MW, D, D, (bf16_t*)(ws + WS_WC), scr, r, lane); continue; } r -= I_C;
        if (r < I_O) { p0_transpose_item<0>(P.w_out, D, D, D, (bf16_t*)(ws + WS_WOUT), scr, r, lane); continue; } r -= I_O;
        if (r < I_FI) { p0_transpose_item<2>(P.w_ffn_in, D, 2 * DFF, 2 * DFF, (bf16_t*)(ws + WS_WFFIN), scr, r, lane); continue; } r -= I_FI;
        p0_transpose_item<0>(P.w_ffn_out, DFF, D, D, (bf16_t*)(ws + WS_WFFOUT), scr, r, lane);
    }
    for (int r = gw; r < S + NMEM; r += NGW) {
        if (r < S) rms_row_to_bf16(P.x + (size_t)r * D, P.g_pre_mix, (bf16_t*)(ws + WS_XN) + (size_t)r * D, lane);
        else rms_row_to_bf16(P.mem + (size_t)(r - S) * D, P.g_mem, (bf16_t*)(ws + WS_MEMN) + (size_t)(r - S) * D, lane);
    }
    float* R128 = (float*)(ws + WS_ROPE128); float* R64 = (float*)(ws + WS_ROPE64);
    for (int i = blockIdx.x * NT + tid; i < S * 64; i += G * NT) {
        const int s = i >> 6, j = i & 63;
        const float ang = (float)P.pos[s] * (float)ROPE_FREQ[j];
        float sn, cs; sincos_d((double)ang, sn, cs);
        *(float2*)(R128 + 2 * i) = make_float2(cs, sn);
        if ((j & 1) == 0) { const int i2 = s * 32 + (j >> 1); *(float2*)(R64 + 2 * i2) = make_float2(cs, sn); }
    }
}

__device__ __forceinline__ unsigned ordkey(float f) { const unsigned u = __float_as_uint(f); return (u & 0x80000000u) ? ~u : (u | 0x80000000u); }
__device__ __forceinline__ float ret_loggamma(int h) { return log1pf(-exp2f(-5.0f - (float)h)); }

__device__ __forceinline__ void naive_index(const Ptrs& P, unsigned char* lds, int t) {
    float* q = (float*)lds; float* w = q + NIH * IDXD; unsigned* keys = (unsigned*)(w + 16); int* red = (int*)(keys + S);
    const f16_t* IQ = (const f16_t*)(P.ws + WS_IQ); const f16_t* IK = (const f16_t*)(P.ws + WS_IK); const float* IW = (const float*)(P.ws + WS_IW); unsigned* MASK = (unsigned*)(P.ws + WS_MASK);
    const int tid = threadIdx.x, lane = tid & 63, wv = tid >> 6;
    __syncthreads();
    for (int i = tid; i < NIH * IDXD; i += NT) q[i] = (float)IQ[(size_t)t * (NIH * IDXD) + i];
    if (tid < NIH) w[tid] = IW[(size_t)t * NIH + tid];
    __syncthreads();
    const int n = t + 1;
    for (int k = tid; k < n; k += NT) {
        float kk[IDXD];
        const f16_t* kp = IK + (size_t)k * IDXD;
#pragma unroll
        for (int d = 0; d < IDXD; ++d) kk[d] = (float)kp[d];
        float sc = 0.f;
        for (int h = 0; h < NIH; ++h) {
            float x = 0.f;
#pragma unroll
            for (int d = 0; d < IDXD; ++d) x = fmaf(q[h * IDXD + d], kk[d], x);
            sc = fmaf(fmaxf(x, 0.f), w[h], sc);
        }
        keys[k] = ordkey(sc);
    }
    __syncthreads();
    unsigned tau = 0u;
    if (n > 256) {
        for (int b = 31; b >= 0; --b) {
            const unsigned cand = tau | (1u << b);
            int c = 0;
            for (int k = tid; k < n; k += NT) c += (keys[k] >= cand) ? 1 : 0;
#pragma unroll
            for (int o = 1; o < 64; o <<= 1) c += __shfl_xor(c, o);
            __syncthreads();
            if (lane == 0) red[wv] = c;
            __syncthreads();
            int tot = 0;
#pragma unroll
            for (int i = 0; i < NWAVES; ++i) tot += red[i];
            if (tot >= 256) tau = cand;
        }
    }
    for (int k0 = 0; k0 < S; k0 += NT) {
        const int k = k0 + tid;
        const bool sel = (k < n) && (keys[k] >= tau);
        const unsigned long long b = __ballot(sel);
        if (lane == 0) { MASK[(size_t)(k >> 5) * S + t] = (unsigned)b; MASK[(size_t)((k >> 5) + 1) * S + t] = (unsigned)(b >> 32); }
    }
}

typedef short bf16x8 __attribute__((ext_vector_type(8)));
typedef float f32x16 __attribute__((ext_vector_type(16)));
typedef float f32x4 __attribute__((ext_vector_type(4)));
typedef float f32x2_t __attribute__((ext_vector_type(2)));
typedef __bf16 bf16x2_t __attribute__((ext_vector_type(2)));
typedef unsigned u32x4 __attribute__((ext_vector_type(4)));
typedef unsigned u32x2 __attribute__((ext_vector_type(2)));
#define MFMA32(a, b, c) __builtin_amdgcn_mfma_f32_32x32x16_bf16((a), (b), (c), 0, 0, 0)
__device__ __forceinline__ int crow(int r, int hi) { return (r & 3) + 8 * (r >> 2) + 4 * hi; }
__device__ __forceinline__ bf16x8 ldg8(const bf16_t* p) { return *(const bf16x8*)p; }
__device__ __forceinline__ unsigned cvtpk(float lo, float hi) { f32x2_t v = {lo, hi}; bf16x2_t b = __builtin_convertvector(v, bf16x2_t); return __builtin_bit_cast(unsigned, b); }
__device__ __forceinline__ bf16x8 pack_step(const f32x16& x, int s) {
    u32x4 p; p.x = cvtpk(x[8 * s], x[8 * s + 1]); p.y = cvtpk(x[8 * s + 2], x[8 * s + 3]); p.z = cvtpk(x[8 * s + 4], x[8 * s + 5]); p.w = cvtpk(x[8 * s + 6], x[8 * s + 7]);
    return __builtin_bit_cast(bf16x8, p);
}
__device__ __forceinline__ f32x16 zero16() { f32x16 z; for (int i = 0; i < 16; ++i) z[i] = 0.f; return z; }

__device__ __forceinline__ void ret_kv_mfma(const Ptrs& P, int nh) {
    const int lane = threadIdx.x & 63, w = __builtin_amdgcn_readfirstlane(threadIdx.x >> 6), n = nh >> 3, h = nh & 7, db = w & 3, eh = w >> 2;
    int r = lane & 31, hh = lane >> 5; asm volatile("" : "+v"(r), "+v"(hh));
    const bf16_t* RKT = (const bf16_t*)(P.ws + WS_RKT) + (size_t)(h * 128 + 32 * db + r) * S + n * 128 + 8 * hh;
    const bf16_t* RVT = (const bf16_t*)(P.ws + WS_RVT) + (size_t)(h * 256 + 128 * eh + r) * S + n * 128 + 8 * hh;
    f32x16 acc[4];
#pragma unroll
    for (int eb = 0; eb < 4; ++eb) acc[eb] = zero16();
#pragma unroll
    for (int ks = 0; ks < 8; ++ks) {
        const bf16x8 a = ldg8(RKT + 16 * ks);
#pragma unroll
        for (int eb = 0; eb < 4; ++eb) acc[eb] = MFMA32(a, ldg8(RVT + (size_t)(32 * eb) * S + 16 * ks), acc[eb]);
    }
    float* KVS = (float*)(P.ws + WS_KVS);
#pragma unroll
    for (int eb = 0; eb < 4; ++eb)
#pragma unroll
        for (int g = 0; g < 4; ++g) {
            const int e = 128 * eh + 32 * eb + r, d0 = 32 * db + 8 * g + 4 * hh;
            *(f32x4*)(KVS + ((size_t)nh * 256 + e) * 128 + d0) = (f32x4){acc[eb][4 * g], acc[eb][4 * g + 1], acc[eb][4 * g + 2], acc[eb][4 * g + 3]};
        }
}
__device__ __forceinline__ void ret_scan(const Ptrs& P, int task) {
    const float* KVS = (const float*)(P.ws + WS_KVS); bf16_t* PREV = (bf16_t*)(P.ws + WS_PREV);
    const int i = task * NT + threadIdx.x, h = i >> 15;
    const float lg = log1pf(-exp2f(-5.0f - (float)h)), cd = __expf(128.0f * lg), gm = __expf(lg);
    float st = 0.f;
#pragma unroll 8
    for (int n = 0; n < 64; ++n) { const size_t o = (size_t)n * (8 * 128 * 256) + i; PREV[o] = f2bf(st * gm); st = st * cd + KVS[o]; }
}
__device__ __forceinline__ void ret_out_mfma(const Ptrs& P, unsigned char* lds, int nh) {
    const int lane = threadIdx.x & 63, w = __builtin_amdgcn_readfirstlane(threadIdx.x >> 6), n = nh >> 3, h = nh & 7, ib = w & 3, eh = w >> 2, tok0 = n * 128;
    int r = lane & 31, hh = lane >> 5; asm volatile("" : "+v"(r), "+v"(hh));
    float2* red = (float2*)lds;
    const bf16_t* RQ = (const bf16_t*)(P.ws + WS_RQ) + (size_t)(tok0 + 32 * ib + r) * 1024 + h * 128 + 8 * hh;
    bf16x8 qf[8];
#pragma unroll
    for (int ks = 0; ks < 8; ++ks) qf[ks] = ldg8(RQ + 16 * ks);
    f32x16 acc[4];
#pragma unroll
    for (int eb = 0; eb < 4; ++eb) acc[eb] = zero16();
    for (int jb = 0; jb <= ib; ++jb) {
        f32x16 X = zero16();
        const bf16_t* RK = (const bf16_t*)(P.ws + WS_RK) + (size_t)(tok0 + 32 * jb + r) * 1024 + h * 128 + 8 * hh;
#pragma unroll
        for (int ks = 0; ks < 8; ++ks) X = MFMA32(ldg8(RK + 16 * ks), qf[ks], X);
        if (jb == ib) {
#pragma unroll
            for (int reg = 0; reg < 16; ++reg) if (crow(reg, hh) > r) X[reg] = 0.f;
        }
#pragma unroll
        for (int s = 0; s < 2; ++s) {
            const bf16x8 xs = pack_step(X, s);
            const bf16_t* VT = (const bf16_t*)(P.ws + WS_RVT) + (size_t)(h * 256 + 128 * eh + r) * S + tok0 + 32 * jb + 16 * s + 8 * hh;
#pragma unroll
            for (int eb = 0; eb < 4; ++eb) acc[eb] = MFMA32(ldg8(VT + (size_t)(32 * eb) * S), xs, acc[eb]);
        }
    }
    {
        const bf16_t* PT = (const bf16_t*)(P.ws + WS_PREV) + ((size_t)nh * 256 + 128 * eh + r) * 128 + 8 * hh;
#pragma unroll
        for (int ks = 0; ks < 8; ++ks)
#pragma unroll
            for (int eb = 0; eb < 4; ++eb) acc[eb] = MFMA32(ldg8(PT + (size_t)(32 * eb) * 128 + 16 * ks), qf[ks], acc[eb]);
    }
    float s1 = 0.f, s2 = 0.f;
#pragma unroll
    for (int eb = 0; eb < 4; ++eb)
#pragma unroll
        for (int reg = 0; reg < 16; ++reg) { const float v = acc[eb][reg]; s1 += v; s2 = fmaf(v, v, s2); }
    s1 += __shfl_xor(s1, 32); s2 += __shfl_xor(s2, 32);
    __syncthreads();
    if (hh == 0) red[w * 32 + r] = make_float2(s1, s2);
    __syncthreads();
    { const float2 o = red[(w ^ 4) * 32 + r]; s1 += o.x; s2 += o.y; }
    const float mu = s1 * (1.0f / 256.0f), var = fmaxf(s2 * (1.0f / 256.0f) - mu * mu, 0.f), rs = rsqrtf(var + EPS);
    bf16_t* OB = (bf16_t*)(P.ws + WS_OB) + (size_t)(tok0 + 32 * ib + r) * 2048 + h * 256 + 128 * eh + 4 * hh;
#pragma unroll
    for (int eb = 0; eb < 4; ++eb)
#pragma unroll
        for (int g = 0; g < 4; ++g) {
            bf16_t* p = OB + 32 * eb + 8 * g;
            const u32x2 gw = *(const u32x2*)p;
            const float g0 = __uint_as_float(gw.x << 16), g1 = __uint_as_float(gw.x & 0xffff0000u), g2 = __uint_as_float(gw.y << 16), g3 = __uint_as_float(gw.y & 0xffff0000u);
            u32x2 o; o.x = cvtpk(g0 * (acc[eb][4 * g] - mu) * rs, g1 * (acc[eb][4 * g + 1] - mu) * rs); o.y = cvtpk(g2 * (acc[eb][4 * g + 2] - mu) * rs, g3 * (acc[eb][4 * g + 3] - mu) * rs);
            *(u32x2*)p = o;
        }
}
__device__ __forceinline__ void memattn_mfma(const Ptrs& P, int u) {
    const int lane = threadIdx.x & 63, h = u & 3, t0 = (u >> 2) * 32;
    int r = lane & 31, hh = lane >> 5; asm volatile("" : "+v"(r), "+v"(hh));
    const bf16_t* MQ = (const bf16_t*)(P.ws + WS_MQ) + (size_t)(t0 + r) * 1024 + h * 256 + 8 * hh;
    f32x16 X[8];
#pragma unroll
    for (int kb = 0; kb < 8; ++kb) X[kb] = zero16();
    {
        const bf16_t* MK = (const bf16_t*)(P.ws + WS_MEMK) + (size_t)r * 1024 + h * 256 + 8 * hh;
#pragma unroll 1
        for (int ks = 0; ks < 16; ++ks) {
            const bf16x8 qf = ldg8(MQ + 16 * ks);
#pragma unroll
            for (int kb = 0; kb < 8; ++kb) X[kb] = MFMA32(ldg8(MK + (size_t)(32 * kb) * 1024 + 16 * ks), qf, X[kb]);
        }
    }
    float mx = -INFINITY;
#pragma unroll
    for (int kb = 0; kb < 8; ++kb)
#pragma unroll
        for (int reg = 0; reg < 16; ++reg) mx = fmaxf(mx, X[kb][reg]);
    mx = fmaxf(mx, __shfl_xor(mx, 32));
    float l = 0.f;
    bf16x8 pf[16];
#pragma unroll
    for (int kb = 0; kb < 8; ++kb) {
#pragma unroll
        for (int reg = 0; reg < 16; ++reg) { const float p = __builtin_amdgcn_exp2f(X[kb][reg] - mx); X[kb][reg] = p; l += p; }
        pf[2 * kb] = pack_step(X[kb], 0); pf[2 * kb + 1] = pack_step(X[kb], 1);
    }
    l += __shfl_xor(l, 32);
    const float inv = 1.0f / l;
    bf16_t* OC = (bf16_t*)(P.ws + WS_OC) + (size_t)(t0 + r) * 1024 + h * 256 + 4 * hh;
    const bf16_t* VT = (const bf16_t*)(P.ws + WS_MVT) + (size_t)(h * 256 + r) * 256 + 8 * hh;
#pragma unroll
    for (int dh = 0; dh < 2; ++dh) {
        f32x16 O[4];
#pragma unroll
        for (int db = 0; db < 4; ++db) O[db] = zero16();
#pragma unroll
        for (int kk = 0; kk < 16; ++kk) {
#pragma unroll
            for (int db = 0; db < 4; ++db) O[db] = MFMA32(ldg8(VT + (size_t)(128 * dh + 32 * db) * 256 + 16 * kk), pf[kk], O[db]);
            if (kk & 1) asm volatile("" ::: "memory");
        }
#pragma unroll
        for (int db = 0; db < 4; ++db)
#pragma unroll
            for (int g = 0; g < 4; ++g) {
                u32x2 o; o.x = cvtpk(O[db][4 * g] * inv, O[db][4 * g + 1] * inv); o.y = cvtpk(O[db][4 * g + 2] * inv, O[db][4 * g + 3] * inv);
                *(u32x2*)(OC + 128 * dh + 32 * db + 8 * g) = o;
            }
    }
}
__device__ __forceinline__ float mask_sel(unsigned w, int c, float x) { const int m = __builtin_amdgcn_sbfe((int)w, c, 1); return __uint_as_float((__float_as_uint(x) & (unsigned)m) | (0xff800000u & ~(unsigned)m)); }
__device__ __forceinline__ void attn_mfma(const Ptrs& P, LAS unsigned char* lds, int h, int qb) {
    const int tid = threadIdx.x, lane = tid & 63, w = __builtin_amdgcn_readfirstlane(tid >> 6), g = w >> 2, qs = w & 3;
    int r = lane & 31, hh = lane >> 5; asm volatile("" : "+v"(r), "+v"(hh));
    const int q0 = 128 * qb + 32 * qs, nst = qb + 1;
    const bf16_t* AK = (const bf16_t*)(P.ws + WS_AK) + h * 128; const bf16_t* AVT = (const bf16_t*)(P.ws + WS_AVT) + (size_t)h * 128 * S;
    const unsigned* MASKT = (const unsigned*)(P.ws + WS_MASK) + q0 + r;
    const int skey = tid >> 4, sch = tid & 15, sd = tid >> 3, svc = tid & 7;
    bf16x8 qf[8];
    { const bf16_t* AQ = (const bf16_t*)(P.ws + WS_AQ) + (size_t)(q0 + r) * 1024 + h * 128 + 8 * hh;
#pragma unroll
      for (int ks = 0; ks < 8; ++ks) qf[ks] = ldg8(AQ + 16 * ks); }
    f32x16 O[4];
#pragma unroll
    for (int db = 0; db < 4; ++db) O[db] = zero16();
    float m_run = -1e30f, l_run = 0.f;
    u32x4 sk[4], sv[4];
#define ATT_ISSUE(st) do { _Pragma("unroll") for (int i = 0; i < 4; ++i) { \
        sk[i] = *(const u32x4*)(AK + (size_t)(128 * (st) + 64 * (i >> 1) + skey + 32 * (i & 1)) * 1024 + sch * 8); \
        sv[i] = *(const u32x4*)(AVT + (size_t)(sd + 64 * (i & 1)) * S + 128 * (st) + 64 * (i >> 1) + svc * 8); } } while (0)
#define ATT_WRITE(buf) do { _Pragma("unroll") for (int i = 0; i < 4; ++i) { const int key = skey + 32 * (i & 1), d = sd + 64 * (i & 1); \
        *(LAS u32x4*)(lds + (buf) * 65536 + (i >> 1) * 32768 + key * 256 + ((sch ^ (key & 15)) << 4)) = sk[i]; \
        *(LAS u32x4*)(lds + (buf) * 65536 + (i >> 1) * 32768 + 16384 + d * 128 + ((svc ^ ((d >> 1) & 7)) << 4)) = sv[i]; } } while (0)
    __syncthreads();
    ATT_ISSUE(0); ATT_WRITE(0);
    __syncthreads();
    for (int st = 0; st < nst; ++st) {
        const bool more = st + 1 < nst;
        if (more) ATT_ISSUE(st + 1);
        unsigned w0 = MASKT[(size_t)(4 * st + 2 * g) * S], w1 = MASKT[(size_t)(4 * st + 2 * g + 1) * S];
        const LAS unsigned char* Kb = lds + (st & 1) * 65536 + g * 32768; const LAS unsigned char* Vb = Kb + 16384;
        f32x16 X0 = zero16(), X1 = zero16();
#pragma unroll
        for (int ks = 0; ks < 8; ++ks) {
            const bf16x8 a0 = *(const LAS bf16x8*)(Kb + r * 256 + (((2 * ks + hh) ^ (r & 15)) << 4));
            const bf16x8 a1 = *(const LAS bf16x8*)(Kb + (32 + r) * 256 + (((2 * ks + hh) ^ (r & 15)) << 4));
            X0 = MFMA32(a0, qf[ks], X0); X1 = MFMA32(a1, qf[ks], X1);
        }
        w0 >>= 4 * hh; w1 >>= 4 * hh;
        float tmax = -INFINITY;
#pragma unroll
        for (int reg = 0; reg < 16; ++reg) { const int c = (reg & 3) + 8 * (reg >> 2); X0[reg] = mask_sel(w0, c, X0[reg]); X1[reg] = mask_sel(w1, c, X1[reg]); tmax = fmaxf(tmax, fmaxf(X0[reg], X1[reg])); }
        tmax = fmaxf(tmax, __shfl_xor(tmax, 32));
        const float m_new = fmaxf(m_run, tmax), alpha = __builtin_amdgcn_exp2f(m_run - m_new);
        m_run = m_new;
        float ps = 0.f;
#pragma unroll
        for (int reg = 0; reg < 16; ++reg) { X0[reg] = __builtin_amdgcn_exp2f(X0[reg] - m_new); X1[reg] = __builtin_amdgcn_exp2f(X1[reg] - m_new); ps += X0[reg] + X1[reg]; }
        l_run = l_run * alpha + ps;
#pragma unroll
        for (int db = 0; db < 4; ++db) O[db] = O[db] * alpha;
        bf16x8 pf[4]; pf[0] = pack_step(X0, 0); pf[1] = pack_step(X0, 1); pf[2] = pack_step(X1, 0); pf[3] = pack_step(X1, 1);
#pragma unroll
        for (int s = 0; s < 4; ++s)
#pragma unroll
            for (int db = 0; db < 4; ++db) {
                const bf16x8 vf = *(const LAS bf16x8*)(Vb + (32 * db + r) * 128 + (((2 * s + hh) ^ ((r >> 1) & 7)) << 4));
                O[db] = MFMA32(vf, pf[s], O[db]);
            }
        if (more) ATT_WRITE((st + 1) & 1);
        __syncthreads();
    }
#undef ATT_ISSUE
#undef ATT_WRITE
    l_run += __shfl_xor(l_run, 32);
    LAS float* cb = (LAS float*)(lds + qs * 16896);
    if (g == 1) {
#pragma unroll
        for (int db = 0; db < 4; ++db)
#pragma unroll
            for (int reg = 0; reg < 16; ++reg) cb[(db * 16 + reg) * 64 + lane] = O[db][reg];
        cb[4096 + lane] = m_run; cb[4160 + lane] = l_run;
    }
    __syncthreads();
    if (g == 0) {
        const float m1 = cb[4096 + lane], l1 = cb[4160 + lane], mt = fmaxf(m_run, m1), a0 = __builtin_amdgcn_exp2f(m_run - mt), a1 = __builtin_amdgcn_exp2f(m1 - mt);
        const float inv = 1.0f / (l_run * a0 + l1 * a1), f0 = a0 * inv, f1 = a1 * inv;
        bf16_t* OA = (bf16_t*)(P.ws + WS_OA) + (size_t)(q0 + r) * 1024 + h * 128 + 4 * hh;
#pragma unroll
        for (int db = 0; db < 4; ++db)
#pragma unroll
            for (int gq = 0; gq < 4; ++gq) {
                float v[4];
#pragma unroll
                for (int e = 0; e < 4; ++e) v[e] = O[db][4 * gq + e] * f0 + cb[(db * 16 + 4 * gq + e) * 64 + lane] * f1;
                u32x2 o; o.x = cvtpk(v[0], v[1]); o.y = cvtpk(v[2], v[3]);
                *(u32x2*)(OA + 32 * db + 8 * gq) = o;
            }
    }
}
typedef _Float16 f16x8 __attribute__((ext_vector_type(8)));
__device__ __forceinline__ void index_mfma(const Ptrs& P, LAS unsigned char* lds, int tile) {
    const int tid = threadIdx.x, lane = tid & 63, w = __builtin_amdgcn_readfirstlane(tid >> 6), qp = w & 3, kh = w >> 2, t0 = 8 * tile;
    int r = lane & 31, hh = lane >> 5; asm volatile("" : "+v"(r), "+v"(hh));
    const int nkb = ((t0 + 7) >> 5) + 1, njb = (nkb - kh + 1) >> 1, kbw = 4 * ((t0 >> 7) + 1), tq = t0 + 2 * qp + hh;
    LAS int* cnt = (LAS int*)lds;
    const f16_t* IQ = (const f16_t*)(P.ws + WS_IQ) + (size_t)(t0 + 2 * qp + (r >> 4)) * 1024 + (r & 15) * 64 + 8 * hh;
    f16x8 af[4];
#pragma unroll
    for (int s = 0; s < 4; ++s) af[s] = *(const f16x8*)(IQ + 16 * s);
    float wq0[8], wq1[8];
    { const float* IW = (const float*)(P.ws + WS_IW) + (size_t)(t0 + 2 * qp) * 16 + 4 * hh;
#pragma unroll
      for (int reg = 0; reg < 8; ++reg) { const int hd = (reg & 3) + 8 * (reg >> 2); wq0[reg] = IW[hd]; wq1[reg] = IW[16 + hd]; } }
    unsigned sc[128];
#pragma unroll
    for (int j = 0; j < 128; ++j) sc[j] = 0u;
    const f16_t* IK = (const f16_t*)(P.ws + WS_IK) + (size_t)r * 64 + 8 * hh;
#pragma unroll
    for (int j = 0; j < 128; ++j) {
        if (j < njb) {
            const int kb = 2 * j + kh;
            const f16_t* kp = IK + (size_t)kb * (32 * 64);
            f32x16 X = zero16();
#pragma unroll
            for (int s = 0; s < 4; ++s) X = __builtin_amdgcn_mfma_f32_32x32x16_f16(af[s], *(const f16x8*)(kp + 16 * s), X, 0, 0, 0);
            float p0 = 0.f, p1 = 0.f;
#pragma unroll
            for (int reg = 0; reg < 8; ++reg) { p0 = fmaf(fmaxf(X[reg], 0.f), wq0[reg], p0); p1 = fmaf(fmaxf(X[8 + reg], 0.f), wq1[reg], p1); }
            const auto rr = __builtin_amdgcn_permlane32_swap(__float_as_uint(p0), __float_as_uint(p1), false, false);
            const float score = __uint_as_float(rr[0]) + __uint_as_float(rr[1]);
            sc[j] = (32 * kb + r <= tq) ? ordkey(score) : 0u;
        }
    }
    unsigned tau = 0u;
    __syncthreads();
    if (t0 + 8 > 256) {
#pragma unroll 1
        for (int b = 31; b >= 0; --b) {
            const unsigned cand = tau | (1u << b);
            int c = 0;
#pragma unroll
            for (int jj = 0; jj < 128; jj += 16) {
                if (jj < njb) {
#pragma unroll
                    for (int j = jj; j < jj + 16; ++j) c += (sc[j] >= cand) ? 1 : 0;
                }
            }
            c += __shfl_xor(c, 1); c += __shfl_xor(c, 2); c += __shfl_xor(c, 4); c += __shfl_xor(c, 8); c += __shfl_xor(c, 16);
            LAS int* cb = cnt + (b & 1) * 16;
            if (r == 0) cb[w * 2 + hh] = c;
            __syncthreads();
            const int tot = c + cb[(w ^ 4) * 2 + hh];
            if (tot >= 256) tau = cand;
        }
    }
    const unsigned thr = tau > 1u ? tau : 1u;
    unsigned* MASKT = (unsigned*)(P.ws + WS_MASK) + t0 + 2 * qp;
#pragma unroll
    for (int j = 0; j < 128; ++j) {
        const int kb = 2 * j + kh;
        if (kb < kbw) {
            const unsigned long long bm = __ballot(sc[j] >= thr);
            if (lane == 0) *(uint2*)(MASKT + (size_t)kb * S) = make_uint2((unsigned)bm, (unsigned)(bm >> 32));
        }
    }
}
__device__ __forceinline__ void resnorm_row(const float* xin, const float* y, const float* g1, const float* g2, float* out, bf16_t* h2, int r, int lane) {
    float yv[32], xv[32]; float ss = 0.f;
#pragma unroll
    for (int j = 0; j < 8; ++j) { const float4 t = *(const float4*)(y + (size_t)r * D + j * 256 + lane * 4); yv[4 * j] = t.x; yv[4 * j + 1] = t.y; yv[4 * j + 2] = t.z; yv[4 * j + 3] = t.w; ss += t.x * t.x + t.y * t.y + t.z * t.z + t.w * t.w; }
    ss = wave_sum(ss);
    const float rs = rsqrtf(ss * (1.0f / D) + EPS);
    float s2 = 0.f;
#pragma unroll
    for (int j = 0; j < 8; ++j) {
        const float4 xx = *(const float4*)(xin + (size_t)r * D + j * 256 + lane * 4);
        const float4 gg = *(const float4*)(g1 + j * 256 + lane * 4);
        xv[4 * j] = xx.x + yv[4 * j] * rs * gg.x; xv[4 * j + 1] = xx.y + yv[4 * j + 1] * rs * gg.y; xv[4 * j + 2] = xx.z + yv[4 * j + 2] * rs * gg.z; xv[4 * j + 3] = xx.w + yv[4 * j + 3] * rs * gg.w;
        s2 += xv[4 * j] * xv[4 * j] + xv[4 * j + 1] * xv[4 * j + 1] + xv[4 * j + 2] * xv[4 * j + 2] + xv[4 * j + 3] * xv[4 * j + 3];
        *(float4*)(out + (size_t)r * D + j * 256 + lane * 4) = make_float4(xv[4 * j], xv[4 * j + 1], xv[4 * j + 2], xv[4 * j + 3]);
    }
    if (h2) {
        s2 = wave_sum(s2);
        const float r2 = rsqrtf(s2 * (1.0f / D) + EPS);
#pragma unroll
        for (int j = 0; j < 8; ++j) { const float4 gg = *(const float4*)(g2 + j * 256 + lane * 4);
            uint2 o; o.x = pk2(xv[4 * j] * r2 * gg.x, xv[4 * j + 1] * r2 * gg.y); o.y = pk2(xv[4 * j + 2] * r2 * gg.z, xv[4 * j + 3] * r2 * gg.w);
            *(uint2*)(h2 + (size_t)r * D + j * 256 + lane * 4) = o; }
    }
}

#ifndef MK_PER_PHASE
#define MK_PER_PHASE 0
#endif
constexpr int N_PHASES = 11;
struct Args { Ptrs p; int ph_lo, ph_hi; };
__global__ void __launch_bounds__(NT, 2) mk_fwd(Args args) {
    extern __shared__ __attribute__((aligned(16))) unsigned char lds_raw[];
    LAS unsigned char* lds = (LAS unsigned char*)lds_raw;
    const Ptrs& P = args.p;
    const int tid = threadIdx.x, lane = tid & 63, wave = __builtin_amdgcn_readfirstlane(tid >> 6), G = gridDim.x;
    unsigned char* ws = P.ws;
    for (int u = tid; u < (LDS_BYTES - LDSCTL_OFF) / 4; u += NT) ((LAS unsigned*)(lds + LDSCTL_OFF))[u] = 0u;
    __syncthreads();
    XcdBarrier bar; bar.bar = (unsigned*)(ws + WS_CTL) + CW_BAR; bar.x = 0; bar.st = nullptr;
    if (!MK_PER_PHASE) bar = xcd_barrier_post((unsigned*)(ws + WS_CTL) + CW_BAR, (volatile LAS unsigned*)(lds + MISC_OFF) + 8);
    const int lo = args.ph_lo, hi = args.ph_hi;
#define IN(k) (lo <= (k) && (k) < hi)
#define SEAM(k) do { if (IN(k) && IN((k) + 1)) xcd_barrier(bar); } while (0)
    bf16_t* XN = (bf16_t*)(ws + WS_XN);

    if (IN(0)) { p0_prologue(P, lds, G); }
    SEAM(0);
    if (IN(1)) {
        pg8::Gemm g{XN, (const bf16_t*)(ws + WS_WIN), S + NMEM, NP_IN + 2048, D}; pg8::InProjOrder O; O.init(G, (int)blockIdx.x);
        pg8::EpiInProj E{ws};
        pg8::gemm_phase<pg8::EpiInProj, pg8::InProjOrder, true, true>(lds + RING_OFF, g, O, E);
    }
    SEAM(1);
    if (IN(2)) {
        for (int task = blockIdx.x; task < 512 + 128; task += G) {
            if (task < 512) ret_kv_mfma(P, task);
            else memattn_mfma(P, (task - 512) * 8 + wave);
        }
        for (int i = blockIdx.x; i < 256; i += G) {
#pragma unroll 1
            for (int k = 0; k < 4; ++k) { const int tile = (k == 0) ? i : (k == 1) ? 511 - i : (k == 2) ? 512 + i : 1023 - i; index_mfma(P, lds + RING_OFF, tile); }
        }
    }
    SEAM(2);
    if (IN(3)) {
        for (int task = blockIdx.x; task < 512; task += G) ret_scan(P, task);
        for (int i = blockIdx.x; i < 256; i += G) {
#pragma unroll 1
            for (int k = 0; k < 2; ++k) { const int u = k ? 511 - i : i; attn_mfma(P, lds + RING_OFF, u & 7, 63 - (u >> 3)); }
        }
    }
    SEAM(3);
    if (IN(4)) { for (int task = blockIdx.x; task < 512; task += G) ret_out_mfma(P, lds_raw, task); }
    SEAM(4);
    if (IN(5)) {
        __syncthreads();
        pg8::StaticOrder O; O.init(S, D, G, (int)blockIdx.x);
        { pg8::Gemm g{(const bf16_t*)(ws + WS_OB), (const bf16_t*)(ws + WS_WB), S, D, RVW};
          pg8::EpiGateAcc E{(float*)(ws + WS_MIXED), (bf16_t*)(ws + WS_MIXEDB), (const bf16_t*)(ws + WS_GATES) + D, D, 3 * D, 1, 0};
          pg8::gemm_phase<pg8::EpiGateAcc, pg8::StaticOrder, false, true>(lds + RING_OFF, g, O, E); }
        { pg8::Gemm g{(const bf16_t*)(ws + WS_OA), (const bf16_t*)(ws + WS_WA), S, D, AW};
          pg8::EpiGateAcc E{(float*)(ws + WS_MIXED), (bf16_t*)(ws + WS_MIXEDB), (const bf16_t*)(ws + WS_GATES), D, 3 * D, 0, 0};
          pg8::gemm_phase<pg8::EpiGateAcc, pg8::StaticOrder, false, true>(lds + RING_OFF, g, O, E); }
        { pg8::Gemm g{(const bf16_t*)(ws + WS_OC), (const bf16_t*)(ws + WS_WC), S, D, MW};
          pg8::EpiGateAcc E{(float*)(ws + WS_MIXED), (bf16_t*)(ws + WS_MIXEDB), (const bf16_t*)(ws + WS_GATES) + 2 * D, D, 3 * D, 0, 1};
          pg8::gemm_phase<pg8::EpiGateAcc, pg8::StaticOrder, false, true>(lds + RING_OFF, g, O, E); }
    }
    SEAM(5);
    if (IN(6)) {
        pg8::Gemm g{(const bf16_t*)(ws + WS_MIXEDB), (const bf16_t*)(ws + WS_WOUT), S, D, D}; pg8::StaticOrder O; O.init(S, D, G, (int)blockIdx.x);
        pg8::EpiF32 E{(float*)(ws + WS_Y), D};
        pg8::gemm_phase<pg8::EpiF32, pg8::StaticOrder, false, true>(lds + RING_OFF, g, O, E);
    }
    SEAM(6);
    if (IN(7)) { for (int r = blockIdx.x * NWAVES + wave; r < S; r += G * NWAVES) resnorm_row(P.x, (const float*)(ws + WS_Y), P.g_post_mix, P.g_pre_ffn, P.out, XN, r, lane); }
    SEAM(7);
    if (IN(8)) {
        pg8::Gemm g{XN, (const bf16_t*)(ws + WS_WFFIN), S, 2 * DFF, D}; pg8::StaticOrder O; O.init(S, 2 * DFF, G, (int)blockIdx.x);
        pg8::EpiSwiGLU E{(bf16_t*)(ws + WS_ACT), DFF};
        pg8::gemm_phase<pg8::EpiSwiGLU, pg8::StaticOrder, true, true>(lds + RING_OFF, g, O, E);
    }
    SEAM(8);
    if (IN(9)) {
        pg8::Gemm g{(const bf16_t*)(ws + WS_ACT), (const bf16_t*)(ws + WS_WFFOUT), S, D, DFF}; pg8::StaticOrder O; O.init(S, D, G, (int)blockIdx.x);
        pg8::EpiF32 E{(float*)(ws + WS_Y), D};
        pg8::gemm_phase<pg8::EpiF32, pg8::StaticOrder, false, true>(lds + RING_OFF, g, O, E);
    }
    SEAM(9);
    if (IN(10)) { for (int r = blockIdx.x * NWAVES + wave; r < S; r += G * NWAVES) resnorm_row(P.out, (const float*)(ws + WS_Y), P.g_post_ffn, nullptr, P.out, nullptr, r, lane); }
#undef IN
#undef SEAM
}

extern "C" void kernel_launch(void* const* d_in, const int* in_sizes, int n_in, void* d_out, int out_size, void* d_ws, size_t ws_size, hipStream_t stream) {
    static int grid = 0;
    if (grid == 0) {
        if (n_in != 16 || in_sizes[0] != S * D || out_size != S * D || ws_size < WS_END) { fprintf(stderr, "kernel_launch: unexpected shapes (n_in %d, ws %zu); nothing launched\n", n_in, ws_size); grid = -1; return; }
        int dev = 0, cus = 0, per_cu = 0;
        if (hipGetDevice(&dev) != hipSuccess || hipDeviceGetAttribute(&cus, hipDeviceAttributeMultiprocessorCount, dev) != hipSuccess) { grid = -1; return; }
        if (hipFuncSetAttribute((const void*)mk_fwd, hipFuncAttributeMaxDynamicSharedMemorySize, LDS_BYTES) != hipSuccess) { fprintf(stderr, "kernel_launch: hipFuncSetAttribute failed\n"); grid = -1; return; }
        if (hipOccupancyMaxActiveBlocksPerMultiprocessor(&per_cu, (const void*)mk_fwd, NT, LDS_BYTES) != hipSuccess || per_cu < 1) { fprintf(stderr, "kernel_launch: occupancy query says %d blocks per CU; nothing launched\n", per_cu); grid = -1; return; }
        (void)hipGetLastError();
        grid = cus;
    }
    if (grid < 0) return;
    if (hipMemsetAsync((char*)d_ws + WS_CTL, 0, CTL_ZERO_BYTES, stream) != hipSuccess) return;
    Args a{};
    a.p.x = (const float*)d_in[0]; a.p.mem = (const float*)d_in[1]; a.p.pos = (const int*)d_in[2]; a.p.g_pre_mix = (const float*)d_in[3]; a.p.g_mem = (const float*)d_in[4];
    a.p.w_in = (const float*)d_in[5]; a.p.w_mem_kv = (const float*)d_in[6]; a.p.w_a = (const float*)d_in[7]; a.p.w_b = (const float*)d_in[8]; a.p.w_c = (const float*)d_in[9];
    a.p.w_out = (const float*)d_in[10]; a.p.g_post_mix = (const float*)d_in[11]; a.p.g_pre_ffn = (const float*)d_in[12]; a.p.w_ffn_in = (const float*)d_in[13]; a.p.w_ffn_out = (const float*)d_in[14];
    a.p.g_post_ffn = (const float*)d_in[15]; a.p.out = (float*)d_out; a.p.ws = (unsigned char*)d_ws;
#if MK_PER_PHASE
    for (int ph = 0; ph < N_PHASES; ++ph) { a.ph_lo = ph; a.ph_hi = ph + 1; hipLaunchKernelGGL(mk_fwd, dim3(grid), dim3(NT), LDS_BYTES, stream, a); }
#else
    a.ph_lo = 0; a.ph_hi = N_PHASES;
    hipLaunchKernelGGL(mk_fwd, dim3(grid), dim3(NT), LDS_BYTES, stream, a);
#endif
}
```

```cpp
#include <hip/hip_runtime.h>
#include <cstdio>
#include <cstdint>


typedef unsigned short bf16_t;
typedef _Float16 f16_t;
#define LAS __attribute__((address_space(3)))
#define GAS __attribute__((address_space(1)))
constexpr int S = 8192, D = 2048, NMEM = 256;
constexpr int AW = 1024, IQW = 1024, IDXD = 64, NIH = 16, RQK = 1024, RVW = 2048, MW = 1024;
constexpr int INC = 17488, DFF = 5632;
constexpr int C_AQ = 0, C_AK = 1024, C_AV = 2048, C_IQ = 3072, C_IK = 4096, C_IW = 4160, C_RQ = 4176, C_RK = 5200, C_RV = 6224, C_RG = 8272, C_MQ = 10320, C_GT = 11344;
static_assert(C_GT + 3 * D == INC, "cols");
constexpr float EPS = 1e-6f;
constexpr int NP_IN = 69 * 256;
constexpr int NWAVES = 8, NT = NWAVES * 64;

constexpr size_t MiB = 1u << 20;
constexpr size_t WS_CTL = 0, CTL_ZERO_BYTES = 1 * MiB;
constexpr size_t WS_WIN = 2 * MiB, WS_WMEMKV = 71 * MiB, WS_WA = 79 * MiB, WS_WB = 83 * MiB, WS_WC = 91 * MiB, WS_WOUT = 95 * MiB, WS_WFFIN = 103 * MiB, WS_WFFOUT = 147 * MiB;
constexpr size_t WS_XN = 169 * MiB, WS_MEMN = 201 * MiB, WS_ROPE128 = 202 * MiB, WS_ROPE64 = 206 * MiB;
constexpr size_t WS_AQ = 208 * MiB, WS_AK = 224 * MiB, WS_AV = 240 * MiB, WS_IQ = 256 * MiB, WS_RQ = 272 * MiB, WS_RK = 288 * MiB, WS_MQ = 304 * MiB;
constexpr size_t WS_RV = 320 * MiB, WS_RG = 352 * MiB, WS_GATES = 384 * MiB;
constexpr size_t WS_IK = 480 * MiB, WS_IW = 481 * MiB, WS_MEMK = 482 * MiB, WS_MVT = 483 * MiB, WS_MASK = 484 * MiB, WS_PREV = 492 * MiB, WS_RKT = 524 * MiB;
constexpr size_t WS_AVT = 240 * MiB;
constexpr size_t WS_RVT = 320 * MiB;
constexpr size_t WS_OA = WS_IQ, WS_OC = WS_XN, WS_OB = WS_RG;
constexpr size_t WS_KVS = 2 * MiB;
constexpr size_t WS_MIXED = 2 * MiB, WS_MIXEDB = 208 * MiB, WS_Y = 272 * MiB, WS_ACT = 384 * MiB;
constexpr size_t WS_END = 540 * MiB;
static_assert(WS_WIN + (size_t)NP_IN * D * 2 == WS_WMEMKV, "in-proj and mem-kv weight copies must be contiguous");
static_assert(WS_XN + (size_t)S * D * 2 == WS_MEMN, "XN and MEMN must be contiguous");

__device__ __forceinline__ float bf2f(bf16_t b) { return __uint_as_float(((unsigned)b) << 16); }
__device__ __forceinline__ bf16_t f2bf(float f) { unsigned u = __float_as_uint(f); return (bf16_t)((u + 0x7fffu + ((u >> 16) & 1u)) >> 16); }
__device__ __forceinline__ unsigned pk2(float lo, float hi) { return (unsigned)f2bf(lo) | ((unsigned)f2bf(hi) << 16); }
__device__ __forceinline__ unsigned pkh2(float lo, float hi) { const f16_t a = (f16_t)lo, b = (f16_t)hi; return (unsigned)__builtin_bit_cast(unsigned short, a) | ((unsigned)__builtin_bit_cast(unsigned short, b) << 16); }
__device__ __forceinline__ float wave_sum(float v) {
#pragma unroll
    for (int o = 1; o < 64; o <<= 1) v += __shfl_xor(v, o);
    return v;
}
__device__ __forceinline__ float wave_max(float v) {
#pragma unroll
    for (int o = 1; o < 64; o <<= 1) v = fmaxf(v, __shfl_xor(v, o));
    return v;
}
__device__ __forceinline__ float sigmoidf_(float x) { return 1.0f / (1.0f + __expf(-x)); }
__device__ __forceinline__ float siluf_(float x) { return x / (1.0f + __expf(-x)); }

__constant__ double ROPE_FREQ[64] = {1.0, 0.8659643233600653, 0.7498942093324559, 0.6493816315762113, 0.5623413251903491, 0.4869675251658631, 0.4216965034285822, 0.3651741272548377, 0.31622776601683794, 0.27384196342643613, 0.23713737056616552, 0.2053525026457146, 0.1778279410038923, 0.1539926526059492, 0.1333521432163324, 0.11547819846894582, 0.1, 0.08659643233600653, 0.07498942093324558, 0.06493816315762113, 0.05623413251903491, 0.04869675251658631, 0.042169650342858224, 0.03651741272548377, 0.03162277660168379, 0.027384196342643614, 0.023713737056616554, 0.02053525026457146, 0.01778279410038923, 0.01539926526059492, 0.01333521432163324, 0.011547819846894581, 0.01, 0.008659643233600654, 0.007498942093324558, 0.006493816315762113, 0.005623413251903491, 0.004869675251658631, 0.004216965034285823, 0.003651741272548377, 0.0031622776601683794, 0.0027384196342643613, 0.0023713737056616554, 0.002053525026457146, 0.0017782794100389228, 0.001539926526059492, 0.001333521432163324, 0.0011547819846894581, 0.001, 0.0008659643233600654, 0.0007498942093324559, 0.0006493816315762113, 0.0005623413251903491, 0.0004869675251658631, 0.00042169650342858224, 0.0003651741272548377, 0.00031622776601683794, 0.0002738419634264361, 0.00023713737056616554, 0.0002053525026457146, 0.00017782794100389227, 0.0001539926526059492, 0.0001333521432163324, 0.00011547819846894582};

__device__ __forceinline__ void sincos_d(double a, float& s, float& c) {
    const double n = rint(a * 0.63661977236758134308);
    double r = fma(-n, 1.57079632679489655800, a);
    r = fma(-n, 6.12323399573676603587e-17, r);
    const double r2 = r * r;
    double sp = -7.6471637318198164759e-13;
    sp = fma(sp, r2, 1.6059043836821614599e-10); sp = fma(sp, r2, -2.5052108385441718775e-08); sp = fma(sp, r2, 2.7557319223985890653e-06);
    sp = fma(sp, r2, -1.9841269841269841270e-04); sp = fma(sp, r2, 8.3333333333333333333e-03); sp = fma(sp, r2, -1.6666666666666666667e-01);
    const double sn = fma(sp * r2, r, r);
    double cp = 4.7794773323873852974e-14;
    cp = fma(cp, r2, -1.1470745597729724714e-11); cp = fma(cp, r2, 2.0876756987868098979e-09); cp = fma(cp, r2, -2.7557319223985890653e-07);
    cp = fma(cp, r2, 2.4801587301587301587e-05); cp = fma(cp, r2, -1.3888888888888888889e-03); cp = fma(cp, r2, 4.1666666666666666667e-02); cp = fma(cp, r2, -0.5);
    const double cs = fma(cp, r2, 1.0);
    const int q = ((int)n) & 3;
    const double ss = (q == 0) ? sn : (q == 1) ? cs : (q == 2) ? -sn : -cs;
    const double cc = (q == 0) ? cs : (q == 1) ? -sn : (q == 2) ? -cs : sn;
    s = (float)ss; c = (float)cc;
}
namespace pg8 {
#define PG8_LAS __attribute__((address_space(3)))
typedef unsigned short bf16_t;
typedef short bf16x8 __attribute__((ext_vector_type(8)));
typedef float f32x4 __attribute__((ext_vector_type(4)));
typedef unsigned u32x4 __attribute__((ext_vector_type(4)));
constexpr int BM = 256, BK = 64, HALF = 128, HTB = HALF * BK * 2  , STAGE_BYTES = 8 * HTB, NXCD = 8, WGM = 8;

__host__ __device__ __forceinline__ int lds_byte(int r, int c) { const int st = (r >> 4) * 2 + (c >> 5), rr = r & 15, cc = c & 31, ob = rr * 64 + cc * 2; return st * 1024 + (ob ^ (((ob >> 9) & 1) << 5)); }
__host__ __device__ __forceinline__ void stage_rc(int b, int& R, int& C) { const int st = b / 1024, sb = b % 1024, swz = sb ^ (((sb >> 9) & 1) << 5); R = (st >> 1) * 16 + swz / 64; C = (st & 1) * 32 + (swz % 64) / 2; }
__host__ __device__ __forceinline__ int perm32(int rho) { const int n = rho >> 4, i = rho & 15; return 8 * (i >> 2) + 4 * n + (i & 3); }

struct Unit { int pm, pn; };
struct Gemm { const bf16_t* A; const bf16_t* Bt; int M, N, K; };

struct StaticOrder {
    int nM, nN, nwg, G, c;
    __host__ __device__ void init(int M, int N, int G_, int c_) { nM = M / BM; nN = N / BM; nwg = nM * nN; G = G_; c = c_; }
    __host__ __device__ bool next(int i, Unit& u) const {
        const long L = (long)i * G + c; if (L >= nwg) return false;
        int wgid = (int)L; { const int q = nwg / NXCD, r = nwg % NXCD, xcd = wgid % NXCD, off = wgid / NXCD; wgid = (xcd < r ? xcd * (q + 1) : r * (q + 1) + (xcd - r) * q) + off; }
        const int nig = WGM * nN, gid = wgid / nig, fm = gid * WGM, gsz = (nM - fm) < WGM ? (nM - fm) : WGM;
        u.pm = fm + ((wgid % nig) % gsz); u.pn = (wgid % nig) / gsz; return true;
    }
    __device__ __forceinline__ void a_ready(const Unit&) const {}
    __device__ __forceinline__ void done(const Unit&) const {}
};

__device__ __forceinline__ unsigned cvt_pk_bf16(float lo, float hi) { unsigned r; asm volatile("v_cvt_pk_bf16_f32 %0, %1, %2" : "=v"(r) : "v"(lo), "v"(hi)); return r; }
__device__ __forceinline__ unsigned cvt_pk_f16(float lo, float hi) { const _Float16 a = (_Float16)lo, b = (_Float16)hi; return (unsigned)__builtin_bit_cast(unsigned short, a) | ((unsigned)__builtin_bit_cast(unsigned short, b) << 16); }
__device__ __forceinline__ bf16_t f2bf_dev(float f) { unsigned u = __float_as_uint(f); return (bf16_t)((u + 0x7fffu + ((u >> 16) & 1u)) >> 16); }
__device__ __forceinline__ int tokperm(int s) { return (s & ~12) | ((s & 4) << 1) | ((s & 8) >> 1); }
__device__ __forceinline__ float ret_l2gamma(int h) { return log1pf(-exp2f(-5.0f - (float)h)) * 1.4426950408889634f; }
__device__ __forceinline__ float ep_sigmoid(float x) { return __builtin_amdgcn_rcpf(1.0f + __builtin_amdgcn_exp2f(-1.4426950408889634f * x)); }
__device__ __forceinline__ float ep_silu(float x) { return x * ep_sigmoid(x); }

struct EpiInProj {
    static constexpr bool PERM = true, AFTER_DRAIN = false;
    unsigned char* ws;
    __device__ __forceinline__ void operator()(const f32x4 (&acc)[2][2][4][2], const Unit& u, int wr, int wc, int fr, int fq) const {
        const int pn = u.pn, row0 = u.pm * BM + wr * 64 + fr;
        if (pn < 8 || (pn >= 16 && pn < 24)) {
            const size_t doff = pn < 8 ? WS_AQ + (size_t)(pn >> 2) * (16u << 20) : WS_RQ + (size_t)((pn - 16) >> 2) * (16u << 20);
            bf16_t* dst = (bf16_t*)(ws + doff); const float* R128 = (const float*)(ws + WS_ROPE128);
            const float sc0 = pn < 4 ? 0.08838834764831845f * 1.4426950408889634f : pn >= 20 ? 0.08838834764831845f : 1.0f;
            const int head = (pn & 3) * 2 + (wc >> 1), j0 = 32 * (wc & 1) + 8 * fq;
            const bool isrq = pn >= 16 && pn < 20, isrk = pn >= 20;
            const float l2g = ret_l2gamma(head);
#pragma unroll
            for (int ai = 0; ai < 2; ++ai)
#pragma unroll
                for (int m = 0; m < 4; ++m) {
                    const int row = row0 + ai * HALF + m * 16;
                    const f32x4* tb = (const f32x4*)(R128 + ((size_t)row * 64 + j0) * 2);
                    const f32x4 t0 = tb[0], t1 = tb[1], t2 = tb[2], t3 = tb[3];
                    const f32x4 a0 = acc[ai][0][m][0], a1 = acc[ai][0][m][1], b0 = acc[ai][1][m][0], b1 = acc[ai][1][m][1];
                    float y1[8], y2[8];
                    y1[0] = a0[0] * t0[0] - b0[0] * t0[1]; y1[1] = a0[1] * t0[2] - b0[1] * t0[3]; y1[2] = a0[2] * t1[0] - b0[2] * t1[1]; y1[3] = a0[3] * t1[2] - b0[3] * t1[3];
                    y1[4] = a1[0] * t2[0] - b1[0] * t2[1]; y1[5] = a1[1] * t2[2] - b1[1] * t2[3]; y1[6] = a1[2] * t3[0] - b1[2] * t3[1]; y1[7] = a1[3] * t3[2] - b1[3] * t3[3];
                    y2[0] = b0[0] * t0[0] + a0[0] * t0[1]; y2[1] = b0[1] * t0[2] + a0[1] * t0[3]; y2[2] = b0[2] * t1[0] + a0[2] * t1[1]; y2[3] = b0[3] * t1[2] + a0[3] * t1[3];
                    y2[4] = b1[0] * t2[0] + a1[0] * t2[1]; y2[5] = b1[1] * t2[2] + a1[1] * t2[3]; y2[6] = b1[2] * t3[0] + a1[2] * t3[1]; y2[7] = b1[3] * t3[2] + a1[3] * t3[3];
                    const float fi = (float)(row & 127);
                    const float sc = isrq ? __builtin_amdgcn_exp2f(fi * l2g) : isrk ? sc0 * __builtin_amdgcn_exp2f(-fi * l2g) : sc0;
                    u32x4 w1, w2;
                    w1.x = cvt_pk_bf16(y1[0] * sc, y1[1] * sc); w1.y = cvt_pk_bf16(y1[2] * sc, y1[3] * sc); w1.z = cvt_pk_bf16(y1[4] * sc, y1[5] * sc); w1.w = cvt_pk_bf16(y1[6] * sc, y1[7] * sc);
                    w2.x = cvt_pk_bf16(y2[0] * sc, y2[1] * sc); w2.y = cvt_pk_bf16(y2[2] * sc, y2[3] * sc); w2.z = cvt_pk_bf16(y2[4] * sc, y2[5] * sc); w2.w = cvt_pk_bf16(y2[6] * sc, y2[7] * sc);
                    bf16_t* o = dst + (size_t)row * 1024 + head * 128 + j0;
                    *(u32x4*)o = w1; *(u32x4*)(o + 64) = w2;
                    if (isrk) {
                        const float kt = sc0 * __builtin_amdgcn_exp2f((127.0f - fi) * l2g);
                        bf16_t* tp = (bf16_t*)(ws + WS_RKT) + ((size_t)head * 128 + j0) * S + tokperm(row);
#pragma unroll
                        for (int e = 0; e < 8; ++e) { tp[(size_t)e * S] = f2bf_dev(y1[e] * kt); tp[(size_t)(64 + e) * S] = f2bf_dev(y2[e] * kt); }
                    }
                }
        } else if ((pn >= 12 && pn < 16) || pn == 68) {
            const bool isq = pn != 68;
            if (isq || wc == 0) {
                unsigned short* dst = (unsigned short*)(ws + (isq ? WS_IQ : WS_IK)); const float* R64 = (const float*)(ws + WS_ROPE64); const int ld = isq ? 1024 : 64, hoff = isq ? ((pn - 12) * 4 + wc) * 64 : 0, j0 = 8 * fq;
                const float sc = isq ? 0.125f : 1.0f;
#pragma unroll
                for (int ai = 0; ai < 2; ++ai)
#pragma unroll
                    for (int m = 0; m < 4; ++m) {
                        const int row = row0 + ai * HALF + m * 16;
                        const f32x4* tb = (const f32x4*)(R64 + ((size_t)row * 32 + j0) * 2);
                        const f32x4 t0 = tb[0], t1 = tb[1], t2 = tb[2], t3 = tb[3];
                        const f32x4 a0 = acc[ai][0][m][0], a1 = acc[ai][0][m][1], b0 = acc[ai][1][m][0], b1 = acc[ai][1][m][1];
                        u32x4 w1, w2;
                        w1.x = cvt_pk_f16((a0[0] * t0[0] - b0[0] * t0[1]) * sc, (a0[1] * t0[2] - b0[1] * t0[3]) * sc);
                        w1.y = cvt_pk_f16((a0[2] * t1[0] - b0[2] * t1[1]) * sc, (a0[3] * t1[2] - b0[3] * t1[3]) * sc);
                        w1.z = cvt_pk_f16((a1[0] * t2[0] - b1[0] * t2[1]) * sc, (a1[1] * t2[2] - b1[1] * t2[3]) * sc);
                        w1.w = cvt_pk_f16((a1[2] * t3[0] - b1[2] * t3[1]) * sc, (a1[3] * t3[2] - b1[3] * t3[3]) * sc);
                        w2.x = cvt_pk_f16((b0[0] * t0[0] + a0[0] * t0[1]) * sc, (b0[1] * t0[2] + a0[1] * t0[3]) * sc);
                        w2.y = cvt_pk_f16((b0[2] * t1[0] + a0[2] * t1[1]) * sc, (b0[3] * t1[2] + a0[3] * t1[3]) * sc);
                        w2.z = cvt_pk_f16((b1[0] * t2[0] + a1[0] * t2[1]) * sc, (b1[1] * t2[2] + a1[1] * t2[3]) * sc);
                        w2.w = cvt_pk_f16((b1[2] * t3[0] + a1[2] * t3[1]) * sc, (b1[3] * t3[2] + a1[3] * t3[3]) * sc);
                        unsigned short* o = dst + (size_t)row * ld + hoff + j0;
                        *(u32x4*)o = w1; *(u32x4*)(o + 32) = w2;
                    }
            } else if (wc == 1 && fq < 2) {
#pragma unroll
                for (int ai = 0; ai < 2; ++ai)
#pragma unroll
                    for (int m = 0; m < 4; ++m) {
                        const int row = row0 + ai * HALF + m * 16;
                        float* o = (float*)(ws + WS_IW) + (size_t)row * 16 + 8 * fq;
                        *(f32x4*)o = acc[ai][0][m][0] * 0.25f; *(f32x4*)(o + 4) = acc[ai][0][m][1] * 0.25f;
                    }
            }
        } else {
            size_t doff; int ld, pl, act = 0, roff = 0, tr = 0, tld = S; float sc = 1.0f;
            if (pn < 12) { doff = WS_AVT; ld = 1024; pl = pn - 8; tr = 1; }
            else if (pn < 32) { doff = WS_RVT; ld = 2048; pl = pn - 24; tr = 1; }
            else if (pn < 40) { doff = WS_RG; ld = 2048; pl = pn - 32; act = 1; }
            else if (pn < 44) { doff = WS_MQ; ld = 1024; pl = pn - 40; sc = 0.0625f * 1.4426950408889634f; }
            else if (pn < 68) { doff = WS_GATES; ld = 6144; pl = pn - 44; act = 2; }
            else if (pn < 73) { doff = WS_MEMK; ld = 1024; pl = pn - 69; roff = S; }
            else { doff = WS_MVT; ld = 1024; pl = pn - 73; roff = S; tr = 1; tld = NMEM; }
            bf16_t* dst = (bf16_t*)(ws + doff);
            const int col0 = pl * BM + wc * 32 + 8 * fq;
            if (tr) {
#pragma unroll
                for (int ai = 0; ai < 2; ++ai)
#pragma unroll
                    for (int m = 0; m < 4; ++m) {
                        const int row = row0 - roff + ai * HALF + m * 16;
                        bf16_t* tp = dst + (size_t)col0 * tld + tokperm(row);
#pragma unroll
                        for (int bj = 0; bj < 2; ++bj) {
                            const f32x4 v0 = acc[ai][bj][m][0], v1 = acc[ai][bj][m][1];
#pragma unroll
                            for (int e = 0; e < 4; ++e) { tp[(size_t)(bj * HALF + e) * tld] = f2bf_dev(v0[e]); tp[(size_t)(bj * HALF + 4 + e) * tld] = f2bf_dev(v1[e]); }
                        }
                    }
                return;
            }
#pragma unroll
            for (int ai = 0; ai < 2; ++ai)
#pragma unroll
                for (int m = 0; m < 4; ++m) {
                    bf16_t* rowp = dst + (size_t)(row0 - roff + ai * HALF + m * 16) * ld + col0;
#pragma unroll
                    for (int bj = 0; bj < 2; ++bj) {
                        f32x4 v0 = acc[ai][bj][m][0], v1 = acc[ai][bj][m][1];
                        if (act == 1) { v0 = (f32x4){ep_silu(v0[0]), ep_silu(v0[1]), ep_silu(v0[2]), ep_silu(v0[3])}; v1 = (f32x4){ep_silu(v1[0]), ep_silu(v1[1]), ep_silu(v1[2]), ep_silu(v1[3])}; }
                        else if (act == 2) { v0 = (f32x4){ep_sigmoid(v0[0]), ep_sigmoid(v0[1]), ep_sigmoid(v0[2]), ep_sigmoid(v0[3])}; v1 = (f32x4){ep_sigmoid(v1[0]), ep_sigmoid(v1[1]), ep_sigmoid(v1[2]), ep_sigmoid(v1[3])}; }
                        else { v0 = v0 * sc; v1 = v1 * sc; }
                        u32x4 w; w.x = cvt_pk_bf16(v0[0], v0[1]); w.y = cvt_pk_bf16(v0[2], v0[3]); w.z = cvt_pk_bf16(v1[0], v1[1]); w.w = cvt_pk_bf16(v1[2], v1[3]);
                        *(u32x4*)(rowp + bj * HALF) = w;
                    }
                }
        }
    }
};

struct EpiGateAcc {
    static constexpr bool PERM = true, AFTER_DRAIN = false;
    float* F; bf16_t* OB; const bf16_t* G; int ldc, ldg, first, last;
    __device__ __forceinline__ void operator()(const f32x4 (&acc)[2][2][4][2], const Unit& u, int wr, int wc, int fr, int fq) const {
        const int row0 = u.pm * BM + wr * 64 + fr, col0 = u.pn * BM + wc * 32 + 8 * fq;
#pragma unroll
        for (int ai = 0; ai < 2; ++ai)
#pragma unroll
            for (int m = 0; m < 4; ++m) {
                const int row = row0 + ai * HALF + m * 16;
#pragma unroll
                for (int bj = 0; bj < 2; ++bj) {
                    const int col = col0 + bj * HALF;
                    const u32x4 gw = *(const u32x4*)(G + (size_t)row * ldg + col);
                    f32x4 g0, g1;
                    g0[0] = __uint_as_float(gw.x << 16); g0[1] = __uint_as_float(gw.x & 0xffff0000u); g0[2] = __uint_as_float(gw.y << 16); g0[3] = __uint_as_float(gw.y & 0xffff0000u);
                    g1[0] = __uint_as_float(gw.z << 16); g1[1] = __uint_as_float(gw.z & 0xffff0000u); g1[2] = __uint_as_float(gw.w << 16); g1[3] = __uint_as_float(gw.w & 0xffff0000u);
                    f32x4 v0 = acc[ai][bj][m][0] * g0, v1 = acc[ai][bj][m][1] * g1;
                    float* fp = F + (size_t)row * ldc + col;
                    if (!first) { v0 += *(const f32x4*)fp; v1 += *(const f32x4*)(fp + 4); }
                    if (last) { u32x4 w; w.x = cvt_pk_bf16(v0[0], v0[1]); w.y = cvt_pk_bf16(v0[2], v0[3]); w.z = cvt_pk_bf16(v1[0], v1[1]); w.w = cvt_pk_bf16(v1[2], v1[3]); *(u32x4*)(OB + (size_t)row * ldc + col) = w; }
                    else { *(f32x4*)fp = v0; *(f32x4*)(fp + 4) = v1; }
                }
            }
    }
};

struct EpiF32 {
    static constexpr bool PERM = true, AFTER_DRAIN = false;
    float* O; int ldc;
    __device__ __forceinline__ void operator()(const f32x4 (&acc)[2][2][4][2], const Unit& u, int wr, int wc, int fr, int fq) const {
        const int row0 = u.pm * BM + wr * 64 + fr, col0 = u.pn * BM + wc * 32 + 8 * fq;
#pragma unroll
        for (int ai = 0; ai < 2; ++ai)
#pragma unroll
            for (int m = 0; m < 4; ++m)
#pragma unroll
                for (int bj = 0; bj < 2; ++bj) { float* fp = O + (size_t)(row0 + ai * HALF + m * 16) * ldc + col0 + bj * HALF; *(f32x4*)fp = acc[ai][bj][m][0]; *(f32x4*)(fp + 4) = acc[ai][bj][m][1]; }
    }
};

struct EpiSwiGLU {
    static constexpr bool PERM = true, AFTER_DRAIN = false;
    bf16_t* O; int ldc;
    __device__ __forceinline__ void operator()(const f32x4 (&acc)[2][2][4][2], const Unit& u, int wr, int wc, int fr, int fq) const {
        const int row0 = u.pm * BM + wr * 64 + fr, col0 = u.pn * HALF + wc * 32 + 8 * fq;
#pragma unroll
        for (int ai = 0; ai < 2; ++ai)
#pragma unroll
            for (int m = 0; m < 4; ++m) {
                const f32x4 g0 = acc[ai][0][m][0], g1 = acc[ai][0][m][1], u0 = acc[ai][1][m][0], u1 = acc[ai][1][m][1];
                u32x4 w;
                w.x = cvt_pk_bf16(ep_silu(g0[0]) * u0[0], ep_silu(g0[1]) * u0[1]); w.y = cvt_pk_bf16(ep_silu(g0[2]) * u0[2], ep_silu(g0[3]) * u0[3]);
                w.z = cvt_pk_bf16(ep_silu(g1[0]) * u1[0], ep_silu(g1[1]) * u1[1]); w.w = cvt_pk_bf16(ep_silu(g1[2]) * u1[2], ep_silu(g1[3]) * u1[3]);
                *(u32x4*)(O + (size_t)(row0 + ai * HALF + m * 16) * ldc + col0) = w;
            }
    }
};

struct InProjOrder {
    StaticOrder so; int G, c;
    __device__ void init(int G_, int c_) { so.init(8192, 69 * 256, G_, c_); G = G_; c = c_; }
    __device__ bool next(int i, Unit& u) const {
        const long L = (long)i * G + c;
        if (L < so.nwg) return so.next(i, u);
        if (L < so.nwg + 8) { u.pm = 32; u.pn = 69 + (int)(L - so.nwg); return true; }
        return false;
    }
    __device__ __forceinline__ void a_ready(const Unit&) const {}
    __device__ __forceinline__ void done(const Unit&) const {}
};

template <class Epi, class Sched, bool ALIGN_EPI = false, bool SP2 = false>
__device__ __forceinline__ void gemm_phase(PG8_LAS unsigned char* lds, const Gemm g, const Sched& S, const Epi& E) {
    const int tid = threadIdx.x, wid = __builtin_amdgcn_readfirstlane(tid >> 6), lane = tid & 63, wr = wid >> 2, wc = wid & 3, fr = lane & 15, fq = lane >> 4;
    const int K = g.K, nt = K / BK;
    unsigned voffA[2], voffB[2];
#pragma unroll
    for (int i = 0; i < 2; ++i) { int R, C; stage_rc(tid * 16 + i * 8192, R, C); const int Rb = Epi::PERM ? ((R & ~31) + perm32(R & 31)) : R;
        voffA[i] = (unsigned)(R * K + C) * 2u; voffB[i] = (unsigned)(Rb * K + C) * 2u; }
    const size_t kstep = (size_t)(BK * 2);
    const size_t hstep = (size_t)HALF * K * 2;
    const size_t tstep = 2 * hstep;
    const unsigned ldsw = (unsigned)wid * 1024u;
    const int aoff = lds_byte(wr * 64 + fr, fq * 8), boff = lds_byte(wc * 32 + fr, fq * 8);
#define PG8_SA(b, h) (((b) * 2 + (h)) * HTB)
#define PG8_SB(b, h) ((4 + (b) * 2 + (h)) * HTB)
#define PG8_STAGE(bufoff, gbase, voff) do { _Pragma("unroll") for (int _i = 0; _i < 2; ++_i) \
        __builtin_amdgcn_global_load_lds((const unsigned*)((const char*)(gbase) + (voff)[_i]), (PG8_LAS unsigned*)(lds + (bufoff) + ldsw + _i * 8192), 16, 0, 0); } while (0)
#define PG8_LDA(dst, b, h) do { _Pragma("unroll") for (int m = 0; m < 4; ++m) _Pragma("unroll") for (int k = 0; k < 2; ++k) dst[m][k] = *(const PG8_LAS bf16x8*)(lds + PG8_SA(b, h) + aoff + m * 2048 + k * 1024); } while (0)
#define PG8_LDB(dst, b, h) do { _Pragma("unroll") for (int n = 0; n < 2; ++n) _Pragma("unroll") for (int k = 0; k < 2; ++k) dst[n][k] = *(const PG8_LAS bf16x8*)(lds + PG8_SB(b, h) + boff + n * 2048 + k * 1024); } while (0)
#define PG8_MMA(ai, bj, At, Bt) do { __builtin_amdgcn_s_setprio(1); _Pragma("unroll") for (int m = 0; m < 4; ++m) _Pragma("unroll") for (int n = 0; n < 2; ++n) _Pragma("unroll") for (int k = 0; k < 2; ++k) \
        acc[ai][bj][m][n] = __builtin_amdgcn_mfma_f32_16x16x32_bf16(Bt[n][k], At[m][k], acc[ai][bj][m][n], 0, 0, 0); __builtin_amdgcn_s_setprio(0); } while (0)
#define PG8_WAIT_V(n) asm volatile("s_waitcnt vmcnt(" #n ")" ::: "memory")
#define PG8_WAIT_L(n) asm volatile("s_waitcnt lgkmcnt(" #n ")" ::: "memory")
#define PG8_BAR __builtin_amdgcn_s_barrier()
#define PG8_SCHED __builtin_amdgcn_sched_barrier(0)
    Unit cur, nxt; int ui = 0;
    if (!S.next(0, cur)) return;
    f32x4 acc[2][2][4][2];
#pragma unroll
    for (int a = 0; a < 2; ++a)
#pragma unroll
        for (int b = 0; b < 2; ++b)
#pragma unroll
            for (int m = 0; m < 4; ++m)
#pragma unroll
                for (int n = 0; n < 2; ++n) acc[a][b][m][n] = (f32x4){0.f, 0.f, 0.f, 0.f};
    bf16x8 At[4][2], B0[2][2], B1[2][2];
    const char* cA = (const char*)g.A + (size_t)cur.pm * tstep; const char* cB = (const char*)g.Bt + (size_t)cur.pn * tstep;
    S.a_ready(cur);
    if constexpr (SP2) {
        PG8_STAGE(PG8_SB(0, 0), cB, voffB); PG8_STAGE(PG8_SB(0, 1), cB + hstep, voffB); PG8_STAGE(PG8_SA(0, 0), cA, voffA); PG8_STAGE(PG8_SA(0, 1), cA + hstep, voffA);
        if (wr == 1) PG8_BAR;
        PG8_WAIT_V(2); PG8_BAR;
        PG8_STAGE(PG8_SB(1, 0), cB + kstep, voffB); PG8_STAGE(PG8_SA(1, 0), cA + kstep, voffA); PG8_STAGE(PG8_SB(1, 1), cB + hstep + kstep, voffB);
        PG8_WAIT_V(6); PG8_BAR;
    } else {
        PG8_STAGE(PG8_SB(0, 0), cB, voffB); PG8_STAGE(PG8_SA(0, 0), cA, voffA); PG8_STAGE(PG8_SB(0, 1), cB + hstep, voffB); PG8_STAGE(PG8_SA(0, 1), cA + hstep, voffA);
        if (wr == 1) PG8_BAR;
        PG8_WAIT_V(4); PG8_BAR;
        PG8_STAGE(PG8_SB(1, 0), cB + kstep, voffB); PG8_STAGE(PG8_SA(1, 0), cA + kstep, voffA); PG8_STAGE(PG8_SB(1, 1), cB + hstep + kstep, voffB);
        PG8_WAIT_V(6); PG8_BAR;
    }
    for (;;) {
        const bool has_next = S.next(ui + 1, nxt);
        const char* nA = has_next ? (const char*)g.A + (size_t)nxt.pm * tstep : cA; const char* nB = has_next ? (const char*)g.Bt + (size_t)nxt.pn * tstep : cB;
        for (int t = 0; t < nt; t += 2) {
            const bool last = (t == nt - 2);
            const char* a1 = cA + (size_t)(t + 1) * kstep;
            const char* a2 = last ? nA : cA + (size_t)(t + 2) * kstep; const char* b2 = last ? nB : cB + (size_t)(t + 2) * kstep;
            const char* a3 = a2 + kstep; const char* b3 = b2 + kstep;
            if (last && has_next) S.a_ready(nxt);
            if constexpr (SP2) {
            PG8_LDB(B0, 0, 0); PG8_LDB(B1, 0, 1); PG8_SCHED; PG8_LDA(At, 0, 0); PG8_STAGE(PG8_SA(1, 1), a1 + hstep, voffA);
            PG8_WAIT_V(8); PG8_WAIT_L(0); PG8_BAR; PG8_MMA(0, 0, At, B0); PG8_MMA(0, 1, At, B1); PG8_BAR; PG8_SCHED;
            PG8_LDA(At, 0, 1); PG8_STAGE(PG8_SB(0, 0), b2, voffB); PG8_STAGE(PG8_SB(0, 1), b2 + hstep, voffB); PG8_STAGE(PG8_SA(0, 0), a2, voffA);
            PG8_WAIT_V(8); PG8_WAIT_L(0); PG8_BAR; PG8_MMA(1, 0, At, B0); PG8_MMA(1, 1, At, B1); PG8_BAR; PG8_SCHED;
            PG8_LDB(B0, 1, 0); PG8_LDB(B1, 1, 1); PG8_SCHED; PG8_LDA(At, 1, 0); PG8_STAGE(PG8_SA(0, 1), a2 + hstep, voffA);
            PG8_WAIT_V(8); PG8_WAIT_L(0); PG8_BAR; PG8_MMA(0, 0, At, B0); PG8_MMA(0, 1, At, B1); PG8_BAR; PG8_SCHED;
            PG8_LDA(At, 1, 1); PG8_STAGE(PG8_SB(1, 0), b3, voffB); PG8_STAGE(PG8_SB(1, 1), b3 + hstep, voffB); PG8_STAGE(PG8_SA(1, 0), a3, voffA);
            PG8_WAIT_V(8); PG8_WAIT_L(0); PG8_BAR; PG8_MMA(1, 0, At, B0); PG8_MMA(1, 1, At, B1); PG8_BAR; PG8_SCHED;
            } else {
            PG8_LDB(B0, 0, 0); PG8_SCHED; PG8_LDA(At, 0, 0); PG8_STAGE(PG8_SA(1, 1), a1 + hstep, voffA);
            PG8_WAIT_L(8); PG8_BAR; PG8_WAIT_L(0); PG8_MMA(0, 0, At, B0); PG8_BAR; PG8_SCHED;
            PG8_LDB(B1, 0, 1); PG8_STAGE(PG8_SB(0, 0), b2, voffB);
            PG8_BAR; PG8_WAIT_L(0); PG8_MMA(0, 1, At, B1); PG8_BAR;
            PG8_LDA(At, 0, 1); PG8_STAGE(PG8_SA(0, 0), a2, voffA);
            PG8_BAR; PG8_WAIT_L(0); PG8_MMA(1, 0, At, B0); PG8_BAR; PG8_SCHED;
            PG8_STAGE(PG8_SB(0, 1), b2 + hstep, voffB);
            PG8_WAIT_V(6); PG8_BAR; PG8_MMA(1, 1, At, B1); PG8_BAR;
            PG8_LDB(B0, 1, 0); PG8_SCHED; PG8_LDA(At, 1, 0); PG8_STAGE(PG8_SA(0, 1), a2 + hstep, voffA);
            PG8_WAIT_L(8); PG8_BAR; PG8_WAIT_L(0); PG8_MMA(0, 0, At, B0); PG8_BAR; PG8_SCHED;
            PG8_LDB(B1, 1, 1); PG8_STAGE(PG8_SB(1, 0), b3, voffB);
            PG8_BAR; PG8_WAIT_L(0); PG8_MMA(0, 1, At, B1); PG8_BAR;
            PG8_LDA(At, 1, 1); PG8_STAGE(PG8_SA(1, 0), a3, voffA);
            PG8_BAR; PG8_WAIT_L(0); PG8_MMA(1, 0, At, B0); PG8_BAR; PG8_SCHED;
            PG8_STAGE(PG8_SB(1, 1), b3 + hstep, voffB);
            PG8_WAIT_V(6); PG8_BAR; PG8_MMA(1, 1, At, B1); PG8_BAR;
            }
        }
        if constexpr (ALIGN_EPI) { if (wr == 0) PG8_BAR; }
        if constexpr (!Epi::AFTER_DRAIN) { E(acc, cur, wr, wc, fr, fq); S.done(cur); }
        if (!has_next) break;
#pragma unroll
        for (int a = 0; a < 2; ++a)
#pragma unroll
            for (int b = 0; b < 2; ++b)
#pragma unroll
                for (int m = 0; m < 4; ++m)
#pragma unroll
                    for (int n = 0; n < 2; ++n) acc[a][b][m][n] = (f32x4){0.f, 0.f, 0.f, 0.f};
        cur = nxt; cA = nA; cB = nB; ++ui;
        if constexpr (ALIGN_EPI) { if (wr == 1) PG8_BAR; }
    }
    PG8_WAIT_V(0);
    if constexpr (!ALIGN_EPI) { if (wr == 0) PG8_BAR; }
    PG8_BAR;
    if constexpr (Epi::AFTER_DRAIN) { E.fused(acc, cur, wr, wc, fr, fq, lds, wid, lane); S.done(cur); }
#undef PG8_SA
#undef PG8_SB
#undef PG8_STAGE
#undef PG8_LDA
#undef PG8_LDB
#undef PG8_MMA
#undef PG8_WAIT_V
#undef PG8_WAIT_L
#undef PG8_BAR
#undef PG8_SCHED
}
}

constexpr int RING_OFF = 0, RING_BYTES = 131072;
constexpr int LDSCTL_OFF = RING_BYTES, MISC_OFF = LDSCTL_OFF + 320;
constexpr int LDS_BYTES = 147456;
constexpr int CW_BAR = 4096;

typedef GAS unsigned gu32;
#define LDS_WAIT() asm volatile("s_waitcnt lgkmcnt(0)" ::: "memory")
#define XB_TMO      128
#define XB_XCNT(j)  (256  + 64 * (j))
#define XB_XSUB(j)  (1280 + 64 * (j))
#define XB_XGEN(j)  (2304 + 64 * (j))
#define XB_TOP      3328
#define XB_TOPGEN   3392
#define XCD_BAR_WORDS 3456
#define XB_SPIN_CAP (1u << 18)

__device__ __forceinline__ unsigned xb_ld(unsigned* p)              { return __hip_atomic_load(p, __ATOMIC_RELAXED, __HIP_MEMORY_SCOPE_AGENT); }
__device__ __forceinline__ unsigned xb_add(unsigned* p, unsigned v) { return __hip_atomic_fetch_add(p, v, __ATOMIC_RELAXED, __HIP_MEMORY_SCOPE_AGENT); }
__device__ __forceinline__ unsigned xb_xcc_id() { return (unsigned)__builtin_amdgcn_s_getreg((3 << 11) | 20) & 0xFu; }
#define XB_SPIN(cond, bar) do { unsigned _sp = 0; while (cond) { __builtin_amdgcn_s_sleep(1); \
    if ((++_sp & 255u) == 0u) { if (xb_ld(&(bar)[XB_TMO])) break; if (_sp > XB_SPIN_CAP) { atomicAdd(&(bar)[XB_TMO], 1u); break; } } } } while (0)

struct XcdBarrier {
    unsigned* bar; unsigned x;
    volatile LAS unsigned* st;
};

__device__ __forceinline__ XcdBarrier xcd_barrier_post(unsigned* bar, volatile LAS unsigned* st) {
    XcdBarrier b; b.bar = bar; b.x = xb_xcc_id(); b.st = st;
    if (threadIdx.x == 0) (void)xb_add(&bar[XB_XCNT(b.x)], 1u);
    return b;
}
__device__ __forceinline__ void xcd_barrier_complete(unsigned* bar, unsigned x, unsigned& nloc, unsigned& nx) {
    const unsigned G = gridDim.x * gridDim.y * gridDim.z;
    unsigned sum, cnt, mine, sp = 0u;
    for (;;) {
        sum = 0u; cnt = 0u; mine = 0u;
#pragma unroll
        for (unsigned j = 0; j < 16; ++j) { const unsigned c = xb_ld(&bar[XB_XCNT(j)]); sum += c; cnt += (c > 0u) ? 1u : 0u; mine = (j == x) ? c : mine; }
        if (sum == G) break;
        __builtin_amdgcn_s_sleep(1);
        if ((++sp & 255u) == 0u) { if (xb_ld(&bar[XB_TMO])) break; if (sp > XB_SPIN_CAP) { atomicAdd(&bar[XB_TMO], 1u); break; } }
    }
    nloc = mine > 0u ? mine : 1u; nx = cnt > 0u ? cnt : 1u;
}

__device__ __forceinline__ void xcd_barrier(const XcdBarrier& b) {
    asm volatile("s_waitcnt vmcnt(0)" ::: "memory");
    __syncthreads();
    if (threadIdx.x == 0) {
        unsigned* bar = b.bar;
        __builtin_amdgcn_s_waitcnt(0);
        unsigned nloc = b.st[0], nx = b.st[1];
        if (nloc == 0u) { xcd_barrier_complete(bar, b.x, nloc, nx); b.st[0] = nloc; b.st[1] = nx; }
        const unsigned old = xb_add(&bar[XB_XSUB(b.x)], 1u);
        const unsigned gen = old / nloc;
        if (old + 1u == (gen + 1u) * nloc) {
            __builtin_amdgcn_fence(__ATOMIC_RELEASE, "agent");
            asm volatile("s_waitcnt vmcnt(0)" ::: "memory");
            const unsigned og = xb_add(&bar[XB_TOP], 1u);
            const unsigned tg = og / nx;
            if (og + 1u == (tg + 1u) * nx) xb_add(&bar[XB_TOPGEN], 1u);
            else XB_SPIN(xb_ld(&bar[XB_TOPGEN]) == tg, bar);
            __builtin_amdgcn_fence(__ATOMIC_ACQUIRE, "agent");
            xb_add(&bar[XB_XGEN(b.x)], 1u);
            asm volatile("s_waitcnt vmcnt(0)" ::: "memory");
        } else {
            XB_SPIN(xb_ld(&bar[XB_XGEN(b.x)]) == gen, bar);
            __builtin_amdgcn_fence(__ATOMIC_ACQUIRE, "agent");
            asm volatile("s_waitcnt vmcnt(0)" ::: "memory");
        }
    }
    __syncthreads();
}

__device__ __forceinline__ int map_inproj(int np) {
    const int pn = np >> 8, p = np & 255, bj = p >> 7, q = p & 127;
    if (pn < 8 || (pn >= 16 && pn < 24)) { const int base = pn < 4 ? C_AQ : pn < 8 ? C_AK : pn < 20 ? C_RQ : C_RK; return base + ((pn & 3) * 2 + (q >> 6)) * 128 + bj * 64 + (q & 63); }
    if (pn >= 12 && pn < 16) return C_IQ + ((pn - 12) * 4 + (q >> 5)) * 64 + bj * 32 + (q & 31);
    if (pn == 68) { if (p < 32) return C_IK + p; if (p < 48) return C_IW + (p - 32); if (p >= 128 && p < 160) return C_IK + 32 + (p - 128); return -1; }
    int base, pl;
    if (pn < 12) { base = C_AV; pl = pn - 8; } else if (pn < 32) { base = C_RV; pl = pn - 24; } else if (pn < 40) { base = C_RG; pl = pn - 32; } else if (pn < 44) { base = C_MQ; pl = pn - 40; } else { base = C_GT; pl = pn - 44; }
    return base + pl * 256 + p;
}
__device__ __forceinline__ int map_ffin(int np) { return ((np >> 7) & 1) * DFF + (np >> 8) * 128 + (np & 127); }
template <int MAP> __device__ __forceinline__ void p0_transpose_item(const float* W, int K, int Nsrc, int Ndst, bf16_t* WT, LAS float* scr, int item, int lane) {
    const int nblk = Ndst / 32, kb = item / nblk, nb = item % nblk, k0 = 64 * kb, n0 = 32 * nb;
    const int np = n0 + (lane & 31);
    const int sc = MAP == 0 ? np : MAP == 1 ? map_inproj(np) : map_ffin(np);
    float tv[32];
    const float* wp = W + (size_t)(k0 + (lane >> 5)) * Nsrc + (sc >= 0 ? sc : 0);
#pragma unroll
    for (int i = 0; i < 32; ++i) tv[i] = wp[(size_t)(2 * i) * Nsrc];
#pragma unroll
    for (int i = 0; i < 32; ++i) { const int kk = 2 * i + (lane >> 5); scr[kk * 33 + (lane & 31)] = sc >= 0 ? tv[i] : 0.f; }
    LDS_WAIT(); asm volatile("" ::: "memory");
    const int c = lane & 7;
#pragma unroll
    for (int j = 0; j < 4; ++j) { const int n = (lane >> 3) + 8 * j; const LAS float* s = scr + (8 * c) * 33 + n;
        uint4 o; o.x = pk2(s[0 * 33], s[1 * 33]); o.y = pk2(s[2 * 33], s[3 * 33]); o.z = pk2(s[4 * 33], s[5 * 33]); o.w = pk2(s[6 * 33], s[7 * 33]);
        *(uint4*)(WT + (size_t)(n0 + n) * K + k0 + 8 * c) = o; }
    LDS_WAIT(); asm volatile("" ::: "memory");
}
__device__ __forceinline__ void rms_row_to_bf16(const float* src, const float* g, bf16_t* dst, int lane) {
    float v[32]; float ss = 0.f;
#pragma unroll
    for (int j = 0; j < 8; ++j) { const float4 t = *(const float4*)(src + j * 256 + lane * 4); v[4 * j] = t.x; v[4 * j + 1] = t.y; v[4 * j + 2] = t.z; v[4 * j + 3] = t.w; ss += t.x * t.x + t.y * t.y + t.z * t.z + t.w * t.w; }
    ss = wave_sum(ss);
    const float rs = rsqrtf(ss * (1.0f / D) + EPS);
#pragma unroll
    for (int j = 0; j < 8; ++j) { const float4 gg = *(const float4*)(g + j * 256 + lane * 4);
        uint2 o; o.x = pk2(v[4 * j] * rs * gg.x, v[4 * j + 1] * rs * gg.y); o.y = pk2(v[4 * j + 2] * rs * gg.z, v[4 * j + 3] * rs * gg.w);
        *(uint2*)(dst + j * 256 + lane * 4) = o; }
}

struct Ptrs {
    const float *x, *mem; const int* pos; const float *g_pre_mix, *g_mem, *w_in, *w_mem_kv, *w_a, *w_b, *w_c, *w_out, *g_post_mix, *g_pre_ffn, *w_ffn_in, *w_ffn_out, *g_post_ffn;
    float* out; unsigned char* ws;
};

__device__ __forceinline__ void p0_prologue(const Ptrs& P, LAS unsigned char* lds, int G) {
    const int tid = threadIdx.x, lane = tid & 63, wave = __builtin_amdgcn_readfirstlane(tid >> 6);
    LAS float* scr = (LAS float*)(lds + RING_OFF + wave * 16384);
    const int gw = blockIdx.x * NWAVES + wave, NGW = G * NWAVES;
    unsigned char* ws = P.ws;
    constexpr int I_IN = (D / 64) * (NP_IN / 32), I_MK = (D / 64) * (2048 / 32), I_A = (AW / 64) * (D / 32), I_B = (RVW / 64) * (D / 32), I_C = (MW / 64) * (D / 32), I_O = (D / 64) * (D / 32),
                  I_FI = (D / 64) * (2 * DFF / 32), I_FO = (DFF / 64) * (D / 32);
    constexpr int NITEMS = I_IN + I_MK + I_A + I_B + I_C + I_O + I_FI + I_FO;
    for (int it = gw; it < NITEMS; it += NGW) {
        int r = it;
        if (r < I_IN) { p0_transpose_item<1>(P.w_in, D, INC, NP_IN, (bf16_t*)(ws + WS_WIN), scr, r, lane); continue; } r -= I_IN;
        if (r < I_MK) { p0_transpose_item<0>(P.w_mem_kv, D, 2048, 2048, (bf16_t*)(ws + WS_WMEMKV), scr, r, lane); continue; } r -= I_MK;
        if (r < I_A) { p0_transpose_item<0>(P.w_a, AW, D, D, (bf16_t*)(ws + WS_WA), scr, r, lane); continue; } r -= I_A;
        if (r < I_B) { p0_transpose_item<0>(P.w_b, RVW, D, D, (bf16_t*)(ws + WS_WB), scr, r, lane); continue; } r -= I_B;
        if (r < I_C) { p0_transpose_item<0>(P.w_c, MW, D, D, (bf16_t*)(ws + WS_WC), scr, r, lane); continue; } r -= I_C;
        if (r < I_O) { p0_transpose_item<0>(P.w_out, D, D, D, (bf16_t*)(ws + WS_WOUT), scr, r, lane); continue; } r -= I_O;
        if (r < I_FI) { p0_transpose_item<2>(P.w_ffn_in, D, 2 * DFF, 2 * DFF, (bf16_t*)(ws + WS_WFFIN), scr, r, lane); continue; } r -= I_FI;
        p0_transpose_item<0>(P.w_ffn_out, DFF, D, D, (bf16_t*)(ws + WS_WFFOUT), scr, r, lane);
    }
    for (int r = gw; r < S + NMEM; r += NGW) {
        if (r < S) rms_row_to_bf16(P.x + (size_t)r * D, P.g_pre_mix, (bf16_t*)(ws + WS_XN) + (size_t)r * D, lane);
        else rms_row_to_bf16(P.mem + (size_t)(r - S) * D, P.g_mem, (bf16_t*)(ws + WS_MEMN) + (size_t)(r - S) * D, lane);
    }
    float* R128 = (float*)(ws + WS_ROPE128); float* R64 = (float*)(ws + WS_ROPE64);
    for (int i = blockIdx.x * NT + tid; i < S * 64; i += G * NT) {
        const int s = i >> 6, j = i & 63;
        const float ang = (float)P.pos[s] * (float)ROPE_FREQ[j];
        float sn, cs; sincos_d((double)ang, sn, cs);
        *(float2*)(R128 + 2 * i) = make_float2(cs, sn);
        if ((j & 1) == 0) { const int i2 = s * 32 + (j >> 1); *(float2*)(R64 + 2 * i2) = make_float2(cs, sn); }
    }
}

__device__ __forceinline__ unsigned ordkey(float f) { const unsigned u = __float_as_uint(f); return (u & 0x80000000u) ? ~u : (u | 0x80000000u); }
__device__ __forceinline__ float ret_loggamma(int h) { return log1pf(-exp2f(-5.0f - (float)h)); }

__device__ __forceinline__ void naive_index(const Ptrs& P, unsigned char* lds, int t) {
    float* q = (float*)lds; float* w = q + NIH * IDXD; unsigned* keys = (unsigned*)(w + 16); int* red = (int*)(keys + S);
    const f16_t* IQ = (const f16_t*)(P.ws + WS_IQ); const f16_t* IK = (const f16_t*)(P.ws + WS_IK); const float* IW = (const float*)(P.ws + WS_IW); unsigned* MASK = (unsigned*)(P.ws + WS_MASK);
    const int tid = threadIdx.x, lane = tid & 63, wv = tid >> 6;
    __syncthreads();
    for (int i = tid; i < NIH * IDXD; i += NT) q[i] = (float)IQ[(size_t)t * (NIH * IDXD) + i];
    if (tid < NIH) w[tid] = IW[(size_t)t * NIH + tid];
    __syncthreads();
    const int n = t + 1;
    for (int k = tid; k < n; k += NT) {
        float kk[IDXD];
        const f16_t* kp = IK + (size_t)k * IDXD;
#pragma unroll
        for (int d = 0; d < IDXD; ++d) kk[d] = (float)kp[d];
        float sc = 0.f;
        for (int h = 0; h < NIH; ++h) {
            float x = 0.f;
#pragma unroll
            for (int d = 0; d < IDXD; ++d) x = fmaf(q[h * IDXD + d], kk[d], x);
            sc = fmaf(fmaxf(x, 0.f), w[h], sc);
        }
        keys[k] = ordkey(sc);
    }
    __syncthreads();
    unsigned tau = 0u;
    if (n > 256) {
        for (int b = 31; b >= 0; --b) {
            const unsigned cand = tau | (1u << b);
            int c = 0;
            for (int k = tid; k < n; k += NT) c += (keys[k] >= cand) ? 1 : 0;
#pragma unroll
            for (int o = 1; o < 64; o <<= 1) c += __shfl_xor(c, o);
            __syncthreads();
            if (lane == 0) red[wv] = c;
            __syncthreads();
            int tot = 0;
#pragma unroll
            for (int i = 0; i < NWAVES; ++i) tot += red[i];
            if (tot >= 256) tau = cand;
        }
    }
    for (int k0 = 0; k0 < S; k0 += NT) {
        const int k = k0 + tid;
        const bool sel = (k < n) && (keys[k] >= tau);
        const unsigned long long b = __ballot(sel);
        if (lane == 0) { MASK[(size_t)(k >> 5) * S + t] = (unsigned)b; MASK[(size_t)((k >> 5) + 1) * S + t] = (unsigned)(b >> 32); }
    }
}

typedef short bf16x8 __attribute__((ext_vector_type(8)));
typedef float f32x16 __attribute__((ext_vector_type(16)));
typedef float f32x4 __attribute__((ext_vector_type(4)));
typedef float f32x2_t __attribute__((ext_vector_type(2)));
typedef __bf16 bf16x2_t __attribute__((ext_vector_type(2)));
typedef unsigned u32x4 __attribute__((ext_vector_type(4)));
typedef unsigned u32x2 __attribute__((ext_vector_type(2)));
#define MFMA32(a, b, c) __builtin_amdgcn_mfma_f32_32x32x16_bf16((a), (b), (c), 0, 0, 0)
__device__ __forceinline__ int crow(int r, int hi) { return (r & 3) + 8 * (r >> 2) + 4 * hi; }
__device__ __forceinline__ bf16x8 ldg8(const bf16_t* p) { return *(const bf16x8*)p; }
__device__ __forceinline__ unsigned cvtpk(float lo, float hi) { f32x2_t v = {lo, hi}; bf16x2_t b = __builtin_convertvector(v, bf16x2_t); return __builtin_bit_cast(unsigned, b); }
__device__ __forceinline__ bf16x8 pack_step(const f32x16& x, int s) {
    u32x4 p; p.x = cvtpk(x[8 * s], x[8 * s + 1]); p.y = cvtpk(x[8 * s + 2], x[8 * s + 3]); p.z = cvtpk(x[8 * s + 4], x[8 * s + 5]); p.w = cvtpk(x[8 * s + 6], x[8 * s + 7]);
    return __builtin_bit_cast(bf16x8, p);
}
__device__ __forceinline__ f32x16 zero16() { f32x16 z; for (int i = 0; i < 16; ++i) z[i] = 0.f; return z; }

template <int RB, int NROWS> __device__ __forceinline__ void stage_rows(LAS unsigned char* dst, const unsigned char* src, size_t pitch) {
    constexpr int CPR = RB / 16, RPP = NT / CPR, NP = NROWS / RPP;
    const int tid = threadIdx.x, ch = tid % CPR, r0 = tid / CPR;
    u32x4 v[NP];
#pragma unroll
    for (int p = 0; p < NP; ++p) v[p] = *(const GAS u32x4*)(src + (size_t)(r0 + p * RPP) * pitch + ch * 16);
#pragma unroll
    for (int p = 0; p < NP; ++p) { const int row = r0 + p * RPP; *(LAS u32x4*)(dst + row * RB + ((ch ^ (row & 15)) << 4)) = v[p]; }
}
template <int RB> __device__ __forceinline__ bf16x8 lfrag(const LAS unsigned char* base, int row, int chunk) { return *(const LAS bf16x8*)(base + row * RB + ((chunk ^ (row & 15)) << 4)); }

__device__ __forceinline__ void ret_kv_mfma(const Ptrs& P, LAS unsigned char* lds, int nh) {
    const int lane = threadIdx.x & 63, w = __builtin_amdgcn_readfirstlane(threadIdx.x >> 6), n = nh >> 3, h = nh & 7, db = w & 3, eh = w >> 2;
    int r = lane & 31, hh = lane >> 5; asm volatile("" : "+v"(r), "+v"(hh));
    __syncthreads();
    stage_rows<256, 128>(lds, P.ws + WS_RKT + ((size_t)(h * 128) * S + n * 128) * 2, (size_t)S * 2);
    stage_rows<256, 256>(lds + 32768, P.ws + WS_RVT + ((size_t)(h * 256) * S + n * 128) * 2, (size_t)S * 2);
    __syncthreads();
    f32x16 acc[4];
#pragma unroll
    for (int eb = 0; eb < 4; ++eb) acc[eb] = zero16();
#pragma unroll
    for (int ks = 0; ks < 8; ++ks) {
        const bf16x8 a = lfrag<256>(lds, 32 * db + r, 2 * ks + hh);
#pragma unroll
        for (int eb = 0; eb < 4; ++eb) acc[eb] = MFMA32(a, lfrag<256>(lds + 32768, 128 * eh + 32 * eb + r, 2 * ks + hh), acc[eb]);
    }
    float* KVS = (float*)(P.ws + WS_KVS);
#pragma unroll
    for (int eb = 0; eb < 4; ++eb)
#pragma unroll
        for (int g = 0; g < 4; ++g) {
            const int e = 128 * eh + 32 * eb + r, d0 = 32 * db + 8 * g + 4 * hh;
            *(f32x4*)(KVS + ((size_t)nh * 256 + e) * 128 + d0) = (f32x4){acc[eb][4 * g], acc[eb][4 * g + 1], acc[eb][4 * g + 2], acc[eb][4 * g + 3]};
        }
}
__device__ __forceinline__ void ret_scan(const Ptrs& P, int task) {
    const float* KVS = (const float*)(P.ws + WS_KVS); bf16_t* PREV = (bf16_t*)(P.ws + WS_PREV);
    const int i = task * NT + threadIdx.x, h = i >> 15;
    const float lg = log1pf(-exp2f(-5.0f - (float)h)), cd = __expf(128.0f * lg), gm = __expf(lg);
    float st = 0.f;
#pragma unroll 8
    for (int n = 0; n < 64; ++n) { const size_t o = (size_t)n * (8 * 128 * 256) + i; PREV[o] = f2bf(st * gm); st = st * cd + KVS[o]; }
}
__device__ __forceinline__ void ret_out_mfma(const Ptrs& P, LAS unsigned char* lds, int nh) {
    const int lane = threadIdx.x & 63, w = __builtin_amdgcn_readfirstlane(threadIdx.x >> 6), n = nh >> 3, h = nh & 7, ib = w & 3, eh = w >> 2, tok0 = n * 128;
    int r = lane & 31, hh = lane >> 5; asm volatile("" : "+v"(r), "+v"(hh));
    LAS float* red = (LAS float*)(lds + 98304);
    __syncthreads();
    stage_rows<256, 128>(lds, P.ws + WS_RQ + ((size_t)tok0 * 1024 + h * 128) * 2, 2048);
    stage_rows<256, 128>(lds + 32768, P.ws + WS_RK + ((size_t)tok0 * 1024 + h * 128) * 2, 2048);
    stage_rows<256, 256>(lds + 65536, P.ws + WS_RVT + ((size_t)(h * 256) * S + tok0) * 2, (size_t)S * 2);
    __syncthreads();
    bf16x8 qf[8];
#pragma unroll
    for (int ks = 0; ks < 8; ++ks) qf[ks] = lfrag<256>(lds, 32 * ib + r, 2 * ks + hh);
    f32x16 acc[4];
#pragma unroll
    for (int eb = 0; eb < 4; ++eb) acc[eb] = zero16();
    for (int jb = 0; jb <= ib; ++jb) {
        f32x16 X = zero16();
#pragma unroll
        for (int ks = 0; ks < 8; ++ks) X = MFMA32(lfrag<256>(lds + 32768, 32 * jb + r, 2 * ks + hh), qf[ks], X);
        if (jb == ib) {
#pragma unroll
            for (int reg = 0; reg < 16; ++reg) if (crow(reg, hh) > r) X[reg] = 0.f;
        }
#pragma unroll
        for (int s = 0; s < 2; ++s) {
            const bf16x8 xs = pack_step(X, s);
#pragma unroll
            for (int eb = 0; eb < 4; ++eb) acc[eb] = MFMA32(lfrag<256>(lds + 65536, 128 * eh + 32 * eb + r, 4 * jb + 2 * s + hh), xs, acc[eb]);
        }
    }
    __syncthreads();
    stage_rows<256, 256>(lds + 32768, P.ws + WS_PREV + ((size_t)nh * 256 * 128) * 2, 256);
    __syncthreads();
#pragma unroll
    for (int ks = 0; ks < 8; ++ks)
#pragma unroll
        for (int eb = 0; eb < 4; ++eb) acc[eb] = MFMA32(lfrag<256>(lds + 32768, 128 * eh + 32 * eb + r, 2 * ks + hh), qf[ks], acc[eb]);
    float s1 = 0.f, s2 = 0.f;
#pragma unroll
    for (int eb = 0; eb < 4; ++eb)
#pragma unroll
        for (int reg = 0; reg < 16; ++reg) { const float v = acc[eb][reg]; s1 += v; s2 = fmaf(v, v, s2); }
    s1 += __shfl_xor(s1, 32); s2 += __shfl_xor(s2, 32);
    if (hh == 0) { red[(w * 32 + r) * 2] = s1; red[(w * 32 + r) * 2 + 1] = s2; }
    __syncthreads();
    { s1 += red[((w ^ 4) * 32 + r) * 2]; s2 += red[((w ^ 4) * 32 + r) * 2 + 1]; }
    const float mu = s1 * (1.0f / 256.0f), var = fmaxf(s2 * (1.0f / 256.0f) - mu * mu, 0.f), rs = rsqrtf(var + EPS);
    bf16_t* OB = (bf16_t*)(P.ws + WS_OB) + (size_t)(tok0 + 32 * ib + r) * 2048 + h * 256 + 128 * eh + 4 * hh;
#pragma unroll
    for (int eb = 0; eb < 4; ++eb)
#pragma unroll
        for (int g = 0; g < 4; ++g) {
            bf16_t* p = OB + 32 * eb + 8 * g;
            const u32x2 gw = *(const u32x2*)p;
            const float g0 = __uint_as_float(gw.x << 16), g1 = __uint_as_float(gw.x & 0xffff0000u), g2 = __uint_as_float(gw.y << 16), g3 = __uint_as_float(gw.y & 0xffff0000u);
            u32x2 o; o.x = cvtpk(g0 * (acc[eb][4 * g] - mu) * rs, g1 * (acc[eb][4 * g + 1] - mu) * rs); o.y = cvtpk(g2 * (acc[eb][4 * g + 2] - mu) * rs, g3 * (acc[eb][4 * g + 3] - mu) * rs);
            *(u32x2*)p = o;
        }
}
__device__ __forceinline__ void memattn_mfma(const Ptrs& P, LAS unsigned char* lds, int task) {
    const int lane = threadIdx.x & 63, w = __builtin_amdgcn_readfirstlane(threadIdx.x >> 6), h = task & 3, t0 = (task >> 2) * 256 + 32 * w;
    int r = lane & 31, hh = lane >> 5; asm volatile("" : "+v"(r), "+v"(hh));
    const bf16_t* MQ = (const bf16_t*)(P.ws + WS_MQ) + (size_t)(t0 + r) * 1024 + h * 256 + 8 * hh;
    __syncthreads();
    stage_rows<512, 256>(lds, P.ws + WS_MEMK + (size_t)(h * 256) * 2, 2048);
    __syncthreads();
    f32x16 X[8];
#pragma unroll
    for (int kb = 0; kb < 8; ++kb) X[kb] = zero16();
#pragma unroll 1
    for (int ks = 0; ks < 16; ++ks) {
        const bf16x8 qf = ldg8(MQ + 16 * ks);
#pragma unroll
        for (int kb = 0; kb < 8; ++kb) X[kb] = MFMA32(lfrag<512>(lds, 32 * kb + r, 2 * ks + hh), qf, X[kb]);
    }
    float mx = -INFINITY;
#pragma unroll
    for (int kb = 0; kb < 8; ++kb)
#pragma unroll
        for (int reg = 0; reg < 16; ++reg) mx = fmaxf(mx, X[kb][reg]);
    mx = fmaxf(mx, __shfl_xor(mx, 32));
    float l = 0.f;
    bf16x8 pf[16];
#pragma unroll
    for (int kb = 0; kb < 8; ++kb) {
#pragma unroll
        for (int reg = 0; reg < 16; ++reg) { const float p = __builtin_amdgcn_exp2f(X[kb][reg] - mx); X[kb][reg] = p; l += p; }
        pf[2 * kb] = pack_step(X[kb], 0); pf[2 * kb + 1] = pack_step(X[kb], 1);
    }
    l += __shfl_xor(l, 32);
    const float inv = 1.0f / l;
    __syncthreads();
    stage_rows<512, 256>(lds, P.ws + WS_MVT + (size_t)(h * 256) * 256 * 2, 512);
    __syncthreads();
    bf16_t* OC = (bf16_t*)(P.ws + WS_OC) + (size_t)(t0 + r) * 1024 + h * 256 + 4 * hh;
#pragma unroll
    for (int dh = 0; dh < 2; ++dh) {
        f32x16 O[4];
#pragma unroll
        for (int db = 0; db < 4; ++db) O[db] = zero16();
#pragma unroll
        for (int kk = 0; kk < 16; ++kk)
#pragma unroll
            for (int db = 0; db < 4; ++db) O[db] = MFMA32(lfrag<512>(lds, 128 * dh + 32 * db + r, 2 * kk + hh), pf[kk], O[db]);
#pragma unroll
        for (int db = 0; db < 4; ++db)
#pragma unroll
            for (int g = 0; g < 4; ++g) {
                u32x2 o; o.x = cvtpk(O[db][4 * g] * inv, O[db][4 * g + 1] * inv); o.y = cvtpk(O[db][4 * g + 2] * inv, O[db][4 * g + 3] * inv);
                *(u32x2*)(OC + 128 * dh + 32 * db + 8 * g) = o;
            }
    }
}
__device__ __forceinline__ float mask_sel(unsigned w, int c, float x) { const int m = __builtin_amdgcn_sbfe((int)w, c, 1); return __uint_as_float((__float_as_uint(x) & (unsigned)m) | (0xff800000u & ~(unsigned)m)); }
__device__ __forceinline__ void attn_mfma(const Ptrs& P, LAS unsigned char* lds, int h, int qb) {
    const int tid = threadIdx.x, lane = tid & 63, w = __builtin_amdgcn_readfirstlane(tid >> 6), g = w >> 2, qs = w & 3;
    int r = lane & 31, hh = lane >> 5; asm volatile("" : "+v"(r), "+v"(hh));
    const int q0 = 128 * qb + 32 * qs, nst = qb + 1;
    const bf16_t* AK = (const bf16_t*)(P.ws + WS_AK) + h * 128; const bf16_t* AVT = (const bf16_t*)(P.ws + WS_AVT) + (size_t)h * 128 * S;
    const unsigned* MASKT = (const unsigned*)(P.ws + WS_MASK) + q0 + r;
    const int skey = tid >> 4, sch = tid & 15, sd = tid >> 3, svc = tid & 7;
    bf16x8 qf[8];
    { const bf16_t* AQ = (const bf16_t*)(P.ws + WS_AQ) + (size_t)(q0 + r) * 1024 + h * 128 + 8 * hh;
#pragma unroll
      for (int ks = 0; ks < 8; ++ks) qf[ks] = ldg8(AQ + 16 * ks); }
    f32x16 O[4];
#pragma unroll
    for (int db = 0; db < 4; ++db) O[db] = zero16();
    float m_run = -1e30f, l_run = 0.f;
    u32x4 sk[4], sv[4];
#define ATT_ISSUE(st) do { _Pragma("unroll") for (int i = 0; i < 4; ++i) { \
        sk[i] = *(const u32x4*)(AK + (size_t)(128 * (st) + 64 * (i >> 1) + skey + 32 * (i & 1)) * 1024 + sch * 8); \
        sv[i] = *(const u32x4*)(AVT + (size_t)(sd + 64 * (i & 1)) * S + 128 * (st) + 64 * (i >> 1) + svc * 8); } } while (0)
#define ATT_WRITE(buf) do { _Pragma("unroll") for (int i = 0; i < 4; ++i) { const int key = skey + 32 * (i & 1), d = sd + 64 * (i & 1); \
        *(LAS u32x4*)(lds + (buf) * 65536 + (i >> 1) * 32768 + key * 256 + ((sch ^ (key & 15)) << 4)) = sk[i]; \
        *(LAS u32x4*)(lds + (buf) * 65536 + (i >> 1) * 32768 + 16384 + d * 128 + ((svc ^ ((d >> 1) & 7)) << 4)) = sv[i]; } } while (0)
    __syncthreads();
    ATT_ISSUE(0); ATT_WRITE(0);
    __syncthreads();
    for (int st = 0; st < nst; ++st) {
        const bool more = st + 1 < nst;
        if (more) ATT_ISSUE(st + 1);
        unsigned w0 = MASKT[(size_t)(4 * st + 2 * g) * S], w1 = MASKT[(size_t)(4 * st + 2 * g + 1) * S];
        const LAS unsigned char* Kb = lds + (st & 1) * 65536 + g * 32768; const LAS unsigned char* Vb = Kb + 16384;
        f32x16 X0 = zero16(), X1 = zero16();
#pragma unroll
        for (int ks = 0; ks < 8; ++ks) {
            const bf16x8 a0 = *(const LAS bf16x8*)(Kb + r * 256 + (((2 * ks + hh) ^ (r & 15)) << 4));
            const bf16x8 a1 = *(const LAS bf16x8*)(Kb + (32 + r) * 256 + (((2 * ks + hh) ^ (r & 15)) << 4));
            X0 = MFMA32(a0, qf[ks], X0); X1 = MFMA32(a1, qf[ks], X1);
        }
        w0 >>= 4 * hh; w1 >>= 4 * hh;
        float tmax = -INFINITY;
#pragma unroll
        for (int reg = 0; reg < 16; ++reg) { const int c = (reg & 3) + 8 * (reg >> 2); X0[reg] = mask_sel(w0, c, X0[reg]); X1[reg] = mask_sel(w1, c, X1[reg]); tmax = fmaxf(tmax, fmaxf(X0[reg], X1[reg])); }
        tmax = fmaxf(tmax, __shfl_xor(tmax, 32));
        const float m_new = fmaxf(m_run, tmax), alpha = __builtin_amdgcn_exp2f(m_run - m_new);
        m_run = m_new;
        float ps = 0.f;
#pragma unroll
        for (int reg = 0; reg < 16; ++reg) { X0[reg] = __builtin_amdgcn_exp2f(X0[reg] - m_new); X1[reg] = __builtin_amdgcn_exp2f(X1[reg] - m_new); ps += X0[reg] + X1[reg]; }
        l_run = l_run * alpha + ps;
#pragma unroll
        for (int db = 0; db < 4; ++db) O[db] = O[db] * alpha;
        bf16x8 pf[4]; pf[0] = pack_step(X0, 0); pf[1] = pack_step(X0, 1); pf[2] = pack_step(X1, 0); pf[3] = pack_step(X1, 1);
#pragma unroll
        for (int s = 0; s < 4; ++s)
#pragma unroll
            for (int db = 0; db < 4; ++db) {
                const bf16x8 vf = *(const LAS bf16x8*)(Vb + (32 * db + r) * 128 + (((2 * s + hh) ^ ((r >> 1) & 7)) << 4));
                O[db] = MFMA32(vf, pf[s], O[db]);
            }
        if (more) ATT_WRITE((st + 1) & 1);
        __syncthreads();
    }
#undef ATT_ISSUE
#undef ATT_WRITE
    l_run += __shfl_xor(l_run, 32);
    LAS float* cb = (LAS float*)(lds + qs * 16896);
    if (g == 1) {
#pragma unroll
        for (int db = 0; db < 4; ++db)
#pragma unroll
            for (int reg = 0; reg < 16; ++reg) cb[(db * 16 + reg) * 64 + lane] = O[db][reg];
        cb[4096 + lane] = m_run; cb[4160 + lane] = l_run;
    }
    __syncthreads();
    if (g == 0) {
        const float m1 = cb[4096 + lane], l1 = cb[4160 + lane], mt = fmaxf(m_run, m1), a0 = __builtin_amdgcn_exp2f(m_run - mt), a1 = __builtin_amdgcn_exp2f(m1 - mt);
        const float inv = 1.0f / (l_run * a0 + l1 * a1), f0 = a0 * inv, f1 = a1 * inv;
        bf16_t* OA = (bf16_t*)(P.ws + WS_OA) + (size_t)(q0 + r) * 1024 + h * 128 + 4 * hh;
#pragma unroll
        for (int db = 0; db < 4; ++db)
#pragma unroll
            for (int gq = 0; gq < 4; ++gq) {
                float v[4];
#pragma unroll
                for (int e = 0; e < 4; ++e) v[e] = O[db][4 * gq + e] * f0 + cb[(db * 16 + 4 * gq + e) * 64 + lane] * f1;
                u32x2 o; o.x = cvtpk(v[0], v[1]); o.y = cvtpk(v[2], v[3]);
                *(u32x2*)(OA + 32 * db + 8 * gq) = o;
            }
    }
}
typedef _Float16 f16x8 __attribute__((ext_vector_type(8)));
__device__ __forceinline__ float relu_i(float x) { const int i = __float_as_int(x); return __int_as_float(i > 0 ? i : 0); }
__device__ __forceinline__ void index_mfma(const Ptrs& P, LAS unsigned char* lds, int tile) {
    const int tid = threadIdx.x, lane = tid & 63, w = __builtin_amdgcn_readfirstlane(tid >> 6), qp = w & 3, kh = w >> 2, t0 = 8 * tile;
    int r = lane & 31, hh = lane >> 5; asm volatile("" : "+v"(r), "+v"(hh));
    const int nkb = ((t0 + 7) >> 5) + 1, nst = (nkb + 7) >> 3, njb = 4 * nst, kbw = 4 * ((t0 >> 7) + 1), tq = t0 + 2 * qp + hh;
    LAS int* cnt = (LAS int*)lds;
    LAS unsigned char* ring = lds + 1024;
    const f16_t* IQ = (const f16_t*)(P.ws + WS_IQ) + (size_t)(t0 + 2 * qp + (r >> 4)) * 1024 + (r & 15) * 64 + 8 * hh;
    f16x8 af[4];
#pragma unroll
    for (int s = 0; s < 4; ++s) af[s] = *(const f16x8*)(IQ + 16 * s);
    float wq0[8], wq1[8];
    { const float* IW = (const float*)(P.ws + WS_IW) + (size_t)(t0 + 2 * qp) * 16 + 4 * hh;
#pragma unroll
      for (int reg = 0; reg < 8; ++reg) { const int hd = (reg & 3) + 8 * (reg >> 2); wq0[reg] = IW[hd]; wq1[reg] = IW[16 + hd]; } }
    typedef unsigned u32x32 __attribute__((ext_vector_type(32)));
    u32x32 sc[4];
#pragma unroll
    for (int g = 0; g < 4; ++g)
#pragma unroll
        for (int e = 0; e < 32; ++e) sc[g][e] = 0u;
    const f16_t* IK = (const f16_t*)(P.ws + WS_IK) + (size_t)(tid >> 3) * 64 + (tid & 7) * 8;
    const int srow = tid >> 3, sch = tid & 7;
    u32x4 sk[4];
    const f16_t* ikp = IK;
#define IDX_ISSUE() do { asm volatile("" : "+v"(ikp)); _Pragma("unroll") for (int i = 0; i < 4; ++i) sk[i] = *(const GAS u32x4*)(ikp + (size_t)(64 * i) * 64); ikp += 256 * 64; } while (0)
#define IDX_WRITE(buf) do { _Pragma("unroll") for (int i = 0; i < 4; ++i) { const int row = srow + 64 * i; *(LAS u32x4*)(ring + (buf) * 32768 + row * 128 + ((sch ^ ((row >> 1) & 7)) << 4)) = sk[i]; } } while (0)
#ifndef PROBE_SCORE_REPS
#define PROBE_SCORE_REPS 1
#endif
#pragma unroll 1
    for (int rep = 0; rep < PROBE_SCORE_REPS; ++rep) {
    ikp = IK;
    __syncthreads();
    IDX_ISSUE(); IDX_WRITE(0);
    __syncthreads();
#pragma unroll
    for (int g = 0; g < 4; ++g) {
#pragma unroll 1
        for (int s8 = 0; s8 < 8; ++s8) {
            const int st = 8 * g + s8;
            if (st >= nst) break;
            if (st + 1 < nst) IDX_ISSUE();
            const LAS unsigned char* kbuf = ring + (s8 & 1) * 32768;
#pragma unroll
            for (int b = 0; b < 4; ++b) {
                const int kbl = 2 * b + kh, kb = 8 * st + kbl;
                const LAS unsigned char* kp = kbuf + (32 * kbl + r) * 128;
                f32x16 X = zero16();
#pragma unroll
                for (int s = 0; s < 4; ++s) X = __builtin_amdgcn_mfma_f32_32x32x16_f16(af[s], *(const LAS f16x8*)(kp + (((2 * s + hh) ^ ((r >> 1) & 7)) << 4)), X, 0, 0, 0);
                float p0 = 0.f, p1 = 0.f;
#pragma unroll
                for (int reg = 0; reg < 8; ++reg) { p0 = fmaf(relu_i(X[reg]), wq0[reg], p0); p1 = fmaf(relu_i(X[8 + reg]), wq1[reg], p1); }
                const auto rr = __builtin_amdgcn_permlane32_swap(__float_as_uint(p0), __float_as_uint(p1), false, false);
                const float score = __uint_as_float(rr[0]) + __uint_as_float(rr[1]);
                sc[g][4 * s8 + b] = (32 * kb + r <= tq) ? ordkey(score) : 0u;
            }
            if (st + 1 < nst) IDX_WRITE((s8 + 1) & 1);
            __syncthreads();
        }
    }
    }
#undef IDX_ISSUE
#undef IDX_WRITE
    unsigned tau = 0u;
#ifndef PROBE_BISECT_REPS
#define PROBE_BISECT_REPS 1
#endif
#pragma unroll 1
    for (int rep = 0; rep < PROBE_BISECT_REPS; ++rep)
    if (t0 + 8 > 256) {
        tau = 0u; __syncthreads();
        int settled = 0, mine = 0;
#pragma unroll 1
        for (int b = 31; b >= 0; --b) {
            const unsigned cand = tau | (1u << b);
            int c = 0;
#pragma unroll
            for (int g = 0; g < 4; ++g)
#pragma unroll
                for (int hf = 0; hf < 2; ++hf) {
                    if (32 * g + 16 * hf < njb) {
#pragma unroll
                        for (int e = 16 * hf; e < 16 * hf + 16; ++e) c += (sc[g][e] >= cand) ? 1 : 0;
                    }
                }
            c += __shfl_xor(c, 1); c += __shfl_xor(c, 2); c += __shfl_xor(c, 4); c += __shfl_xor(c, 8); c += __shfl_xor(c, 16);
            LAS int* cb = cnt + (b & 1) * 16; LAS int* fb = cnt + 32 + (b & 1) * 8;
            if (r == 0) cb[w * 2 + hh] = c;
            if (lane == 0) fb[w] = settled;
            __syncthreads();
            if ((fb[0] & fb[1] & fb[2] & fb[3]) != 0) break;
            const int tot = c + cb[(w ^ 4) * 2 + hh];
            if (tot >= 256) tau = cand;
            mine |= (tot == 256) ? 1 : 0;
            settled = __all(mine) ? 1 : 0;
        }
    }
    const unsigned thr = tau > 1u ? tau : 1u;
    unsigned* MASKT = (unsigned*)(P.ws + WS_MASK) + t0 + 2 * qp;
#pragma unroll
    for (int g = 0; g < 4; ++g)
#pragma unroll
        for (int e = 0; e < 32; ++e) {
            const int j = 32 * g + e, kb = 8 * (j >> 2) + 2 * (j & 3) + kh;
            if (kb < kbw) {
                const unsigned long long bm = __ballot(sc[g][e] >= thr);
                if (lane == 0) *(uint2*)(MASKT + (size_t)kb * S) = make_uint2((unsigned)bm, (unsigned)(bm >> 32));
            }
        }
}
__device__ __forceinline__ void resnorm_row(const float* xin, const float* y, const float* g1, const float* g2, float* out, bf16_t* h2, int r, int lane) {
    float yv[32], xv[32]; float ss = 0.f;
#pragma unroll
    for (int j = 0; j < 8; ++j) { const float4 t = *(const float4*)(y + (size_t)r * D + j * 256 + lane * 4); yv[4 * j] = t.x; yv[4 * j + 1] = t.y; yv[4 * j + 2] = t.z; yv[4 * j + 3] = t.w; ss += t.x * t.x + t.y * t.y + t.z * t.z + t.w * t.w; }
    ss = wave_sum(ss);
    const float rs = rsqrtf(ss * (1.0f / D) + EPS);
    float s2 = 0.f;
#pragma unroll
    for (int j = 0; j < 8; ++j) {
        const float4 xx = *(const float4*)(xin + (size_t)r * D + j * 256 + lane * 4);
        const float4 gg = *(const float4*)(g1 + j * 256 + lane * 4);
        xv[4 * j] = xx.x + yv[4 * j] * rs * gg.x; xv[4 * j + 1] = xx.y + yv[4 * j + 1] * rs * gg.y; xv[4 * j + 2] = xx.z + yv[4 * j + 2] * rs * gg.z; xv[4 * j + 3] = xx.w + yv[4 * j + 3] * rs * gg.w;
        s2 += xv[4 * j] * xv[4 * j] + xv[4 * j + 1] * xv[4 * j + 1] + xv[4 * j + 2] * xv[4 * j + 2] + xv[4 * j + 3] * xv[4 * j + 3];
        *(float4*)(out + (size_t)r * D + j * 256 + lane * 4) = make_float4(xv[4 * j], xv[4 * j + 1], xv[4 * j + 2], xv[4 * j + 3]);
    }
    if (h2) {
        s2 = wave_sum(s2);
        const float r2 = rsqrtf(s2 * (1.0f / D) + EPS);
#pragma unroll
        for (int j = 0; j < 8; ++j) { const float4 gg = *(const float4*)(g2 + j * 256 + lane * 4);
            uint2 o; o.x = pk2(xv[4 * j] * r2 * gg.x, xv[4 * j + 1] * r2 * gg.y); o.y = pk2(xv[4 * j + 2] * r2 * gg.z, xv[4 * j + 3] * r2 * gg.w);
            *(uint2*)(h2 + (size_t)r * D + j * 256 + lane * 4) = o; }
    }
}

#ifndef PROBE_REPEAT_PHASE
#define PROBE_REPEAT_PHASE -1
#endif
#ifndef MK_PER_PHASE
#define MK_PER_PHASE 0
#endif
constexpr int N_PHASES = 11;
struct Args { Ptrs p; int ph_lo, ph_hi; };
__global__ void __launch_bounds__(NT, 2) mk_fwd(Args args) {
    extern __shared__ __attribute__((aligned(16))) unsigned char lds_raw[];
    LAS unsigned char* lds = (LAS unsigned char*)lds_raw;
    const Ptrs& P = args.p;
    const int tid = threadIdx.x, lane = tid & 63, wave = __builtin_amdgcn_readfirstlane(tid >> 6), G = gridDim.x;
    unsigned char* ws = P.ws;
    for (int u = tid; u < (LDS_BYTES - LDSCTL_OFF) / 4; u += NT) ((LAS unsigned*)(lds + LDSCTL_OFF))[u] = 0u;
    __syncthreads();
    XcdBarrier bar; bar.bar = (unsigned*)(ws + WS_CTL) + CW_BAR; bar.x = 0; bar.st = nullptr;
    if (!MK_PER_PHASE) bar = xcd_barrier_post((unsigned*)(ws + WS_CTL) + CW_BAR, (volatile LAS unsigned*)(lds + MISC_OFF) + 8);
    const int lo = args.ph_lo, hi = args.ph_hi;
#define IN(k) (lo <= (k) && (k) < hi)
#define SEAM(k) do { if (IN(k) && IN((k) + 1)) xcd_barrier(bar); } while (0)
    bf16_t* XN = (bf16_t*)(ws + WS_XN);

    if (IN(0)) { p0_prologue(P, lds, G); }
    SEAM(0);
    if (IN(1)) {
        pg8::Gemm g{XN, (const bf16_t*)(ws + WS_WIN), S + NMEM, NP_IN + 2048, D}; pg8::InProjOrder O; O.init(G, (int)blockIdx.x);
        pg8::EpiInProj E{ws};
        pg8::gemm_phase<pg8::EpiInProj, pg8::InProjOrder, true, true>(lds + RING_OFF, g, O, E);
    }
    SEAM(1);
    if (IN(2)) {
        for (int task = blockIdx.x; task < 512 + 128; task += G) {
            if (task < 512) ret_kv_mfma(P, lds + RING_OFF, task);
            else memattn_mfma(P, lds + RING_OFF, task - 512);
        }
        for (int i = blockIdx.x; i < 256; i += G) {
#pragma unroll 1
            for (int k = 0; k < 4; ++k) { const int tile = (k == 0) ? i : (k == 1) ? 511 - i : (k == 2) ? 512 + i : 1023 - i; index_mfma(P, lds + RING_OFF, tile); }
        }
    }
    SEAM(2);
    if (IN(3)) {
        for (int task = blockIdx.x; task < 512; task += G) ret_scan(P, task);
        for (int i = blockIdx.x; i < 256; i += G) {
#pragma unroll 1
            for (int k = 0; k < 2; ++k) { const int u = k ? 511 - i : i; attn_mfma(P, lds + RING_OFF, u & 7, 63 - (u >> 3)); }
        }
    }
    SEAM(3);
    if (IN(4)) { for (int task = blockIdx.x; task < 512; task += G) ret_out_mfma(P, lds + RING_OFF, task); }
    SEAM(4);
    if (IN(5)) {
        __syncthreads();
        pg8::StaticOrder O; O.init(S, D, G, (int)blockIdx.x);
        { pg8::Gemm g{(const bf16_t*)(ws + WS_OB), (const bf16_t*)(ws + WS_WB), S, D, RVW};
          pg8::EpiGateAcc E{(float*)(ws + WS_MIXED), (bf16_t*)(ws + WS_MIXEDB), (const bf16_t*)(ws + WS_GATES) + D, D, 3 * D, 1, 0};
          pg8::gemm_phase<pg8::EpiGateAcc, pg8::StaticOrder, false, true>(lds + RING_OFF, g, O, E); }
        { pg8::Gemm g{(const bf16_t*)(ws + WS_OA), (const bf16_t*)(ws + WS_WA), S, D, AW};
          pg8::EpiGateAcc E{(float*)(ws + WS_MIXED), (bf16_t*)(ws + WS_MIXEDB), (const bf16_t*)(ws + WS_GATES), D, 3 * D, 0, 0};
          pg8::gemm_phase<pg8::EpiGateAcc, pg8::StaticOrder, false, true>(lds + RING_OFF, g, O, E); }
        { pg8::Gemm g{(const bf16_t*)(ws + WS_OC), (const bf16_t*)(ws + WS_WC), S, D, MW};
          pg8::EpiGateAcc E{(float*)(ws + WS_MIXED), (bf16_t*)(ws + WS_MIXEDB), (const bf16_t*)(ws + WS_GATES) + 2 * D, D, 3 * D, 0, 1};
          pg8::gemm_phase<pg8::EpiGateAcc, pg8::StaticOrder, false, true>(lds + RING_OFF, g, O, E); }
    }
    SEAM(5);
    if (IN(6)) {
        pg8::Gemm g{(const bf16_t*)(ws + WS_MIXEDB), (const bf16_t*)(ws + WS_WOUT), S, D, D}; pg8::StaticOrder O; O.init(S, D, G, (int)blockIdx.x);
        pg8::EpiF32 E{(float*)(ws + WS_Y), D};
        pg8::gemm_phase<pg8::EpiF32, pg8::StaticOrder, false, true>(lds + RING_OFF, g, O, E);
    }
    SEAM(6);
    if (IN(7)) { for (int r = blockIdx.x * NWAVES + wave; r < S; r += G * NWAVES) resnorm_row(P.x, (const float*)(ws + WS_Y), P.g_post_mix, P.g_pre_ffn, P.out, XN, r, lane); }
    SEAM(7);
    if (IN(8)) {
        pg8::Gemm g{XN, (const bf16_t*)(ws + WS_WFFIN), S, 2 * DFF, D}; pg8::StaticOrder O; O.init(S, 2 * DFF, G, (int)blockIdx.x);
        pg8::EpiSwiGLU E{(bf16_t*)(ws + WS_ACT), DFF};
        pg8::gemm_phase<pg8::EpiSwiGLU, pg8::StaticOrder, true, true>(lds + RING_OFF, g, O, E);
    }
    SEAM(8);
    if (IN(9)) {
        pg8::Gemm g{(const bf16_t*)(ws + WS_ACT), (const bf16_t*)(ws + WS_WFFOUT), S, D, DFF}; pg8::StaticOrder O; O.init(S, D, G, (int)blockIdx.x);
        pg8::EpiF32 E{(float*)(ws + WS_Y), D};
        pg8::gemm_phase<pg8::EpiF32, pg8::StaticOrder, false, true>(lds + RING_OFF, g, O, E);
    }
    SEAM(9);
    if (IN(10)) { for (int r = blockIdx.x * NWAVES + wave; r < S; r += G * NWAVES) resnorm_row(P.out, (const float*)(ws + WS_Y), P.g_post_ffn, nullptr, P.out, nullptr, r, lane); }
#undef IN
#undef SEAM
}

extern "C" void kernel_launch(void* const* d_in, const int* in_sizes, int n_in, void* d_out, int out_size, void* d_ws, size_t ws_size, hipStream_t stream) {
    static int grid = 0;
    if (grid == 0) {
        if (n_in != 16 || in_sizes[0] != S * D || out_size != S * D || ws_size < WS_END) { fprintf(stderr, "kernel_launch: unexpected shapes (n_in %d, ws %zu); nothing launched\n", n_in, ws_size); grid = -1; return; }
        int dev = 0, cus = 0, per_cu = 0;
        if (hipGetDevice(&dev) != hipSuccess || hipDeviceGetAttribute(&cus, hipDeviceAttributeMultiprocessorCount, dev) != hipSuccess) { grid = -1; return; }
        if (hipFuncSetAttribute((const void*)mk_fwd, hipFuncAttributeMaxDynamicSharedMemorySize, LDS_BYTES) != hipSuccess) { fprintf(stderr, "kernel_launch: hipFuncSetAttribute failed\n"); grid = -1; return; }
        if (hipOccupancyMaxActiveBlocksPerMultiprocessor(&per_cu, (const void*)mk_fwd, NT, LDS_BYTES) != hipSuccess || per_cu < 1) { fprintf(stderr, "kernel_launch: occupancy query says %d blocks per CU; nothing launched\n", per_cu); grid = -1; return; }
        (void)hipGetLastError();
        grid = cus;
    }
    if (grid < 0) return;
    if (hipMemsetAsync((char*)d_ws + WS_CTL, 0, CTL_ZERO_BYTES, stream) != hipSuccess) return;
    Args a{};
    a.p.x = (const float*)d_in[0]; a.p.mem = (const float*)d_in[1]; a.p.pos = (const int*)d_in[2]; a.p.g_pre_mix = (const float*)d_in[3]; a.p.g_mem = (const float*)d_in[4];
    a.p.w_in = (const float*)d_in[5]; a.p.w_mem_kv = (const float*)d_in[6]; a.p.w_a = (const float*)d_in[7]; a.p.w_b = (const float*)d_in[8]; a.p.w_c = (const float*)d_in[9];
    a.p.w_out = (const float*)d_in[10]; a.p.g_post_mix = (const float*)d_in[11]; a.p.g_pre_ffn = (const float*)d_in[12]; a.p.w_ffn_in = (const float*)d_in[13]; a.p.w_ffn_out = (const float*)d_in[14];
    a.p.g_post_ffn = (const float*)d_in[15]; a.p.out = (float*)d_out; a.p.ws = (unsigned char*)d_ws;
#if MK_PER_PHASE
    for (int ph = 0; ph < N_PHASES; ++ph) { a.ph_lo = ph; a.ph_hi = ph + 1; hipLaunchKernelGGL(mk_fwd, dim3(grid), dim3(NT), LDS_BYTES, stream, a); }
#else
    if (PROBE_REPEAT_PHASE >= 0) {
        a.ph_lo = 0; a.ph_hi = PROBE_REPEAT_PHASE + 1;
        hipLaunchKernelGGL(mk_fwd, dim3(grid), dim3(NT), LDS_BYTES, stream, a);
        (void)hipMemsetAsync((char*)d_ws + WS_CTL, 0, CTL_ZERO_BYTES, stream);
        a.ph_lo = PROBE_REPEAT_PHASE; a.ph_hi = N_PHASES;
        hipLaunchKernelGGL(mk_fwd, dim3(grid), dim3(NT), LDS_BYTES, stream, a);
    } else {
        a.ph_lo = 0; a.ph_hi = N_PHASES;
        hipLaunchKernelGGL(mk_fwd, dim3(grid), dim3(NT), LDS_BYTES, stream, a);
    }
#endif
}
```

```cpp
#include <hip/hip_runtime.h>
#include <cstdio>
#include <cstdint>


typedef unsigned short bf16_t;
typedef _Float16 f16_t;
#define LAS __attribute__((address_space(3)))
#define GAS __attribute__((address_space(1)))
constexpr int S = 8192, D = 2048, NMEM = 256;
constexpr int AW = 1024, IQW = 1024, IDXD = 64, NIH = 16, RQK = 1024, RVW = 2048, MW = 1024;
constexpr int INC = 17488, DFF = 5632;
constexpr int C_AQ = 0, C_AK = 1024, C_AV = 2048, C_IQ = 3072, C_IK = 4096, C_IW = 4160, C_RQ = 4176, C_RK = 5200, C_RV = 6224, C_RG = 8272, C_MQ = 10320, C_GT = 11344;
static_assert(C_GT + 3 * D == INC, "cols");
constexpr float EPS = 1e-6f;
constexpr int NP_IN = 69 * 256;
constexpr int NWAVES = 8, NT = NWAVES * 64;

constexpr size_t MiB = 1u << 20;
constexpr size_t WS_CTL = 0, CTL_ZERO_BYTES = 1 * MiB;
constexpr size_t WS_WIN = 2 * MiB, WS_WMEMKV = 71 * MiB, WS_WA = 79 * MiB, WS_WB = 83 * MiB, WS_WC = 91 * MiB, WS_WOUT = 95 * MiB, WS_WFFIN = 103 * MiB, WS_WFFOUT = 147 * MiB;
constexpr size_t WS_XN = 169 * MiB, WS_MEMN = 201 * MiB, WS_ROPE128 = 202 * MiB, WS_ROPE64 = 206 * MiB;
constexpr size_t WS_AQ = 208 * MiB, WS_AK = 224 * MiB, WS_AV = 240 * MiB, WS_IQ = 256 * MiB, WS_RQ = 272 * MiB, WS_RK = 288 * MiB, WS_MQ = 304 * MiB;
constexpr size_t WS_RV = 320 * MiB, WS_RG = 352 * MiB, WS_GATES = 384 * MiB;
constexpr size_t WS_IK = 480 * MiB, WS_IW = 481 * MiB, WS_MEMK = 482 * MiB, WS_MVT = 483 * MiB, WS_MASK = 484 * MiB, WS_PREV = 492 * MiB, WS_RKT = 524 * MiB;
constexpr size_t WS_AVT = 240 * MiB;
constexpr size_t WS_RVT = 320 * MiB;
constexpr size_t WS_OA = WS_IQ, WS_OC = WS_XN, WS_OB = WS_RG;
constexpr size_t WS_KVS = 2 * MiB;
constexpr size_t WS_MIXED = 2 * MiB, WS_MIXEDB = 208 * MiB, WS_Y = 272 * MiB, WS_ACT = 384 * MiB;
constexpr size_t WS_END = 540 * MiB;
static_assert(WS_WIN + (size_t)NP_IN * D * 2 == WS_WMEMKV, "in-proj and mem-kv weight copies must be contiguous");
static_assert(WS_XN + (size_t)S * D * 2 == WS_MEMN, "XN and MEMN must be contiguous");

__device__ __forceinline__ float bf2f(bf16_t b) { return __uint_as_float(((unsigned)b) << 16); }
__device__ __forceinline__ bf16_t f2bf(float f) { unsigned u = __float_as_uint(f); return (bf16_t)((u + 0x7fffu + ((u >> 16) & 1u)) >> 16); }
__device__ __forceinline__ unsigned pk2(float lo, float hi) { return (unsigned)f2bf(lo) | ((unsigned)f2bf(hi) << 16); }
__device__ __forceinline__ unsigned pkh2(float lo, float hi) { const f16_t a = (f16_t)lo, b = (f16_t)hi; return (unsigned)__builtin_bit_cast(unsigned short, a) | ((unsigned)__builtin_bit_cast(unsigned short, b) << 16); }
__device__ __forceinline__ float wave_sum(float v) {
#pragma unroll
    for (int o = 1; o < 64; o <<= 1) v += __shfl_xor(v, o);
    return v;
}
__device__ __forceinline__ float wave_max(float v) {
#pragma unroll
    for (int o = 1; o < 64; o <<= 1) v = fmaxf(v, __shfl_xor(v, o));
    return v;
}
__device__ __forceinline__ float sigmoidf_(float x) { return 1.0f / (1.0f + __expf(-x)); }
__device__ __forceinline__ float siluf_(float x) { return x / (1.0f + __expf(-x)); }

__constant__ double ROPE_FREQ[64] = {1.0, 0.8659643233600653, 0.7498942093324559, 0.6493816315762113, 0.5623413251903491, 0.4869675251658631, 0.4216965034285822, 0.3651741272548377, 0.31622776601683794, 0.27384196342643613, 0.23713737056616552, 0.2053525026457146, 0.1778279410038923, 0.1539926526059492, 0.1333521432163324, 0.11547819846894582, 0.1, 0.08659643233600653, 0.07498942093324558, 0.06493816315762113, 0.05623413251903491, 0.04869675251658631, 0.042169650342858224, 0.03651741272548377, 0.03162277660168379, 0.027384196342643614, 0.023713737056616554, 0.02053525026457146, 0.01778279410038923, 0.01539926526059492, 0.01333521432163324, 0.011547819846894581, 0.01, 0.008659643233600654, 0.007498942093324558, 0.006493816315762113, 0.005623413251903491, 0.004869675251658631, 0.004216965034285823, 0.003651741272548377, 0.0031622776601683794, 0.0027384196342643613, 0.0023713737056616554, 0.002053525026457146, 0.0017782794100389228, 0.001539926526059492, 0.001333521432163324, 0.0011547819846894581, 0.001, 0.0008659643233600654, 0.0007498942093324559, 0.0006493816315762113, 0.0005623413251903491, 0.0004869675251658631, 0.00042169650342858224, 0.0003651741272548377, 0.00031622776601683794, 0.0002738419634264361, 0.00023713737056616554, 0.0002053525026457146, 0.00017782794100389227, 0.0001539926526059492, 0.0001333521432163324, 0.00011547819846894582};

__device__ __forceinline__ void sincos_d(double a, float& s, float& c) {
    const double n = rint(a * 0.63661977236758134308);
    double r = fma(-n, 1.57079632679489655800, a);
    r = fma(-n, 6.12323399573676603587e-17, r);
    const double r2 = r * r;
    double sp = -7.6471637318198164759e-13;
    sp = fma(sp, r2, 1.6059043836821614599e-10); sp = fma(sp, r2, -2.5052108385441718775e-08); sp = fma(sp, r2, 2.7557319223985890653e-06);
    sp = fma(sp, r2, -1.9841269841269841270e-04); sp = fma(sp, r2, 8.3333333333333333333e-03); sp = fma(sp, r2, -1.6666666666666666667e-01);
    const double sn = fma(sp * r2, r, r);
    double cp = 4.7794773323873852974e-14;
    cp = fma(cp, r2, -1.1470745597729724714e-11); cp = fma(cp, r2, 2.0876756987868098979e-09); cp = fma(cp, r2, -2.7557319223985890653e-07);
    cp = fma(cp, r2, 2.4801587301587301587e-05); cp = fma(cp, r2, -1.3888888888888888889e-03); cp = fma(cp, r2, 4.1666666666666666667e-02); cp = fma(cp, r2, -0.5);
    const double cs = fma(cp, r2, 1.0);
    const int q = ((int)n) & 3;
    const double ss = (q == 0) ? sn : (q == 1) ? cs : (q == 2) ? -sn : -cs;
    const double cc = (q == 0) ? cs : (q == 1) ? -sn : (q == 2) ? -cs : sn;
    s = (float)ss; c = (float)cc;
}
namespace pg8 {
#define PG8_LAS __attribute__((address_space(3)))
typedef unsigned short bf16_t;
typedef short bf16x8 __attribute__((ext_vector_type(8)));
typedef float f32x4 __attribute__((ext_vector_type(4)));
typedef unsigned u32x4 __attribute__((ext_vector_type(4)));
constexpr int BM = 256, BK = 64, HALF = 128, HTB = HALF * BK * 2  , STAGE_BYTES = 8 * HTB, NXCD = 8, WGM = 8;

__host__ __device__ __forceinline__ int lds_byte(int r, int c) { const int st = (r >> 4) * 2 + (c >> 5), rr = r & 15, cc = c & 31, ob = rr * 64 + cc * 2; return st * 1024 + (ob ^ (((ob >> 9) & 1) << 5)); }
__host__ __device__ __forceinline__ void stage_rc(int b, int& R, int& C) { const int st = b / 1024, sb = b % 1024, swz = sb ^ (((sb >> 9) & 1) << 5); R = (st >> 1) * 16 + swz / 64; C = (st & 1) * 32 + (swz % 64) / 2; }
__host__ __device__ __forceinline__ int perm32(int rho) { const int n = rho >> 4, i = rho & 15; return 8 * (i >> 2) + 4 * n + (i & 3); }

struct Unit { int pm, pn, kd; };
struct Gemm { const bf16_t* A; const bf16_t* Bt; int M, N, K; };

struct StaticOrder {
    int nM, nN, nwg, G, c;
    __host__ __device__ void init(int M, int N, int G_, int c_) { nM = M / BM; nN = N / BM; nwg = nM * nN; G = G_; c = c_; }
    __host__ __device__ bool next(int i, Unit& u) const {
        const long L = (long)i * G + c; if (L >= nwg) return false;
        int wgid = (int)L; { const int q = nwg / NXCD, r = nwg % NXCD, xcd = wgid % NXCD, off = wgid / NXCD; wgid = (xcd < r ? xcd * (q + 1) : r * (q + 1) + (xcd - r) * q) + off; }
        const int nig = WGM * nN, gid = wgid / nig, fm = gid * WGM, gsz = (nM - fm) < WGM ? (nM - fm) : WGM;
        u.pm = fm + ((wgid % nig) % gsz); u.pn = (wgid % nig) / gsz; return true;
    }
    __device__ __forceinline__ void a_ready(const Unit&) const {}
    __device__ __forceinline__ void done(const Unit&) const {}
};

__device__ __forceinline__ unsigned cvt_pk_bf16(float lo, float hi) { unsigned r; asm volatile("v_cvt_pk_bf16_f32 %0, %1, %2" : "=v"(r) : "v"(lo), "v"(hi)); return r; }
__device__ __forceinline__ unsigned cvt_pk_f16(float lo, float hi) { const _Float16 a = (_Float16)lo, b = (_Float16)hi; return (unsigned)__builtin_bit_cast(unsigned short, a) | ((unsigned)__builtin_bit_cast(unsigned short, b) << 16); }
__device__ __forceinline__ bf16_t f2bf_dev(float f) { unsigned u = __float_as_uint(f); return (bf16_t)((u + 0x7fffu + ((u >> 16) & 1u)) >> 16); }
__device__ __forceinline__ int tokperm(int s) { return (s & ~12) | ((s & 4) << 1) | ((s & 8) >> 1); }
__device__ __forceinline__ float ret_l2gamma(int h) { return log1pf(-exp2f(-5.0f - (float)h)) * 1.4426950408889634f; }
__device__ __forceinline__ float ep_sigmoid(float x) { return __builtin_amdgcn_rcpf(1.0f + __builtin_amdgcn_exp2f(-1.4426950408889634f * x)); }
__device__ __forceinline__ float ep_silu(float x) { return x * ep_sigmoid(x); }

struct EpiInProj {
    static constexpr bool PERM = true, AFTER_DRAIN = false;
    unsigned char* ws;
    __device__ __forceinline__ void operator()(const f32x4 (&acc)[2][2][4][2], const Unit& u, int wr, int wc, int fr, int fq) const {
        const int pn = u.pn, row0 = u.pm * BM + wr * 64 + fr;
        if (pn < 8 || (pn >= 16 && pn < 24)) {
            const size_t doff = pn < 8 ? WS_AQ + (size_t)(pn >> 2) * (16u << 20) : WS_RQ + (size_t)((pn - 16) >> 2) * (16u << 20);
            bf16_t* dst = (bf16_t*)(ws + doff); const float* R128 = (const float*)(ws + WS_ROPE128);
            const float sc0 = pn < 4 ? 0.08838834764831845f * 1.4426950408889634f : pn >= 20 ? 0.08838834764831845f : 1.0f;
            const int head = (pn & 3) * 2 + (wc >> 1), j0 = 32 * (wc & 1) + 8 * fq;
            const bool isrq = pn >= 16 && pn < 20, isrk = pn >= 20;
            const float l2g = ret_l2gamma(head);
#pragma unroll
            for (int ai = 0; ai < 2; ++ai)
#pragma unroll
                for (int m = 0; m < 4; ++m) {
                    const int row = row0 + ai * HALF + m * 16;
                    const f32x4* tb = (const f32x4*)(R128 + ((size_t)row * 64 + j0) * 2);
                    const f32x4 t0 = tb[0], t1 = tb[1], t2 = tb[2], t3 = tb[3];
                    const f32x4 a0 = acc[ai][0][m][0], a1 = acc[ai][0][m][1], b0 = acc[ai][1][m][0], b1 = acc[ai][1][m][1];
                    float y1[8], y2[8];
                    y1[0] = a0[0] * t0[0] - b0[0] * t0[1]; y1[1] = a0[1] * t0[2] - b0[1] * t0[3]; y1[2] = a0[2] * t1[0] - b0[2] * t1[1]; y1[3] = a0[3] * t1[2] - b0[3] * t1[3];
                    y1[4] = a1[0] * t2[0] - b1[0] * t2[1]; y1[5] = a1[1] * t2[2] - b1[1] * t2[3]; y1[6] = a1[2] * t3[0] - b1[2] * t3[1]; y1[7] = a1[3] * t3[2] - b1[3] * t3[3];
                    y2[0] = b0[0] * t0[0] + a0[0] * t0[1]; y2[1] = b0[1] * t0[2] + a0[1] * t0[3]; y2[2] = b0[2] * t1[0] + a0[2] * t1[1]; y2[3] = b0[3] * t1[2] + a0[3] * t1[3];
                    y2[4] = b1[0] * t2[0] + a1[0] * t2[1]; y2[5] = b1[1] * t2[2] + a1[1] * t2[3]; y2[6] = b1[2] * t3[0] + a1[2] * t3[1]; y2[7] = b1[3] * t3[2] + a1[3] * t3[3];
                    const float fi = (float)(row & 127);
                    const float sc = isrq ? __builtin_amdgcn_exp2f(fi * l2g) : isrk ? sc0 * __builtin_amdgcn_exp2f(-fi * l2g) : sc0;
                    u32x4 w1, w2;
                    w1.x = cvt_pk_bf16(y1[0] * sc, y1[1] * sc); w1.y = cvt_pk_bf16(y1[2] * sc, y1[3] * sc); w1.z = cvt_pk_bf16(y1[4] * sc, y1[5] * sc); w1.w = cvt_pk_bf16(y1[6] * sc, y1[7] * sc);
                    w2.x = cvt_pk_bf16(y2[0] * sc, y2[1] * sc); w2.y = cvt_pk_bf16(y2[2] * sc, y2[3] * sc); w2.z = cvt_pk_bf16(y2[4] * sc, y2[5] * sc); w2.w = cvt_pk_bf16(y2[6] * sc, y2[7] * sc);
                    bf16_t* o = dst + (size_t)row * 1024 + head * 128 + j0;
                    *(u32x4*)o = w1; *(u32x4*)(o + 64) = w2;
                    if (isrk) {
                        const float kt = sc0 * __builtin_amdgcn_exp2f((127.0f - fi) * l2g);
                        bf16_t* tp = (bf16_t*)(ws + WS_RKT) + ((size_t)head * 128 + j0) * S + tokperm(row);
#pragma unroll
                        for (int e = 0; e < 8; ++e) { tp[(size_t)e * S] = f2bf_dev(y1[e] * kt); tp[(size_t)(64 + e) * S] = f2bf_dev(y2[e] * kt); }
                    }
                }
        } else if ((pn >= 12 && pn < 16) || pn == 68) {
            const bool isq = pn != 68;
            if (isq || wc == 0) {
                unsigned short* dst = (unsigned short*)(ws + (isq ? WS_IQ : WS_IK)); const float* R64 = (const float*)(ws + WS_ROPE64); const int ld = isq ? 1024 : 64, hoff = isq ? ((pn - 12) * 4 + wc) * 64 : 0, j0 = 8 * fq;
                const float sc = isq ? 0.125f : 1.0f;
#pragma unroll
                for (int ai = 0; ai < 2; ++ai)
#pragma unroll
                    for (int m = 0; m < 4; ++m) {
                        const int row = row0 + ai * HALF + m * 16;
                        const f32x4* tb = (const f32x4*)(R64 + ((size_t)row * 32 + j0) * 2);
                        const f32x4 t0 = tb[0], t1 = tb[1], t2 = tb[2], t3 = tb[3];
                        const f32x4 a0 = acc[ai][0][m][0], a1 = acc[ai][0][m][1], b0 = acc[ai][1][m][0], b1 = acc[ai][1][m][1];
                        u32x4 w1, w2;
                        w1.x = cvt_pk_f16((a0[0] * t0[0] - b0[0] * t0[1]) * sc, (a0[1] * t0[2] - b0[1] * t0[3]) * sc);
                        w1.y = cvt_pk_f16((a0[2] * t1[0] - b0[2] * t1[1]) * sc, (a0[3] * t1[2] - b0[3] * t1[3]) * sc);
                        w1.z = cvt_pk_f16((a1[0] * t2[0] - b1[0] * t2[1]) * sc, (a1[1] * t2[2] - b1[1] * t2[3]) * sc);
                        w1.w = cvt_pk_f16((a1[2] * t3[0] - b1[2] * t3[1]) * sc, (a1[3] * t3[2] - b1[3] * t3[3]) * sc);
                        w2.x = cvt_pk_f16((b0[0] * t0[0] + a0[0] * t0[1]) * sc, (b0[1] * t0[2] + a0[1] * t0[3]) * sc);
                        w2.y = cvt_pk_f16((b0[2] * t1[0] + a0[2] * t1[1]) * sc, (b0[3] * t1[2] + a0[3] * t1[3]) * sc);
                        w2.z = cvt_pk_f16((b1[0] * t2[0] + a1[0] * t2[1]) * sc, (b1[1] * t2[2] + a1[1] * t2[3]) * sc);
                        w2.w = cvt_pk_f16((b1[2] * t3[0] + a1[2] * t3[1]) * sc, (b1[3] * t3[2] + a1[3] * t3[3]) * sc);
                        unsigned short* o = dst + (size_t)row * ld + hoff + j0;
                        *(u32x4*)o = w1; *(u32x4*)(o + 32) = w2;
                    }
            } else if (wc == 1 && fq < 2) {
#pragma unroll
                for (int ai = 0; ai < 2; ++ai)
#pragma unroll
                    for (int m = 0; m < 4; ++m) {
                        const int row = row0 + ai * HALF + m * 16;
                        float* o = (float*)(ws + WS_IW) + (size_t)row * 16 + 8 * fq;
                        *(f32x4*)o = acc[ai][0][m][0] * 0.25f; *(f32x4*)(o + 4) = acc[ai][0][m][1] * 0.25f;
                    }
            }
        } else {
            size_t doff; int ld, pl, act = 0, roff = 0, tr = 0, tld = S; float sc = 1.0f;
            if (pn < 12) { doff = WS_AVT; ld = 1024; pl = pn - 8; tr = 1; }
            else if (pn < 32) { doff = WS_RVT; ld = 2048; pl = pn - 24; tr = 1; }
            else if (pn < 40) { doff = WS_RG; ld = 2048; pl = pn - 32; act = 1; }
            else if (pn < 44) { doff = WS_MQ; ld = 1024; pl = pn - 40; sc = 0.0625f * 1.4426950408889634f; }
            else if (pn < 68) { doff = WS_GATES; ld = 6144; pl = pn - 44; act = 2; }
            else if (pn < 73) { doff = WS_MEMK; ld = 1024; pl = pn - 69; roff = S; }
            else { doff = WS_MVT; ld = 1024; pl = pn - 73; roff = S; tr = 1; tld = NMEM; }
            bf16_t* dst = (bf16_t*)(ws + doff);
            const int col0 = pl * BM + wc * 32 + 8 * fq;
            if (tr) {
#ifndef PROBE_TR_REPS
#define PROBE_TR_REPS 1
#endif
#pragma unroll 1
              for (int rep = 0; rep < PROBE_TR_REPS; ++rep)
#pragma unroll
                for (int ai = 0; ai < 2; ++ai)
#pragma unroll
                    for (int m = 0; m < 4; ++m) {
                        const int row = row0 - roff + ai * HALF + m * 16;
                        bf16_t* tp = dst + (size_t)col0 * tld + tokperm(row);
#pragma unroll
                        for (int bj = 0; bj < 2; ++bj) {
                            const f32x4 v0 = acc[ai][bj][m][0], v1 = acc[ai][bj][m][1];
#pragma unroll
                            for (int e = 0; e < 4; ++e) { tp[(size_t)(bj * HALF + e) * tld] = f2bf_dev(v0[e]); tp[(size_t)(bj * HALF + 4 + e) * tld] = f2bf_dev(v1[e]); }
                        }
                    }
                return;
            }
#pragma unroll
            for (int ai = 0; ai < 2; ++ai)
#pragma unroll
                for (int m = 0; m < 4; ++m) {
                    bf16_t* rowp = dst + (size_t)(row0 - roff + ai * HALF + m * 16) * ld + col0;
#pragma unroll
                    for (int bj = 0; bj < 2; ++bj) {
                        f32x4 v0 = acc[ai][bj][m][0], v1 = acc[ai][bj][m][1];
                        if (act == 1) { v0 = (f32x4){ep_silu(v0[0]), ep_silu(v0[1]), ep_silu(v0[2]), ep_silu(v0[3])}; v1 = (f32x4){ep_silu(v1[0]), ep_silu(v1[1]), ep_silu(v1[2]), ep_silu(v1[3])}; }
                        else if (act == 2) { v0 = (f32x4){ep_sigmoid(v0[0]), ep_sigmoid(v0[1]), ep_sigmoid(v0[2]), ep_sigmoid(v0[3])}; v1 = (f32x4){ep_sigmoid(v1[0]), ep_sigmoid(v1[1]), ep_sigmoid(v1[2]), ep_sigmoid(v1[3])}; }
                        else { v0 = v0 * sc; v1 = v1 * sc; }
                        u32x4 w; w.x = cvt_pk_bf16(v0[0], v0[1]); w.y = cvt_pk_bf16(v0[2], v0[3]); w.z = cvt_pk_bf16(v1[0], v1[1]); w.w = cvt_pk_bf16(v1[2], v1[3]);
                        *(u32x4*)(rowp + bj * HALF) = w;
                    }
                }
        }
    }
};

struct EpiGateAcc {
    static constexpr bool PERM = true, AFTER_DRAIN = false;
    float* F; bf16_t* OB; const bf16_t* G; int ldc, ldg, first, last;
    __device__ __forceinline__ void operator()(const f32x4 (&acc)[2][2][4][2], const Unit& u, int wr, int wc, int fr, int fq) const {
        const int row0 = u.pm * BM + wr * 64 + fr, col0 = u.pn * BM + wc * 32 + 8 * fq;
#pragma unroll
        for (int ai = 0; ai < 2; ++ai)
#pragma unroll
            for (int m = 0; m < 4; ++m) {
                const int row = row0 + ai * HALF + m * 16;
#pragma unroll
                for (int bj = 0; bj < 2; ++bj) {
                    const int col = col0 + bj * HALF;
                    const u32x4 gw = *(const u32x4*)(G + (size_t)row * ldg + col);
                    f32x4 g0, g1;
                    g0[0] = __uint_as_float(gw.x << 16); g0[1] = __uint_as_float(gw.x & 0xffff0000u); g0[2] = __uint_as_float(gw.y << 16); g0[3] = __uint_as_float(gw.y & 0xffff0000u);
                    g1[0] = __uint_as_float(gw.z << 16); g1[1] = __uint_as_float(gw.z & 0xffff0000u); g1[2] = __uint_as_float(gw.w << 16); g1[3] = __uint_as_float(gw.w & 0xffff0000u);
                    f32x4 v0 = acc[ai][bj][m][0] * g0, v1 = acc[ai][bj][m][1] * g1;
                    float* fp = F + (size_t)row * ldc + col;
                    if (!first) { v0 += *(const f32x4*)fp; v1 += *(const f32x4*)(fp + 4); }
                    if (last) { u32x4 w; w.x = cvt_pk_bf16(v0[0], v0[1]); w.y = cvt_pk_bf16(v0[2], v0[3]); w.z = cvt_pk_bf16(v1[0], v1[1]); w.w = cvt_pk_bf16(v1[2], v1[3]); *(u32x4*)(OB + (size_t)row * ldc + col) = w; }
                    else { *(f32x4*)fp = v0; *(f32x4*)(fp + 4) = v1; }
                }
            }
    }
};

struct EpiF32 {
    static constexpr bool PERM = true, AFTER_DRAIN = false;
    float* O; int ldc;
    __device__ __forceinline__ void operator()(const f32x4 (&acc)[2][2][4][2], const Unit& u, int wr, int wc, int fr, int fq) const {
        const int row0 = u.pm * BM + wr * 64 + fr, col0 = u.pn * BM + wc * 32 + 8 * fq;
#pragma unroll
        for (int ai = 0; ai < 2; ++ai)
#pragma unroll
            for (int m = 0; m < 4; ++m)
#pragma unroll
                for (int bj = 0; bj < 2; ++bj) { float* fp = O + (size_t)(row0 + ai * HALF + m * 16) * ldc + col0 + bj * HALF; *(f32x4*)fp = acc[ai][bj][m][0]; *(f32x4*)(fp + 4) = acc[ai][bj][m][1]; }
    }
};

struct EpiSwiGLU {
    static constexpr bool PERM = true, AFTER_DRAIN = false;
    bf16_t* O; int ldc;
    __device__ __forceinline__ void operator()(const f32x4 (&acc)[2][2][4][2], const Unit& u, int wr, int wc, int fr, int fq) const {
        const int row0 = u.pm * BM + wr * 64 + fr, col0 = u.pn * HALF + wc * 32 + 8 * fq;
#pragma unroll
        for (int ai = 0; ai < 2; ++ai)
#pragma unroll
            for (int m = 0; m < 4; ++m) {
                const f32x4 g0 = acc[ai][0][m][0], g1 = acc[ai][0][m][1], u0 = acc[ai][1][m][0], u1 = acc[ai][1][m][1];
                u32x4 w;
                w.x = cvt_pk_bf16(ep_silu(g0[0]) * u0[0], ep_silu(g0[1]) * u0[1]); w.y = cvt_pk_bf16(ep_silu(g0[2]) * u0[2], ep_silu(g0[3]) * u0[3]);
                w.z = cvt_pk_bf16(ep_silu(g1[0]) * u1[0], ep_silu(g1[1]) * u1[1]); w.w = cvt_pk_bf16(ep_silu(g1[2]) * u1[2], ep_silu(g1[3]) * u1[3]);
                *(u32x4*)(O + (size_t)(row0 + ai * HALF + m * 16) * ldc + col0) = w;
            }
    }
};

struct InProjOrder {
    StaticOrder so; int G, c;
    __device__ void init(int G_, int c_) { so.init(8192, 69 * 256, G_, c_); G = G_; c = c_; }
    __device__ bool next(int i, Unit& u) const {
        const long L = (long)i * G + c;
        if (L < so.nwg) return so.next(i, u);
        if (L < so.nwg + 8) { u.pm = 32; u.pn = 69 + (int)(L - so.nwg); return true; }
        return false;
    }
    __device__ __forceinline__ void a_ready(const Unit&) const {}
    __device__ __forceinline__ void done(const Unit&) const {}
};

template <class Epi, class Sched, bool ALIGN_EPI = false, bool SP2 = false>
__device__ __forceinline__ void gemm_phase(PG8_LAS unsigned char* lds, const Gemm g, const Sched& S, const Epi& E) {
    const int tid = threadIdx.x, wid = __builtin_amdgcn_readfirstlane(tid >> 6), lane = tid & 63, wr = wid >> 2, wc = wid & 3, fr = lane & 15, fq = lane >> 4;
    const int K = g.K, nt = K / BK;
    unsigned voffA[2], voffB[2];
#pragma unroll
    for (int i = 0; i < 2; ++i) { int R, C; stage_rc(tid * 16 + i * 8192, R, C); const int Rb = Epi::PERM ? ((R & ~31) + perm32(R & 31)) : R;
        voffA[i] = (unsigned)(R * K + C) * 2u; voffB[i] = (unsigned)(Rb * K + C) * 2u; }
    const size_t kstep = (size_t)(BK * 2);
    const size_t hstep = (size_t)HALF * K * 2;
    const size_t tstep = 2 * hstep;
    const unsigned ldsw = (unsigned)wid * 1024u;
    const int aoff = lds_byte(wr * 64 + fr, fq * 8), boff = lds_byte(wc * 32 + fr, fq * 8);
#define PG8_SA(b, h) (((b) * 2 + (h)) * HTB)
#define PG8_SB(b, h) ((4 + (b) * 2 + (h)) * HTB)
#define PG8_STAGE(bufoff, gbase, voff) do { _Pragma("unroll") for (int _i = 0; _i < 2; ++_i) \
        __builtin_amdgcn_global_load_lds((const unsigned*)((const char*)(gbase) + (voff)[_i]), (PG8_LAS unsigned*)(lds + (bufoff) + ldsw + _i * 8192), 16, 0, 0); } while (0)
#define PG8_LDA(dst, b, h) do { _Pragma("unroll") for (int m = 0; m < 4; ++m) _Pragma("unroll") for (int k = 0; k < 2; ++k) dst[m][k] = *(const PG8_LAS bf16x8*)(lds + PG8_SA(b, h) + aoff + m * 2048 + k * 1024); } while (0)
#define PG8_LDB(dst, b, h) do { _Pragma("unroll") for (int n = 0; n < 2; ++n) _Pragma("unroll") for (int k = 0; k < 2; ++k) dst[n][k] = *(const PG8_LAS bf16x8*)(lds + PG8_SB(b, h) + boff + n * 2048 + k * 1024); } while (0)
#define PG8_MMA(ai, bj, At, Bt) do { __builtin_amdgcn_s_setprio(1); _Pragma("unroll") for (int m = 0; m < 4; ++m) _Pragma("unroll") for (int n = 0; n < 2; ++n) _Pragma("unroll") for (int k = 0; k < 2; ++k) \
        acc[ai][bj][m][n] = __builtin_amdgcn_mfma_f32_16x16x32_bf16(Bt[n][k], At[m][k], acc[ai][bj][m][n], 0, 0, 0); __builtin_amdgcn_s_setprio(0); } while (0)
#define PG8_WAIT_V(n) asm volatile("s_waitcnt vmcnt(" #n ")" ::: "memory")
#define PG8_WAIT_L(n) asm volatile("s_waitcnt lgkmcnt(" #n ")" ::: "memory")
#define PG8_BAR __builtin_amdgcn_s_barrier()
#define PG8_SCHED __builtin_amdgcn_sched_barrier(0)
    Unit cur, nxt; int ui = 0;
    if (!S.next(0, cur)) return;
    f32x4 acc[2][2][4][2];
#pragma unroll
    for (int a = 0; a < 2; ++a)
#pragma unroll
        for (int b = 0; b < 2; ++b)
#pragma unroll
            for (int m = 0; m < 4; ++m)
#pragma unroll
                for (int n = 0; n < 2; ++n) acc[a][b][m][n] = (f32x4){0.f, 0.f, 0.f, 0.f};
    bf16x8 At[4][2], B0[2][2], B1[2][2];
    const char* cA = (const char*)g.A + (size_t)cur.pm * tstep; const char* cB = (const char*)g.Bt + (size_t)cur.pn * tstep;
    S.a_ready(cur);
    if constexpr (SP2) {
        PG8_STAGE(PG8_SB(0, 0), cB, voffB); PG8_STAGE(PG8_SB(0, 1), cB + hstep, voffB); PG8_STAGE(PG8_SA(0, 0), cA, voffA); PG8_STAGE(PG8_SA(0, 1), cA + hstep, voffA);
        if (wr == 1) PG8_BAR;
        PG8_WAIT_V(2); PG8_BAR;
        PG8_STAGE(PG8_SB(1, 0), cB + kstep, voffB); PG8_STAGE(PG8_SA(1, 0), cA + kstep, voffA); PG8_STAGE(PG8_SB(1, 1), cB + hstep + kstep, voffB);
        PG8_WAIT_V(6); PG8_BAR;
    } else {
        PG8_STAGE(PG8_SB(0, 0), cB, voffB); PG8_STAGE(PG8_SA(0, 0), cA, voffA); PG8_STAGE(PG8_SB(0, 1), cB + hstep, voffB); PG8_STAGE(PG8_SA(0, 1), cA + hstep, voffA);
        if (wr == 1) PG8_BAR;
        PG8_WAIT_V(4); PG8_BAR;
        PG8_STAGE(PG8_SB(1, 0), cB + kstep, voffB); PG8_STAGE(PG8_SA(1, 0), cA + kstep, voffA); PG8_STAGE(PG8_SB(1, 1), cB + hstep + kstep, voffB);
        PG8_WAIT_V(6); PG8_BAR;
    }
    for (;;) {
        const bool has_next = S.next(ui + 1, nxt);
        const char* nA = has_next ? (const char*)g.A + (size_t)nxt.pm * tstep : cA; const char* nB = has_next ? (const char*)g.Bt + (size_t)nxt.pn * tstep : cB;
        for (int t = 0; t < nt; t += 2) {
            const bool last = (t == nt - 2);
            const char* a1 = cA + (size_t)(t + 1) * kstep;
            const char* a2 = last ? nA : cA + (size_t)(t + 2) * kstep; const char* b2 = last ? nB : cB + (size_t)(t + 2) * kstep;
            const char* a3 = a2 + kstep; const char* b3 = b2 + kstep;
            if (last && has_next) S.a_ready(nxt);
            if constexpr (SP2) {
            PG8_LDB(B0, 0, 0); PG8_LDB(B1, 0, 1); PG8_SCHED; PG8_LDA(At, 0, 0); PG8_STAGE(PG8_SA(1, 1), a1 + hstep, voffA);
            PG8_WAIT_V(8); PG8_WAIT_L(0); PG8_BAR; PG8_MMA(0, 0, At, B0); PG8_MMA(0, 1, At, B1); PG8_BAR; PG8_SCHED;
            PG8_LDA(At, 0, 1); PG8_STAGE(PG8_SB(0, 0), b2, voffB); PG8_STAGE(PG8_SB(0, 1), b2 + hstep, voffB); PG8_STAGE(PG8_SA(0, 0), a2, voffA);
            PG8_WAIT_V(8); PG8_WAIT_L(0); PG8_BAR; PG8_MMA(1, 0, At, B0); PG8_MMA(1, 1, At, B1); PG8_BAR; PG8_SCHED;
            PG8_LDB(B0, 1, 0); PG8_LDB(B1, 1, 1); PG8_SCHED; PG8_LDA(At, 1, 0); PG8_STAGE(PG8_SA(0, 1), a2 + hstep, voffA);
            PG8_WAIT_V(8); PG8_WAIT_L(0); PG8_BAR; PG8_MMA(0, 0, At, B0); PG8_MMA(0, 1, At, B1); PG8_BAR; PG8_SCHED;
            PG8_LDA(At, 1, 1); PG8_STAGE(PG8_SB(1, 0), b3, voffB); PG8_STAGE(PG8_SB(1, 1), b3 + hstep, voffB); PG8_STAGE(PG8_SA(1, 0), a3, voffA);
            PG8_WAIT_V(8); PG8_WAIT_L(0); PG8_BAR; PG8_MMA(1, 0, At, B0); PG8_MMA(1, 1, At, B1); PG8_BAR; PG8_SCHED;
            } else {
            PG8_LDB(B0, 0, 0); PG8_SCHED; PG8_LDA(At, 0, 0); PG8_STAGE(PG8_SA(1, 1), a1 + hstep, voffA);
            PG8_WAIT_L(8); PG8_BAR; PG8_WAIT_L(0); PG8_MMA(0, 0, At, B0); PG8_BAR; PG8_SCHED;
            PG8_LDB(B1, 0, 1); PG8_STAGE(PG8_SB(0, 0), b2, voffB);
            PG8_BAR; PG8_WAIT_L(0); PG8_MMA(0, 1, At, B1); PG8_BAR;
            PG8_LDA(At, 0, 1); PG8_STAGE(PG8_SA(0, 0), a2, voffA);
            PG8_BAR; PG8_WAIT_L(0); PG8_MMA(1, 0, At, B0); PG8_BAR; PG8_SCHED;
            PG8_STAGE(PG8_SB(0, 1), b2 + hstep, voffB);
            PG8_WAIT_V(6); PG8_BAR; PG8_MMA(1, 1, At, B1); PG8_BAR;
            PG8_LDB(B0, 1, 0); PG8_SCHED; PG8_LDA(At, 1, 0); PG8_STAGE(PG8_SA(0, 1), a2 + hstep, voffA);
            PG8_WAIT_L(8); PG8_BAR; PG8_WAIT_L(0); PG8_MMA(0, 0, At, B0); PG8_BAR; PG8_SCHED;
            PG8_LDB(B1, 1, 1); PG8_STAGE(PG8_SB(1, 0), b3, voffB);
            PG8_BAR; PG8_WAIT_L(0); PG8_MMA(0, 1, At, B1); PG8_BAR;
            PG8_LDA(At, 1, 1); PG8_STAGE(PG8_SA(1, 0), a3, voffA);
            PG8_BAR; PG8_WAIT_L(0); PG8_MMA(1, 0, At, B0); PG8_BAR; PG8_SCHED;
            PG8_STAGE(PG8_SB(1, 1), b3 + hstep, voffB);
            PG8_WAIT_V(6); PG8_BAR; PG8_MMA(1, 1, At, B1); PG8_BAR;
            }
        }
        if constexpr (ALIGN_EPI) { if (wr == 0) PG8_BAR; }
        if constexpr (!Epi::AFTER_DRAIN) { E(acc, cur, wr, wc, fr, fq); S.done(cur); }
        if (!has_next) break;
#pragma unroll
        for (int a = 0; a < 2; ++a)
#pragma unroll
            for (int b = 0; b < 2; ++b)
#pragma unroll
                for (int m = 0; m < 4; ++m)
#pragma unroll
                    for (int n = 0; n < 2; ++n) acc[a][b][m][n] = (f32x4){0.f, 0.f, 0.f, 0.f};
        cur = nxt; cA = nA; cB = nB; ++ui;
        if constexpr (ALIGN_EPI) { if (wr == 1) PG8_BAR; }
    }
    PG8_WAIT_V(0);
    if constexpr (!ALIGN_EPI) { if (wr == 0) PG8_BAR; }
    PG8_BAR;
    if constexpr (Epi::AFTER_DRAIN) { E.fused(acc, cur, wr, wc, fr, fq, lds, wid, lane); S.done(cur); }
#undef PG8_SA
#undef PG8_SB
#undef PG8_STAGE
#undef PG8_LDA
#undef PG8_LDB
#undef PG8_MMA
#undef PG8_WAIT_V
#undef PG8_WAIT_L
#undef PG8_BAR
#undef PG8_SCHED
}
template <class Epi, class Sched, bool ALIGN_EPI = false, bool SP2 = false>
__device__ __forceinline__ void gemm_phase_chain(PG8_LAS unsigned char* lds, const Sched& S, const Epi& E) {
    const int tid = threadIdx.x, wid = __builtin_amdgcn_readfirstlane(tid >> 6), lane = tid & 63, wr = wid >> 2, wc = wid & 3, fr = lane & 15, fq = lane >> 4;
    unsigned rA, rB, cc;
    { int R, C; stage_rc(tid * 16, R, C); const int Rb = Epi::PERM ? ((R & ~31) + perm32(R & 31)) : R; rA = (unsigned)R; rB = (unsigned)Rb; cc = (unsigned)C * 2u; }
    const size_t kstep = (size_t)(BK * 2);
    const unsigned ldsw = (unsigned)wid * 1024u;
    const int aoff = lds_byte(wr * 64 + fr, fq * 8), boff = lds_byte(wc * 32 + fr, fq * 8);
#define PG8_SA(b, h) (((b) * 2 + (h)) * HTB)
#define PG8_SB(b, h) ((4 + (b) * 2 + (h)) * HTB)
#define PG8_STAGE(bufoff, gbase, rr, p2) do { _Pragma("unroll") for (int _i = 0; _i < 2; ++_i) \
        __builtin_amdgcn_global_load_lds((const unsigned*)((const char*)(gbase) + (size_t)(_i * 64) * (p2) + ((rr) * (unsigned)(p2) + cc)), (PG8_LAS unsigned*)(lds + (bufoff) + ldsw + _i * 8192), 16, 0, 0); } while (0)
#define PG8_LDA(dst, b, h) do { _Pragma("unroll") for (int m = 0; m < 4; ++m) _Pragma("unroll") for (int k = 0; k < 2; ++k) dst[m][k] = *(const PG8_LAS bf16x8*)(lds + PG8_SA(b, h) + aoff + m * 2048 + k * 1024); } while (0)
#define PG8_LDB(dst, b, h) do { _Pragma("unroll") for (int n = 0; n < 2; ++n) _Pragma("unroll") for (int k = 0; k < 2; ++k) dst[n][k] = *(const PG8_LAS bf16x8*)(lds + PG8_SB(b, h) + boff + n * 2048 + k * 1024); } while (0)
#define PG8_MMA(ai, bj, At, Bt) do { __builtin_amdgcn_s_setprio(1); _Pragma("unroll") for (int m = 0; m < 4; ++m) _Pragma("unroll") for (int n = 0; n < 2; ++n) _Pragma("unroll") for (int k = 0; k < 2; ++k) \
        acc[ai][bj][m][n] = __builtin_amdgcn_mfma_f32_16x16x32_bf16(Bt[n][k], At[m][k], acc[ai][bj][m][n], 0, 0, 0); __builtin_amdgcn_s_setprio(0); } while (0)
#define PG8_WAIT_V(n) asm volatile("s_waitcnt vmcnt(" #n ")" ::: "memory")
#define PG8_WAIT_L(n) asm volatile("s_waitcnt lgkmcnt(" #n ")" ::: "memory")
#define PG8_BAR __builtin_amdgcn_s_barrier()
#define PG8_SCHED __builtin_amdgcn_sched_barrier(0)
    Unit cur, nxt; int ui = 0;
    if (!S.next(0, cur)) return;
    f32x4 acc[2][2][4][2];
#pragma unroll
    for (int a = 0; a < 2; ++a)
#pragma unroll
        for (int b = 0; b < 2; ++b)
#pragma unroll
            for (int m = 0; m < 4; ++m)
#pragma unroll
                for (int n = 0; n < 2; ++n) acc[a][b][m][n] = (f32x4){0.f, 0.f, 0.f, 0.f};
    bf16x8 At[4][2], B0[2][2], B1[2][2];
    const char* cA; const char* cB; int cK; S.ptrs(cur, cA, cB, cK);
    int nt = cK / BK; unsigned cp2 = 2u * (unsigned)cK; size_t hstep = (size_t)HALF * cK * 2;
    S.a_ready(cur);
    if constexpr (SP2) {
        PG8_STAGE(PG8_SB(0, 0), cB, rB, cp2); PG8_STAGE(PG8_SB(0, 1), cB + hstep, rB, cp2); PG8_STAGE(PG8_SA(0, 0), cA, rA, cp2); PG8_STAGE(PG8_SA(0, 1), cA + hstep, rA, cp2);
        if (wr == 1) PG8_BAR;
        PG8_WAIT_V(2); PG8_BAR;
        PG8_STAGE(PG8_SB(1, 0), cB + kstep, rB, cp2); PG8_STAGE(PG8_SA(1, 0), cA + kstep, rA, cp2); PG8_STAGE(PG8_SB(1, 1), cB + hstep + kstep, rB, cp2);
        PG8_WAIT_V(6); PG8_BAR;
    } else {
        PG8_STAGE(PG8_SB(0, 0), cB, rB, cp2); PG8_STAGE(PG8_SA(0, 0), cA, rA, cp2); PG8_STAGE(PG8_SB(0, 1), cB + hstep, rB, cp2); PG8_STAGE(PG8_SA(0, 1), cA + hstep, rA, cp2);
        if (wr == 1) PG8_BAR;
        PG8_WAIT_V(4); PG8_BAR;
        PG8_STAGE(PG8_SB(1, 0), cB + kstep, rB, cp2); PG8_STAGE(PG8_SA(1, 0), cA + kstep, rA, cp2); PG8_STAGE(PG8_SB(1, 1), cB + hstep + kstep, rB, cp2);
        PG8_WAIT_V(6); PG8_BAR;
    }
    for (;;) {
        const bool has_next = S.next(ui + 1, nxt);
        const char* nA = cA; const char* nB = cB; int nK = cK; if (has_next) S.ptrs(nxt, nA, nB, nK);
        const unsigned np2 = 2u * (unsigned)nK; const size_t nhstep = (size_t)HALF * nK * 2;
        for (int t = 0; t < nt; t += 2) {
            const bool last = (t == nt - 2);
            const unsigned p2x = last ? np2 : cp2; const size_t hsx = last ? nhstep : hstep;
            const char* a1 = cA + (size_t)(t + 1) * kstep;
            const char* a2 = last ? nA : cA + (size_t)(t + 2) * kstep; const char* b2 = last ? nB : cB + (size_t)(t + 2) * kstep;
            const char* a3 = a2 + kstep; const char* b3 = b2 + kstep;
            if (last && has_next) S.a_ready(nxt);
            if constexpr (SP2) {
            PG8_LDB(B0, 0, 0); PG8_LDB(B1, 0, 1); PG8_SCHED; PG8_LDA(At, 0, 0); PG8_STAGE(PG8_SA(1, 1), a1 + hstep, rA, cp2);
            PG8_WAIT_V(8); PG8_WAIT_L(0); PG8_BAR; PG8_MMA(0, 0, At, B0); PG8_MMA(0, 1, At, B1); PG8_BAR; PG8_SCHED;
            PG8_LDA(At, 0, 1); PG8_STAGE(PG8_SB(0, 0), b2, rB, p2x); PG8_STAGE(PG8_SB(0, 1), b2 + hsx, rB, p2x); PG8_STAGE(PG8_SA(0, 0), a2, rA, p2x);
            PG8_WAIT_V(8); PG8_WAIT_L(0); PG8_BAR; PG8_MMA(1, 0, At, B0); PG8_MMA(1, 1, At, B1); PG8_BAR; PG8_SCHED;
            PG8_LDB(B0, 1, 0); PG8_LDB(B1, 1, 1); PG8_SCHED; PG8_LDA(At, 1, 0); PG8_STAGE(PG8_SA(0, 1), a2 + hsx, rA, p2x);
            PG8_WAIT_V(8); PG8_WAIT_L(0); PG8_BAR; PG8_MMA(0, 0, At, B0); PG8_MMA(0, 1, At, B1); PG8_BAR; PG8_SCHED;
            PG8_LDA(At, 1, 1); PG8_STAGE(PG8_SB(1, 0), b3, rB, p2x); PG8_STAGE(PG8_SB(1, 1), b3 + hsx, rB, p2x); PG8_STAGE(PG8_SA(1, 0), a3, rA, p2x);
            PG8_WAIT_V(8); PG8_WAIT_L(0); PG8_BAR; PG8_MMA(1, 0, At, B0); PG8_MMA(1, 1, At, B1); PG8_BAR; PG8_SCHED;
            } else {
            PG8_LDB(B0, 0, 0); PG8_SCHED; PG8_LDA(At, 0, 0); PG8_STAGE(PG8_SA(1, 1), a1 + hstep, rA, cp2);
            PG8_WAIT_L(8); PG8_BAR; PG8_WAIT_L(0); PG8_MMA(0, 0, At, B0); PG8_BAR; PG8_SCHED;
            PG8_LDB(B1, 0, 1); PG8_STAGE(PG8_SB(0, 0), b2, rB, p2x);
            PG8_BAR; PG8_WAIT_L(0); PG8_MMA(0, 1, At, B1); PG8_BAR;
            PG8_LDA(At, 0, 1); PG8_STAGE(PG8_SA(0, 0), a2, rA, p2x);
            PG8_BAR; PG8_WAIT_L(0); PG8_MMA(1, 0, At, B0); PG8_BAR; PG8_SCHED;
            PG8_STAGE(PG8_SB(0, 1), b2 + hsx, rB, p2x);
            PG8_WAIT_V(6); PG8_BAR; PG8_MMA(1, 1, At, B1); PG8_BAR;
            PG8_LDB(B0, 1, 0); PG8_SCHED; PG8_LDA(At, 1, 0); PG8_STAGE(PG8_SA(0, 1), a2 + hsx, rA, p2x);
            PG8_WAIT_L(8); PG8_BAR; PG8_WAIT_L(0); PG8_MMA(0, 0, At, B0); PG8_BAR; PG8_SCHED;
            PG8_LDB(B1, 1, 1); PG8_STAGE(PG8_SB(1, 0), b3, rB, p2x);
            PG8_BAR; PG8_WAIT_L(0); PG8_MMA(0, 1, At, B1); PG8_BAR;
            PG8_LDA(At, 1, 1); PG8_STAGE(PG8_SA(1, 0), a3, rA, p2x);
            PG8_BAR; PG8_WAIT_L(0); PG8_MMA(1, 0, At, B0); PG8_BAR; PG8_SCHED;
            PG8_STAGE(PG8_SB(1, 1), b3 + hsx, rB, p2x);
            PG8_WAIT_V(6); PG8_BAR; PG8_MMA(1, 1, At, B1); PG8_BAR;
            }
        }
        if constexpr (ALIGN_EPI) { if (wr == 0) PG8_BAR; }
        E(acc, cur, wr, wc, fr, fq); S.done(cur);
        if (!has_next) break;
        cur = nxt; cA = nA; cB = nB; cK = nK; nt = cK / BK; cp2 = np2; hstep = nhstep; ++ui;
        if constexpr (ALIGN_EPI) { if (wr == 1) PG8_BAR; }
    }
    PG8_WAIT_V(0);
    if constexpr (!ALIGN_EPI) { if (wr == 0) PG8_BAR; }
    PG8_BAR;
#undef PG8_SA
#undef PG8_SB
#undef PG8_STAGE
#undef PG8_LDA
#undef PG8_LDB
#undef PG8_MMA
#undef PG8_WAIT_V
#undef PG8_WAIT_L
#undef PG8_BAR
#undef PG8_SCHED
}


struct MergeOrder {
    StaticOrder so; unsigned char* ws;
    __device__ void init(unsigned char* ws_, int G_, int c_) { so.init(S, D, G_, c_); ws = ws_; }
    __device__ bool next(int i, Unit& u) const { if (i >= 3) return false; const bool ok = so.next(0, u); u.kd = i; return ok; }
    __device__ __forceinline__ void ptrs(const Unit& u, const char*& A, const char*& B, int& K) const {
        const size_t ao = u.kd == 0 ? WS_OB : u.kd == 1 ? WS_OA : WS_OC, bo = u.kd == 0 ? WS_WB : u.kd == 1 ? WS_WA : WS_WC;
        K = u.kd == 0 ? RVW : 1024;
        A = (const char*)ws + ao + (size_t)u.pm * BM * K * 2; B = (const char*)ws + bo + (size_t)u.pn * BM * K * 2;
    }
    __device__ __forceinline__ void a_ready(const Unit&) const {}
    __device__ __forceinline__ void done(const Unit&) const {}
};
struct EpiGateChain {
    static constexpr bool PERM = true, AFTER_DRAIN = false;
    unsigned char* ws;
    __device__ __forceinline__ bool keep(const Unit& u) const { return u.kd < 2; }
    __device__ __forceinline__ void operator()(f32x4 (&acc)[2][2][4][2], const Unit& u, int wr, int wc, int fr, int fq) const {
        const int row0 = u.pm * BM + wr * 64 + fr, col0 = u.pn * BM + wc * 32 + 8 * fq;
        const int gc = u.kd == 0 ? D : u.kd == 1 ? 0 : 2 * D, gn = u.kd == 0 ? 0 : 2 * D;
        const bf16_t* G = (const bf16_t*)(ws + WS_GATES); bf16_t* OB = (bf16_t*)(ws + WS_MIXEDB);
        const bool last = u.kd == 2;
#pragma unroll
        for (int ai = 0; ai < 2; ++ai)
#pragma unroll
            for (int m = 0; m < 4; ++m) {
                const int row = row0 + ai * HALF + m * 16;
#pragma unroll
                for (int bj = 0; bj < 2; ++bj) {
                    const int col = col0 + bj * HALF;
                    const u32x4 gw = *(const u32x4*)(G + (size_t)row * (3 * D) + gc + col);
                    f32x4 g0, g1;
                    g0[0] = __uint_as_float(gw.x << 16); g0[1] = __uint_as_float(gw.x & 0xffff0000u); g0[2] = __uint_as_float(gw.y << 16); g0[3] = __uint_as_float(gw.y & 0xffff0000u);
                    g1[0] = __uint_as_float(gw.z << 16); g1[1] = __uint_as_float(gw.z & 0xffff0000u); g1[2] = __uint_as_float(gw.w << 16); g1[3] = __uint_as_float(gw.w & 0xffff0000u);
                    if (!last) {
                        const u32x4 hw = *(const u32x4*)(G + (size_t)row * (3 * D) + gn + col);
                        f32x4 h0, h1;
                        h0[0] = __uint_as_float(hw.x << 16); h0[1] = __uint_as_float(hw.x & 0xffff0000u); h0[2] = __uint_as_float(hw.y << 16); h0[3] = __uint_as_float(hw.y & 0xffff0000u);
                        h1[0] = __uint_as_float(hw.z << 16); h1[1] = __uint_as_float(hw.z & 0xffff0000u); h1[2] = __uint_as_float(hw.w << 16); h1[3] = __uint_as_float(hw.w & 0xffff0000u);
#pragma unroll
                        for (int e = 0; e < 4; ++e) { g0[e] *= __builtin_amdgcn_rcpf(fmaxf(h0[e], 1e-30f)); g1[e] *= __builtin_amdgcn_rcpf(fmaxf(h1[e], 1e-30f)); }
                    }
                    acc[ai][bj][m][0] = acc[ai][bj][m][0] * g0; acc[ai][bj][m][1] = acc[ai][bj][m][1] * g1;
                    if (last) {
                        const f32x4 v0 = acc[ai][bj][m][0], v1 = acc[ai][bj][m][1];
                        u32x4 w; w.x = cvt_pk_bf16(v0[0], v0[1]); w.y = cvt_pk_bf16(v0[2], v0[3]); w.z = cvt_pk_bf16(v1[0], v1[1]); w.w = cvt_pk_bf16(v1[2], v1[3]);
                        *(u32x4*)(OB + (size_t)row * D + col) = w;
                    }
                }
            }
    }
};
}

constexpr int RING_OFF = 0, RING_BYTES = 131072;
constexpr int LDSCTL_OFF = RING_BYTES, MISC_OFF = LDSCTL_OFF + 320;
constexpr int LDS_BYTES = 147456;
constexpr int CW_BAR = 4096;

typedef GAS unsigned gu32;
#define LDS_WAIT() asm volatile("s_waitcnt lgkmcnt(0)" ::: "memory")
#define XB_TMO      128
#define XB_XCNT(j)  (256  + 64 * (j))
#define XB_XSUB(j)  (1280 + 64 * (j))
#define XB_XGEN(j)  (2304 + 64 * (j))
#define XB_TOP      3328
#define XB_TOPGEN   3392
#define XCD_BAR_WORDS 3456
#define XB_SPIN_CAP (1u << 18)

__device__ __forceinline__ unsigned xb_ld(unsigned* p)              { return __hip_atomic_load(p, __ATOMIC_RELAXED, __HIP_MEMORY_SCOPE_AGENT); }
__device__ __forceinline__ unsigned xb_add(unsigned* p, unsigned v) { return __hip_atomic_fetch_add(p, v, __ATOMIC_RELAXED, __HIP_MEMORY_SCOPE_AGENT); }
__device__ __forceinline__ unsigned xb_xcc_id() { return (unsigned)__builtin_amdgcn_s_getreg((3 << 11) | 20) & 0xFu; }
#define XB_SPIN(cond, bar) do { unsigned _sp = 0; while (cond) { __builtin_amdgcn_s_sleep(1); \
    if ((++_sp & 255u) == 0u) { if (xb_ld(&(bar)[XB_TMO])) break; if (_sp > XB_SPIN_CAP) { atomicAdd(&(bar)[XB_TMO], 1u); break; } } } } while (0)

struct XcdBarrier {
    unsigned* bar; unsigned x;
    volatile LAS unsigned* st;
};

__device__ __forceinline__ XcdBarrier xcd_barrier_post(unsigned* bar, volatile LAS unsigned* st) {
    XcdBarrier b; b.bar = bar; b.x = xb_xcc_id(); b.st = st;
    if (threadIdx.x == 0) (void)xb_add(&bar[XB_XCNT(b.x)], 1u);
    return b;
}
__device__ __forceinline__ void xcd_barrier_complete(unsigned* bar, unsigned x, unsigned& nloc, unsigned& nx) {
    const unsigned G = gridDim.x * gridDim.y * gridDim.z;
    unsigned sum, cnt, mine, sp = 0u;
    for (;;) {
        sum = 0u; cnt = 0u; mine = 0u;
#pragma unroll
        for (unsigned j = 0; j < 16; ++j) { const unsigned c = xb_ld(&bar[XB_XCNT(j)]); sum += c; cnt += (c > 0u) ? 1u : 0u; mine = (j == x) ? c : mine; }
        if (sum == G) break;
        __builtin_amdgcn_s_sleep(1);
        if ((++sp & 255u) == 0u) { if (xb_ld(&bar[XB_TMO])) break; if (sp > XB_SPIN_CAP) { atomicAdd(&bar[XB_TMO], 1u); break; } }
    }
    nloc = mine > 0u ? mine : 1u; nx = cnt > 0u ? cnt : 1u;
}

__device__ __forceinline__ void xcd_barrier(const XcdBarrier& b) {
    asm volatile("s_waitcnt vmcnt(0)" ::: "memory");
    __syncthreads();
    if (threadIdx.x == 0) {
        unsigned* bar = b.bar;
        __builtin_amdgcn_s_waitcnt(0);
        unsigned nloc = b.st[0], nx = b.st[1];
        if (nloc == 0u) { xcd_barrier_complete(bar, b.x, nloc, nx); b.st[0] = nloc; b.st[1] = nx; }
        const unsigned old = xb_add(&bar[XB_XSUB(b.x)], 1u);
        const unsigned gen = old / nloc;
        if (old + 1u == (gen + 1u) * nloc) {
            __builtin_amdgcn_fence(__ATOMIC_RELEASE, "agent");
            asm volatile("s_waitcnt vmcnt(0)" ::: "memory");
            const unsigned og = xb_add(&bar[XB_TOP], 1u);
            const unsigned tg = og / nx;
            if (og + 1u == (tg + 1u) * nx) xb_add(&bar[XB_TOPGEN], 1u);
            else XB_SPIN(xb_ld(&bar[XB_TOPGEN]) == tg, bar);
            __builtin_amdgcn_fence(__ATOMIC_ACQUIRE, "agent");
            xb_add(&bar[XB_XGEN(b.x)], 1u);
            asm volatile("s_waitcnt vmcnt(0)" ::: "memory");
        } else {
            XB_SPIN(xb_ld(&bar[XB_XGEN(b.x)]) == gen, bar);
            __builtin_amdgcn_fence(__ATOMIC_ACQUIRE, "agent");
            asm volatile("s_waitcnt vmcnt(0)" ::: "memory");
        }
    }
    __syncthreads();
}

__device__ __forceinline__ int map_inproj(int np) {
    const int pn = np >> 8, p = np & 255, bj = p >> 7, q = p & 127;
    if (pn < 8 || (pn >= 16 && pn < 24)) { const int base = pn < 4 ? C_AQ : pn < 8 ? C_AK : pn < 20 ? C_RQ : C_RK; return base + ((pn & 3) * 2 + (q >> 6)) * 128 + bj * 64 + (q & 63); }
    if (pn >= 12 && pn < 16) return C_IQ + ((pn - 12) * 4 + (q >> 5)) * 64 + bj * 32 + (q & 31);
    if (pn == 68) { if (p < 32) return C_IK + p; if (p < 48) return C_IW + (p - 32); if (p >= 128 && p < 160) return C_IK + 32 + (p - 128); return -1; }
    int base, pl;
    if (pn < 12) { base = C_AV; pl = pn - 8; } else if (pn < 32) { base = C_RV; pl = pn - 24; } else if (pn < 40) { base = C_RG; pl = pn - 32; } else if (pn < 44) { base = C_MQ; pl = pn - 40; } else { base = C_GT; pl = pn - 44; }
    return base + pl * 256 + p;
}
__device__ __forceinline__ int map_ffin(int np) { return ((np >> 7) & 1) * DFF + (np >> 8) * 128 + (np & 127); }
template <int MAP> __device__ __forceinline__ void p0_transpose_item(const float* W, int K, int Nsrc, int Ndst, bf16_t* WT, LAS float* scr, int item, int lane) {
    const int nblk = Ndst / 32, kb = item / nblk, nb = item % nblk, k0 = 64 * kb, n0 = 32 * nb;
    const int np = n0 + (lane & 31);
    const int sc = MAP == 0 ? np : MAP == 1 ? map_inproj(np) : map_ffin(np);
    float tv[32];
    const float* wp = W + (size_t)(k0 + (lane >> 5)) * Nsrc + (sc >= 0 ? sc : 0);
#pragma unroll
    for (int i = 0; i < 32; ++i) tv[i] = wp[(size_t)(2 * i) * Nsrc];
#pragma unroll
    for (int i = 0; i < 32; ++i) { const int kk = 2 * i + (lane >> 5); scr[kk * 33 + (lane & 31)] = sc >= 0 ? tv[i] : 0.f; }
    LDS_WAIT(); asm volatile("" ::: "memory");
    const int c = lane & 7;
#pragma unroll
    for (int j = 0; j < 4; ++j) { const int n = (lane >> 3) + 8 * j; const LAS float* s = scr + (8 * c) * 33 + n;
        uint4 o; o.x = pk2(s[0 * 33], s[1 * 33]); o.y = pk2(s[2 * 33], s[3 * 33]); o.z = pk2(s[4 * 33], s[5 * 33]); o.w = pk2(s[6 * 33], s[7 * 33]);
        *(uint4*)(WT + (size_t)(n0 + n) * K + k0 + 8 * c) = o; }
    LDS_WAIT(); asm volatile("" ::: "memory");
}
__device__ __forceinline__ void rms_row_to_bf16(const float* src, const float* g, bf16_t* dst, int lane) {
    float v[32]; float ss = 0.f;
#pragma unroll
    for (int j = 0; j < 8; ++j) { const float4 t = *(const float4*)(src + j * 256 + lane * 4); v[4 * j] = t.x; v[4 * j + 1] = t.y; v[4 * j + 2] = t.z; v[4 * j + 3] = t.w; ss += t.x * t.x + t.y * t.y + t.z * t.z + t.w * t.w; }
    ss = wave_sum(ss);
    const float rs = rsqrtf(ss * (1.0f / D) + EPS);
#pragma unroll
    for (int j = 0; j < 8; ++j) { const float4 gg = *(const float4*)(g + j * 256 + lane * 4);
        uint2 o; o.x = pk2(v[4 * j] * rs * gg.x, v[4 * j + 1] * rs * gg.y); o.y = pk2(v[4 * j + 2] * rs * gg.z, v[4 * j + 3] * rs * gg.w);
        *(uint2*)(dst + j * 256 + lane * 4) = o; }
}

struct Ptrs {
    const float *x, *mem; const int* pos; const float *g_pre_mix, *g_mem, *w_in, *w_mem_kv, *w_a, *w_b, *w_c, *w_out, *g_post_mix, *g_pre_ffn, *w_ffn_in, *w_ffn_out, *g_post_ffn;
    float* out; unsigned char* ws;
};

__device__ __forceinline__ void p0_prologue(const Ptrs& P, LAS unsigned char* lds, int G) {
    const int tid = threadIdx.x, lane = tid & 63, wave = __builtin_amdgcn_readfirstlane(tid >> 6);
    LAS float* scr = (LAS float*)(lds + RING_OFF + wave * 16384);
    const int gw = blockIdx.x * NWAVES + wave, NGW = G * NWAVES;
    unsigned char* ws = P.ws;
    constexpr int I_IN = (D / 64) * (NP_IN / 32), I_MK = (D / 64) * (2048 / 32), I_A = (AW / 64) * (D / 32), I_B = (RVW / 64) * (D / 32), I_C = (MW / 64) * (D / 32), I_O = (D / 64) * (D / 32),
                  I_FI = (D / 64) * (2 * DFF / 32), I_FO = (DFF / 64) * (D / 32);
    constexpr int NITEMS = I_IN + I_MK + I_A + I_B + I_C + I_O + I_FI + I_FO;
    for (int it = gw; it < NITEMS; it += NGW) {
        int r = it;
        if (r < I_IN) { p0_transpose_item<1>(P.w_in, D, INC, NP_IN, (bf16_t*)(ws + WS_WIN), scr, r, lane); continue; } r -= I_IN;
        if (r < I_MK) { p0_transpose_item<0>(P.w_mem_kv, D, 2048, 2048, (bf16_t*)(ws + WS_WMEMKV), scr, r, lane); continue; } r -= I_MK;
        if (r < I_A) { p0_transpose_item<0>(P.w_a, AW, D, D, (bf16_t*)(ws + WS_WA), scr, r, lane); continue; } r -= I_A;
        if (r < I_B) { p0_transpose_item<0>(P.w_b, RVW, D, D, (bf16_t*)(ws + WS_WB), scr, r, lane); continue; } r -= I_B;
        if (r < I_C) { p0_transpose_item<0>(P.w_c, MW, D, D, (bf16_t*)(ws + WS_WC), scr, r, lane); continue; } r -= I_C;
        if (r < I_O) { p0_transpose_item<0>(P.w_out, D, D, D, (bf16_t*)(ws + WS_WOUT), scr, r, lane); continue; } r -= I_O;
        if (r < I_FI) { p0_transpose_item<2>(P.w_ffn_in, D, 2 * DFF, 2 * DFF, (bf16_t*)(ws + WS_WFFIN), scr, r, lane); continue; } r -= I_FI;
        p0_transpose_item<0>(P.w_ffn_out, DFF, D, D, (bf16_t*)(ws + WS_WFFOUT), scr, r, lane);
    }
    for (int r = gw; r < S + NMEM; r += NGW) {
        if (r < S) rms_row_to_bf16(P.x + (size_t)r * D, P.g_pre_mix, (bf16_t*)(ws + WS_XN) + (size_t)r * D, lane);
        else rms_row_to_bf16(P.mem + (size_t)(r - S) * D, P.g_mem, (bf16_t*)(ws + WS_MEMN) + (size_t)(r - S) * D, lane);
    }
    float* R128 = (float*)(ws + WS_ROPE128); float* R64 = (float*)(ws + WS_ROPE64);
    for (int i = blockIdx.x * NT + tid; i < S * 64; i += G * NT) {
        const int s = i >> 6, j = i & 63;
        const float ang = (float)P.pos[s] * (float)ROPE_FREQ[j];
        float sn, cs; sincos_d((double)ang, sn, cs);
        *(float2*)(R128 + 2 * i) = make_float2(cs, sn);
        if ((j & 1) == 0) { const int i2 = s * 32 + (j >> 1); *(float2*)(R64 + 2 * i2) = make_float2(cs, sn); }
    }
}

__device__ __forceinline__ unsigned ordkey(float f) { const unsigned u = __float_as_uint(f); return (u & 0x80000000u) ? ~u : (u | 0x80000000u); }
__device__ __forceinline__ float ret_loggamma(int h) { return log1pf(-exp2f(-5.0f - (float)h)); }

__device__ __forceinline__ void naive_index(const Ptrs& P, unsigned char* lds, int t) {
    float* q = (float*)lds; float* w = q + NIH * IDXD; unsigned* keys = (unsigned*)(w + 16); int* red = (int*)(keys + S);
    const f16_t* IQ = (const f16_t*)(P.ws + WS_IQ); const f16_t* IK = (const f16_t*)(P.ws + WS_IK); const float* IW = (const float*)(P.ws + WS_IW); unsigned* MASK = (unsigned*)(P.ws + WS_MASK);
    const int tid = threadIdx.x, lane = tid & 63, wv = tid >> 6;
    __syncthreads();
    for (int i = tid; i < NIH * IDXD; i += NT) q[i] = (float)IQ[(size_t)t * (NIH * IDXD) + i];
    if (tid < NIH) w[tid] = IW[(size_t)t * NIH + tid];
    __syncthreads();
    const int n = t + 1;
    for (int k = tid; k < n; k += NT) {
        float kk[IDXD];
        const f16_t* kp = IK + (size_t)k * IDXD;
#pragma unroll
        for (int d = 0; d < IDXD; ++d) kk[d] = (float)kp[d];
        float sc = 0.f;
        for (int h = 0; h < NIH; ++h) {
            float x = 0.f;
#pragma unroll
            for (int d = 0; d < IDXD; ++d) x = fmaf(q[h * IDXD + d], kk[d], x);
            sc = fmaf(fmaxf(x, 0.f), w[h], sc);
        }
        keys[k] = ordkey(sc);
    }
    __syncthreads();
    unsigned tau = 0u;
    if (n > 256) {
        for (int b = 31; b >= 0; --b) {
            const unsigned cand = tau | (1u << b);
            int c = 0;
            for (int k = tid; k < n; k += NT) c += (keys[k] >= cand) ? 1 : 0;
#pragma unroll
            for (int o = 1; o < 64; o <<= 1) c += __shfl_xor(c, o);
            __syncthreads();
            if (lane == 0) red[wv] = c;
            __syncthreads();
            int tot = 0;
#pragma unroll
            for (int i = 0; i < NWAVES; ++i) tot += red[i];
            if (tot >= 256) tau = cand;
        }
    }
    for (int k0 = 0; k0 < S; k0 += NT) {
        const int k = k0 + tid;
        const bool sel = (k < n) && (keys[k] >= tau);
        const unsigned long long b = __ballot(sel);
        if (lane == 0) { MASK[(size_t)(k >> 5) * S + t] = (unsigned)b; MASK[(size_t)((k >> 5) + 1) * S + t] = (unsigned)(b >> 32); }
    }
}

typedef short bf16x8 __attribute__((ext_vector_type(8)));
typedef float f32x16 __attribute__((ext_vector_type(16)));
typedef float f32x4 __attribute__((ext_vector_type(4)));
typedef float f32x2_t __attribute__((ext_vector_type(2)));
typedef __bf16 bf16x2_t __attribute__((ext_vector_type(2)));
typedef unsigned u32x4 __attribute__((ext_vector_type(4)));
typedef unsigned u32x2 __attribute__((ext_vector_type(2)));
#define MFMA32(a, b, c) __builtin_amdgcn_mfma_f32_32x32x16_bf16((a), (b), (c), 0, 0, 0)
__device__ __forceinline__ int crow(int r, int hi) { return (r & 3) + 8 * (r >> 2) + 4 * hi; }
__device__ __forceinline__ bf16x8 ldg8(const bf16_t* p) { return *(const bf16x8*)p; }
__device__ __forceinline__ unsigned cvtpk(float lo, float hi) { f32x2_t v = {lo, hi}; bf16x2_t b = __builtin_convertvector(v, bf16x2_t); return __builtin_bit_cast(unsigned, b); }
__device__ __forceinline__ bf16x8 pack_step(const f32x16& x, int s) {
    u32x4 p; p.x = cvtpk(x[8 * s], x[8 * s + 1]); p.y = cvtpk(x[8 * s + 2], x[8 * s + 3]); p.z = cvtpk(x[8 * s + 4], x[8 * s + 5]); p.w = cvtpk(x[8 * s + 6], x[8 * s + 7]);
    return __builtin_bit_cast(bf16x8, p);
}
__device__ __forceinline__ f32x16 zero16() { f32x16 z; for (int i = 0; i < 16; ++i) z[i] = 0.f; return z; }

template <int RB, int NROWS> __device__ __forceinline__ void stage_rows(LAS unsigned char* dst, const unsigned char* src, size_t pitch) {
    constexpr int CPR = RB / 16, RPP = NT / CPR, NP = NROWS / RPP;
    const int tid = threadIdx.x, ch = tid % CPR, r0 = tid / CPR;
    u32x4 v[NP];
#pragma unroll
    for (int p = 0; p < NP; ++p) v[p] = *(const GAS u32x4*)(src + (size_t)(r0 + p * RPP) * pitch + ch * 16);
#pragma unroll
    for (int p = 0; p < NP; ++p) { const int row = r0 + p * RPP; *(LAS u32x4*)(dst + row * RB + ((ch ^ (row & 15)) << 4)) = v[p]; }
}
template <int RB> __device__ __forceinline__ bf16x8 lfrag(const LAS unsigned char* base, int row, int chunk) { return *(const LAS bf16x8*)(base + row * RB + ((chunk ^ (row & 15)) << 4)); }

__device__ __forceinline__ void ret_kv_mfma(const Ptrs& P, LAS unsigned char* lds, int nh) {
    const int lane = threadIdx.x & 63, w = __builtin_amdgcn_readfirstlane(threadIdx.x >> 6), n = nh >> 3, h = nh & 7, db = w & 3, eh = w >> 2;
    int r = lane & 31, hh = lane >> 5; asm volatile("" : "+v"(r), "+v"(hh));
    __syncthreads();
    stage_rows<256, 128>(lds, P.ws + WS_RKT + ((size_t)(h * 128) * S + n * 128) * 2, (size_t)S * 2);
    stage_rows<256, 256>(lds + 32768, P.ws + WS_RVT + ((size_t)(h * 256) * S + n * 128) * 2, (size_t)S * 2);
    __syncthreads();
    f32x16 acc[4];
#pragma unroll
    for (int eb = 0; eb < 4; ++eb) acc[eb] = zero16();
#pragma unroll
    for (int ks = 0; ks < 8; ++ks) {
        const bf16x8 a = lfrag<256>(lds, 32 * db + r, 2 * ks + hh);
#pragma unroll
        for (int eb = 0; eb < 4; ++eb) acc[eb] = MFMA32(a, lfrag<256>(lds + 32768, 128 * eh + 32 * eb + r, 2 * ks + hh), acc[eb]);
    }
    float* KVS = (float*)(P.ws + WS_KVS);
#pragma unroll
    for (int eb = 0; eb < 4; ++eb)
#pragma unroll
        for (int g = 0; g < 4; ++g) {
            const int e = 128 * eh + 32 * eb + r, d0 = 32 * db + 8 * g + 4 * hh;
            *(f32x4*)(KVS + ((size_t)nh * 256 + e) * 128 + d0) = (f32x4){acc[eb][4 * g], acc[eb][4 * g + 1], acc[eb][4 * g + 2], acc[eb][4 * g + 3]};
        }
}
__device__ __forceinline__ void ret_scan(const Ptrs& P, int task) {
    const float* KVS = (const float*)(P.ws + WS_KVS); bf16_t* PREV = (bf16_t*)(P.ws + WS_PREV);
    const int i = task * NT + threadIdx.x, h = i >> 15;
    const float lg = log1pf(-exp2f(-5.0f - (float)h)), cd = __expf(128.0f * lg), gm = __expf(lg);
    float st = 0.f;
#pragma unroll 8
    for (int n = 0; n < 64; ++n) { const size_t o = (size_t)n * (8 * 128 * 256) + i; PREV[o] = f2bf(st * gm); st = st * cd + KVS[o]; }
}
__device__ __forceinline__ void ret_out_mfma(const Ptrs& P, LAS unsigned char* lds, int nh) {
    const int lane = threadIdx.x & 63, w = __builtin_amdgcn_readfirstlane(threadIdx.x >> 6), n = nh >> 3, h = nh & 7, ib = w & 3, eh = w >> 2, tok0 = n * 128;
    int r = lane & 31, hh = lane >> 5; asm volatile("" : "+v"(r), "+v"(hh));
    LAS float* red = (LAS float*)(lds + 98304);
    __syncthreads();
    stage_rows<256, 128>(lds, P.ws + WS_RQ + ((size_t)tok0 * 1024 + h * 128) * 2, 2048);
    stage_rows<256, 128>(lds + 32768, P.ws + WS_RK + ((size_t)tok0 * 1024 + h * 128) * 2, 2048);
    stage_rows<256, 256>(lds + 65536, P.ws + WS_RVT + ((size_t)(h * 256) * S + tok0) * 2, (size_t)S * 2);
    __syncthreads();
    bf16x8 qf[8];
#pragma unroll
    for (int ks = 0; ks < 8; ++ks) qf[ks] = lfrag<256>(lds, 32 * ib + r, 2 * ks + hh);
    f32x16 acc[4];
#pragma unroll
    for (int eb = 0; eb < 4; ++eb) acc[eb] = zero16();
    for (int jb = 0; jb <= ib; ++jb) {
        f32x16 X = zero16();
#pragma unroll
        for (int ks = 0; ks < 8; ++ks) X = MFMA32(lfrag<256>(lds + 32768, 32 * jb + r, 2 * ks + hh), qf[ks], X);
        if (jb == ib) {
#pragma unroll
            for (int reg = 0; reg < 16; ++reg) if (crow(reg, hh) > r) X[reg] = 0.f;
        }
#pragma unroll
        for (int s = 0; s < 2; ++s) {
            const bf16x8 xs = pack_step(X, s);
#pragma unroll
            for (int eb = 0; eb < 4; ++eb) acc[eb] = MFMA32(lfrag<256>(lds + 65536, 128 * eh + 32 * eb + r, 4 * jb + 2 * s + hh), xs, acc[eb]);
        }
    }
    __syncthreads();
    stage_rows<256, 256>(lds + 32768, P.ws + WS_PREV + ((size_t)nh * 256 * 128) * 2, 256);
    __syncthreads();
#pragma unroll
    for (int ks = 0; ks < 8; ++ks)
#pragma unroll
        for (int eb = 0; eb < 4; ++eb) acc[eb] = MFMA32(lfrag<256>(lds + 32768, 128 * eh + 32 * eb + r, 2 * ks + hh), qf[ks], acc[eb]);
    float s1 = 0.f, s2 = 0.f;
#pragma unroll
    for (int eb = 0; eb < 4; ++eb)
#pragma unroll
        for (int reg = 0; reg < 16; ++reg) { const float v = acc[eb][reg]; s1 += v; s2 = fmaf(v, v, s2); }
    s1 += __shfl_xor(s1, 32); s2 += __shfl_xor(s2, 32);
    if (hh == 0) { red[(w * 32 + r) * 2] = s1; red[(w * 32 + r) * 2 + 1] = s2; }
    __syncthreads();
    { s1 += red[((w ^ 4) * 32 + r) * 2]; s2 += red[((w ^ 4) * 32 + r) * 2 + 1]; }
    const float mu = s1 * (1.0f / 256.0f), var = fmaxf(s2 * (1.0f / 256.0f) - mu * mu, 0.f), rs = rsqrtf(var + EPS);
    bf16_t* OB = (bf16_t*)(P.ws + WS_OB) + (size_t)(tok0 + 32 * ib + r) * 2048 + h * 256 + 128 * eh + 4 * hh;
#pragma unroll
    for (int eb = 0; eb < 4; ++eb)
#pragma unroll
        for (int g = 0; g < 4; ++g) {
            bf16_t* p = OB + 32 * eb + 8 * g;
            const u32x2 gw = *(const u32x2*)p;
            const float g0 = __uint_as_float(gw.x << 16), g1 = __uint_as_float(gw.x & 0xffff0000u), g2 = __uint_as_float(gw.y << 16), g3 = __uint_as_float(gw.y & 0xffff0000u);
            u32x2 o; o.x = cvtpk(g0 * (acc[eb][4 * g] - mu) * rs, g1 * (acc[eb][4 * g + 1] - mu) * rs); o.y = cvtpk(g2 * (acc[eb][4 * g + 2] - mu) * rs, g3 * (acc[eb][4 * g + 3] - mu) * rs);
            *(u32x2*)p = o;
        }
}
__device__ __forceinline__ void memattn_mfma(const Ptrs& P, LAS unsigned char* lds, int task) {
    const int lane = threadIdx.x & 63, w = __builtin_amdgcn_readfirstlane(threadIdx.x >> 6), h = task & 3, t0 = (task >> 2) * 256 + 32 * w;
    int r = lane & 31, hh = lane >> 5; asm volatile("" : "+v"(r), "+v"(hh));
    const bf16_t* MQ = (const bf16_t*)(P.ws + WS_MQ) + (size_t)(t0 + r) * 1024 + h * 256 + 8 * hh;
    __syncthreads();
    stage_rows<512, 256>(lds, P.ws + WS_MEMK + (size_t)(h * 256) * 2, 2048);
    __syncthreads();
    f32x16 X[8];
#pragma unroll
    for (int kb = 0; kb < 8; ++kb) X[kb] = zero16();
#pragma unroll 1
    for (int ks = 0; ks < 16; ++ks) {
        const bf16x8 qf = ldg8(MQ + 16 * ks);
#pragma unroll
        for (int kb = 0; kb < 8; ++kb) X[kb] = MFMA32(lfrag<512>(lds, 32 * kb + r, 2 * ks + hh), qf, X[kb]);
    }
    float mx = -INFINITY;
#pragma unroll
    for (int kb = 0; kb < 8; ++kb)
#pragma unroll
        for (int reg = 0; reg < 16; ++reg) mx = fmaxf(mx, X[kb][reg]);
    mx = fmaxf(mx, __shfl_xor(mx, 32));
    float l = 0.f;
    bf16x8 pf[16];
#pragma unroll
    for (int kb = 0; kb < 8; ++kb) {
#pragma unroll
        for (int reg = 0; reg < 16; ++reg) { const float p = __builtin_amdgcn_exp2f(X[kb][reg] - mx); X[kb][reg] = p; l += p; }
        pf[2 * kb] = pack_step(X[kb], 0); pf[2 * kb + 1] = pack_step(X[kb], 1);
    }
    l += __shfl_xor(l, 32);
    const float inv = 1.0f / l;
    __syncthreads();
    stage_rows<512, 256>(lds, P.ws + WS_MVT + (size_t)(h * 256) * 256 * 2, 512);
    __syncthreads();
    bf16_t* OC = (bf16_t*)(P.ws + WS_OC) + (size_t)(t0 + r) * 1024 + h * 256 + 4 * hh;
#pragma unroll
    for (int dh = 0; dh < 2; ++dh) {
        f32x16 O[4];
#pragma unroll
        for (int db = 0; db < 4; ++db) O[db] = zero16();
#pragma unroll
        for (int kk = 0; kk < 16; ++kk)
#pragma unroll
            for (int db = 0; db < 4; ++db) O[db] = MFMA32(lfrag<512>(lds, 128 * dh + 32 * db + r, 2 * kk + hh), pf[kk], O[db]);
#pragma unroll
        for (int db = 0; db < 4; ++db)
#pragma unroll
            for (int g = 0; g < 4; ++g) {
                u32x2 o; o.x = cvtpk(O[db][4 * g] * inv, O[db][4 * g + 1] * inv); o.y = cvtpk(O[db][4 * g + 2] * inv, O[db][4 * g + 3] * inv);
                *(u32x2*)(OC + 128 * dh + 32 * db + 8 * g) = o;
            }
    }
}
__device__ __forceinline__ float max3f(float a, float b, float c) { float r; asm("v_max3_f32 %0, %1, %2, %3" : "=v"(r) : "v"(a), "v"(b), "v"(c)); return r; }
__device__ __forceinline__ float mask_sel(unsigned w, int c, float x) { const int m = __builtin_amdgcn_sbfe((int)w, c, 1); return __uint_as_float((__float_as_uint(x) & (unsigned)m) | (0xff800000u & ~(unsigned)m)); }
__device__ __forceinline__ void attn_mfma(const Ptrs& P, LAS unsigned char* lds, int h, int qb) {
    const int tid = threadIdx.x, lane = tid & 63, w = __builtin_amdgcn_readfirstlane(tid >> 6), g = w >> 2, qs = w & 3;
    int r = lane & 31, hh = lane >> 5; asm volatile("" : "+v"(r), "+v"(hh));
    const int q0 = 128 * qb + 32 * qs, nst = qb + 1;
    const bf16_t* AK = (const bf16_t*)(P.ws + WS_AK) + h * 128; const bf16_t* AVT = (const bf16_t*)(P.ws + WS_AVT) + (size_t)h * 128 * S;
    const unsigned* MASKT = (const unsigned*)(P.ws + WS_MASK) + q0 + r;
    const int skey = tid >> 4, sch = tid & 15, sd = tid >> 3, svc = tid & 7;
    bf16x8 qf[8];
    { const bf16_t* AQ = (const bf16_t*)(P.ws + WS_AQ) + (size_t)(q0 + r) * 1024 + h * 128 + 8 * hh;
#pragma unroll
      for (int ks = 0; ks < 8; ++ks) qf[ks] = ldg8(AQ + 16 * ks); }
    f32x16 O[4];
#pragma unroll
    for (int db = 0; db < 4; ++db) O[db] = zero16();
    float m_run = -1e30f, l_run = 0.f;
    u32x4 sk[4], sv[4];
#define ATT_ISSUE(st) do { _Pragma("unroll") for (int i = 0; i < 4; ++i) { \
        sk[i] = *(const u32x4*)(AK + (size_t)(128 * (st) + 64 * (i >> 1) + skey + 32 * (i & 1)) * 1024 + sch * 8); \
        sv[i] = *(const u32x4*)(AVT + (size_t)(sd + 64 * (i & 1)) * S + 128 * (st) + 64 * (i >> 1) + svc * 8); } } while (0)
#define ATT_WRITE(buf) do { _Pragma("unroll") for (int i = 0; i < 4; ++i) { const int key = skey + 32 * (i & 1), d = sd + 64 * (i & 1); \
        *(LAS u32x4*)(lds + (buf) * 65536 + (i >> 1) * 32768 + key * 256 + ((sch ^ (key & 15)) << 4)) = sk[i]; \
        *(LAS u32x4*)(lds + (buf) * 65536 + (i >> 1) * 32768 + 16384 + d * 128 + ((svc ^ ((d >> 1) & 7)) << 4)) = sv[i]; } } while (0)
    __syncthreads();
    unsigned w0n = MASKT[(size_t)(2 * g) * S], w1n = MASKT[(size_t)(2 * g + 1) * S];
    ATT_ISSUE(0); ATT_WRITE(0);
    __syncthreads();
    for (int st = 0; st < nst; ++st) {
        const bool more = st + 1 < nst;
        unsigned w0 = w0n, w1 = w1n;
        if (more) {
            w0n = MASKT[(size_t)(4 * (st + 1) + 2 * g) * S]; w1n = MASKT[(size_t)(4 * (st + 1) + 2 * g + 1) * S];
            ATT_ISSUE(st + 1);
        }
        const LAS unsigned char* Kb = lds + (st & 1) * 65536 + g * 32768; const LAS unsigned char* Vb = Kb + 16384;
        f32x16 X0, X1;
        {
            bf16x8 kf[16];
#pragma unroll
            for (int ks = 0; ks < 8; ++ks) {
                kf[2 * ks] = *(const LAS bf16x8*)(Kb + r * 256 + (((2 * ks + hh) ^ (r & 15)) << 4));
                kf[2 * ks + 1] = *(const LAS bf16x8*)(Kb + (32 + r) * 256 + (((2 * ks + hh) ^ (r & 15)) << 4));
            }
            const f32x16 z = {0.f, 0.f, 0.f, 0.f, 0.f, 0.f, 0.f, 0.f, 0.f, 0.f, 0.f, 0.f, 0.f, 0.f, 0.f, 0.f};
            X0 = MFMA32(kf[0], qf[0], z); X1 = MFMA32(kf[1], qf[0], z);
#pragma unroll
            for (int ks = 1; ks < 8; ++ks) { X0 = MFMA32(kf[2 * ks], qf[ks], X0); X1 = MFMA32(kf[2 * ks + 1], qf[ks], X1); }
        }
        w0 >>= 4 * hh; w1 >>= 4 * hh;
#pragma unroll
        for (int reg = 0; reg < 16; ++reg) { const int c = (reg & 3) + 8 * (reg >> 2); X0[reg] = mask_sel(w0, c, X0[reg]); X1[reg] = mask_sel(w1, c, X1[reg]); }
        float tmax = max3f(X0[0], X0[1], X1[0]);
        tmax = max3f(tmax, X1[1], X0[2]); tmax = max3f(tmax, X0[3], X1[2]); tmax = max3f(tmax, X1[3], X0[4]);
#pragma unroll
        for (int reg = 4; reg < 16; reg += 2) { tmax = max3f(tmax, X0[reg], X0[reg + 1]); tmax = max3f(tmax, X1[reg], X1[reg + 1]); }
        tmax = max3f(tmax, X0[5], X1[4]);
        tmax = fmaxf(tmax, __shfl_xor(tmax, 32));
        if (__any(tmax > m_run + 8.0f)) {
            const float m_new = fmaxf(m_run, tmax), alpha = __builtin_amdgcn_exp2f(m_run - m_new);
            m_run = m_new; l_run *= alpha;
#pragma unroll
            for (int db = 0; db < 4; ++db) O[db] = O[db] * alpha;
        }
        float ps = 0.f;
#pragma unroll
        for (int reg = 0; reg < 16; ++reg) { X0[reg] = __builtin_amdgcn_exp2f(X0[reg] - m_run); X1[reg] = __builtin_amdgcn_exp2f(X1[reg] - m_run); ps += X0[reg] + X1[reg]; }
        l_run += ps;
        bf16x8 pf[4]; pf[0] = pack_step(X0, 0); pf[1] = pack_step(X0, 1); pf[2] = pack_step(X1, 0); pf[3] = pack_step(X1, 1);
#pragma unroll
        for (int s = 0; s < 4; ++s)
#pragma unroll
            for (int db = 0; db < 4; ++db) {
                const bf16x8 vf = *(const LAS bf16x8*)(Vb + (32 * db + r) * 128 + (((2 * s + hh) ^ ((r >> 1) & 7)) << 4));
                O[db] = MFMA32(vf, pf[s], O[db]);
            }
        if (more) ATT_WRITE((st + 1) & 1);
        __syncthreads();
    }
#undef ATT_ISSUE
#undef ATT_WRITE
    l_run += __shfl_xor(l_run, 32);
    LAS float* cb = (LAS float*)(lds + qs * 16896);
    if (g == 1) {
#pragma unroll
        for (int db = 0; db < 4; ++db)
#pragma unroll
            for (int reg = 0; reg < 16; ++reg) cb[(db * 16 + reg) * 64 + lane] = O[db][reg];
        cb[4096 + lane] = m_run; cb[4160 + lane] = l_run;
    }
    __syncthreads();
    if (g == 0) {
        const float m1 = cb[4096 + lane], l1 = cb[4160 + lane], mt = fmaxf(m_run, m1), a0 = __builtin_amdgcn_exp2f(m_run - mt), a1 = __builtin_amdgcn_exp2f(m1 - mt);
        const float inv = 1.0f / (l_run * a0 + l1 * a1), f0 = a0 * inv, f1 = a1 * inv;
        bf16_t* OA = (bf16_t*)(P.ws + WS_OA) + (size_t)(q0 + r) * 1024 + h * 128 + 4 * hh;
#pragma unroll
        for (int db = 0; db < 4; ++db)
#pragma unroll
            for (int gq = 0; gq < 4; ++gq) {
                float v[4];
#pragma unroll
                for (int e = 0; e < 4; ++e) v[e] = O[db][4 * gq + e] * f0 + cb[(db * 16 + 4 * gq + e) * 64 + lane] * f1;
                u32x2 o; o.x = cvtpk(v[0], v[1]); o.y = cvtpk(v[2], v[3]);
                *(u32x2*)(OA + 32 * db + 8 * gq) = o;
            }
    }
}
typedef _Float16 f16x8 __attribute__((ext_vector_type(8)));
__device__ __forceinline__ float relu_i(float x) { const int i = __float_as_int(x); return __int_as_float(i > 0 ? i : 0); }
__device__ __forceinline__ void index_mfma(const Ptrs& P, LAS unsigned char* lds, int tile) {
    const int tid = threadIdx.x, lane = tid & 63, w = __builtin_amdgcn_readfirstlane(tid >> 6), qp = w & 3, kh = w >> 2, t0 = 8 * tile;
    int r = lane & 31, hh = lane >> 5; asm volatile("" : "+v"(r), "+v"(hh));
    const int nkb = ((t0 + 7) >> 5) + 1, nst = (nkb + 7) >> 3, njb = 4 * nst, kbw = 4 * ((t0 >> 7) + 1), tq = t0 + 2 * qp + hh;
    LAS int* cnt = (LAS int*)lds;
    LAS unsigned char* ring = lds + 1024;
    const f16_t* IQ = (const f16_t*)(P.ws + WS_IQ) + (size_t)(t0 + 2 * qp + (r >> 4)) * 1024 + (r & 15) * 64 + 8 * hh;
    f16x8 af[4];
#pragma unroll
    for (int s = 0; s < 4; ++s) af[s] = *(const f16x8*)(IQ + 16 * s);
    float wq0[8], wq1[8];
    { const float* IW = (const float*)(P.ws + WS_IW) + (size_t)(t0 + 2 * qp) * 16 + 4 * hh;
#pragma unroll
      for (int reg = 0; reg < 8; ++reg) { const int hd = (reg & 3) + 8 * (reg >> 2); wq0[reg] = IW[hd]; wq1[reg] = IW[16 + hd]; } }
    typedef unsigned u32x32 __attribute__((ext_vector_type(32)));
    u32x32 sc[4];
#pragma unroll
    for (int g = 0; g < 4; ++g)
#pragma unroll
        for (int e = 0; e < 32; ++e) sc[g][e] = 0u;
    const f16_t* IK = (const f16_t*)(P.ws + WS_IK) + (size_t)(tid >> 3) * 64 + (tid & 7) * 8;
    const int srow = tid >> 3, sch = tid & 7;
    u32x4 sk[4];
    const f16_t* ikp = IK;
#define IDX_ISSUE() do { asm volatile("" : "+v"(ikp)); _Pragma("unroll") for (int i = 0; i < 4; ++i) sk[i] = *(const GAS u32x4*)(ikp + (size_t)(64 * i) * 64); ikp += 256 * 64; } while (0)
#define IDX_WRITE(buf) do { _Pragma("unroll") for (int i = 0; i < 4; ++i) { const int row = srow + 64 * i; *(LAS u32x4*)(ring + (buf) * 32768 + row * 128 + ((sch ^ ((row >> 1) & 7)) << 4)) = sk[i]; } } while (0)
#ifndef PROBE_SCORE_REPS
#define PROBE_SCORE_REPS 1
#endif
#pragma unroll 1
    for (int rep = 0; rep < PROBE_SCORE_REPS; ++rep) {
    ikp = IK;
    __syncthreads();
    IDX_ISSUE(); IDX_WRITE(0);
    __syncthreads();
#pragma unroll
    for (int g = 0; g < 4; ++g) {
#pragma unroll 1
        for (int s8 = 0; s8 < 8; ++s8) {
            const int st = 8 * g + s8;
            if (st >= nst) break;
            if (st + 1 < nst) IDX_ISSUE();
            const LAS unsigned char* kbuf = ring + (s8 & 1) * 32768;
#pragma unroll
            for (int b = 0; b < 4; ++b) {
                const int kbl = 2 * b + kh, kb = 8 * st + kbl;
                const LAS unsigned char* kp = kbuf + (32 * kbl + r) * 128;
                f32x16 X = zero16();
#pragma unroll
                for (int s = 0; s < 4; ++s) X = __builtin_amdgcn_mfma_f32_32x32x16_f16(af[s], *(const LAS f16x8*)(kp + (((2 * s + hh) ^ ((r >> 1) & 7)) << 4)), X, 0, 0, 0);
                float p0 = 0.f, p1 = 0.f;
#pragma unroll
                for (int reg = 0; reg < 8; ++reg) { p0 = fmaf(relu_i(X[reg]), wq0[reg], p0); p1 = fmaf(relu_i(X[8 + reg]), wq1[reg], p1); }
                const auto rr = __builtin_amdgcn_permlane32_swap(__float_as_uint(p0), __float_as_uint(p1), false, false);
                const float score = __uint_as_float(rr[0]) + __uint_as_float(rr[1]);
                sc[g][4 * s8 + b] = (32 * kb + r <= tq) ? ordkey(score) : 0u;
            }
            if (st + 1 < nst) IDX_WRITE((s8 + 1) & 1);
            __syncthreads();
        }
    }
    }
#undef IDX_ISSUE
#undef IDX_WRITE
    unsigned tau = 0u;
#ifndef PROBE_BISECT_REPS
#define PROBE_BISECT_REPS 1
#endif
#pragma unroll 1
    for (int rep = 0; rep < PROBE_BISECT_REPS; ++rep)
    if (t0 + 8 > 256) {
        tau = 0u; __syncthreads();
        int settled = 0, mine = 0;
#pragma unroll 1
        for (int b = 31; b >= 0; --b) {
            const unsigned cand = tau | (1u << b);
            int c = 0;
#pragma unroll
            for (int g = 0; g < 4; ++g)
#pragma unroll
                for (int hf = 0; hf < 2; ++hf) {
                    if (32 * g + 16 * hf < njb) {
#pragma unroll
                        for (int e = 16 * hf; e < 16 * hf + 16; ++e) c += (sc[g][e] >= cand) ? 1 : 0;
                    }
                }
            c += __shfl_xor(c, 1); c += __shfl_xor(c, 2); c += __shfl_xor(c, 4); c += __shfl_xor(c, 8); c += __shfl_xor(c, 16);
            LAS int* cb = cnt + (b & 1) * 16; LAS int* fb = cnt + 32 + (b & 1) * 8;
            if (r == 0) cb[w * 2 + hh] = c;
            if (lane == 0) fb[w] = settled;
            __syncthreads();
            if ((fb[0] & fb[1] & fb[2] & fb[3]) != 0) break;
            const int tot = c + cb[(w ^ 4) * 2 + hh];
            if (tot >= 256) tau = cand;
            mine |= (tot == 256) ? 1 : 0;
            settled = __all(mine) ? 1 : 0;
        }
    }
    const unsigned thr = tau > 1u ? tau : 1u;
    unsigned* MASKT = (unsigned*)(P.ws + WS_MASK) + t0 + 2 * qp;
#pragma unroll
    for (int g = 0; g < 4; ++g)
#pragma unroll
        for (int e = 0; e < 32; ++e) {
            const int j = 32 * g + e, kb = 8 * (j >> 2) + 2 * (j & 3) + kh;
            if (kb < kbw) {
                const unsigned long long bm = __ballot(sc[g][e] >= thr);
                if (lane == 0) *(uint2*)(MASKT + (size_t)kb * S) = make_uint2((unsigned)bm, (unsigned)(bm >> 32));
            }
        }
}
__device__ __forceinline__ void resnorm_row(const float* xin, const float* y, const float* g1, const float* g2, float* out, bf16_t* h2, int r, int lane) {
    float yv[32], xv[32]; float ss = 0.f;
#pragma unroll
    for (int j = 0; j < 8; ++j) { const float4 t = *(const float4*)(y + (size_t)r * D + j * 256 + lane * 4); yv[4 * j] = t.x; yv[4 * j + 1] = t.y; yv[4 * j + 2] = t.z; yv[4 * j + 3] = t.w; ss += t.x * t.x + t.y * t.y + t.z * t.z + t.w * t.w; }
    ss = wave_sum(ss);
    const float rs = rsqrtf(ss * (1.0f / D) + EPS);
    float s2 = 0.f;
#pragma unroll
    for (int j = 0; j < 8; ++j) {
        const float4 xx = *(const float4*)(xin + (size_t)r * D + j * 256 + lane * 4);
        const float4 gg = *(const float4*)(g1 + j * 256 + lane * 4);
        xv[4 * j] = xx.x + yv[4 * j] * rs * gg.x; xv[4 * j + 1] = xx.y + yv[4 * j + 1] * rs * gg.y; xv[4 * j + 2] = xx.z + yv[4 * j + 2] * rs * gg.z; xv[4 * j + 3] = xx.w + yv[4 * j + 3] * rs * gg.w;
        s2 += xv[4 * j] * xv[4 * j] + xv[4 * j + 1] * xv[4 * j + 1] + xv[4 * j + 2] * xv[4 * j + 2] + xv[4 * j + 3] * xv[4 * j + 3];
        *(float4*)(out + (size_t)r * D + j * 256 + lane * 4) = make_float4(xv[4 * j], xv[4 * j + 1], xv[4 * j + 2], xv[4 * j + 3]);
    }
    if (h2) {
        s2 = wave_sum(s2);
        const float r2 = rsqrtf(s2 * (1.0f / D) + EPS);
#pragma unroll
        for (int j = 0; j < 8; ++j) { const float4 gg = *(const float4*)(g2 + j * 256 + lane * 4);
            uint2 o; o.x = pk2(xv[4 * j] * r2 * gg.x, xv[4 * j + 1] * r2 * gg.y); o.y = pk2(xv[4 * j + 2] * r2 * gg.z, xv[4 * j + 3] * r2 * gg.w);
            *(uint2*)(h2 + (size_t)r * D + j * 256 + lane * 4) = o; }
    }
}

#ifndef PROBE_REPEAT_PHASE
#define PROBE_REPEAT_PHASE -1
#endif
#ifndef MK_PER_PHASE
#define MK_PER_PHASE 0
#endif
constexpr int N_PHASES = 11;
struct Args { Ptrs p; int ph_lo, ph_hi; };
__global__ void __launch_bounds__(NT, 2) mk_fwd(Args args) {
    extern __shared__ __attribute__((aligned(16))) unsigned char lds_raw[];
    LAS unsigned char* lds = (LAS unsigned char*)lds_raw;
    const Ptrs& P = args.p;
    const int tid = threadIdx.x, lane = tid & 63, wave = __builtin_amdgcn_readfirstlane(tid >> 6), G = gridDim.x;
    unsigned char* ws = P.ws;
    for (int u = tid; u < (LDS_BYTES - LDSCTL_OFF) / 4; u += NT) ((LAS unsigned*)(lds + LDSCTL_OFF))[u] = 0u;
    __syncthreads();
    XcdBarrier bar; bar.bar = (unsigned*)(ws + WS_CTL) + CW_BAR; bar.x = 0; bar.st = nullptr;
    if (!MK_PER_PHASE) bar = xcd_barrier_post((unsigned*)(ws + WS_CTL) + CW_BAR, (volatile LAS unsigned*)(lds + MISC_OFF) + 8);
    const int lo = args.ph_lo, hi = args.ph_hi;
#define IN(k) (lo <= (k) && (k) < hi)
#define SEAM(k) do { if (IN(k) && IN((k) + 1)) xcd_barrier(bar); } while (0)
    bf16_t* XN = (bf16_t*)(ws + WS_XN);

    if (IN(0)) { p0_prologue(P, lds, G); }
    SEAM(0);
    if (IN(1)) {
        pg8::Gemm g{XN, (const bf16_t*)(ws + WS_WIN), S + NMEM, NP_IN + 2048, D}; pg8::InProjOrder O; O.init(G, (int)blockIdx.x);
        pg8::EpiInProj E{ws};
        pg8::gemm_phase<pg8::EpiInProj, pg8::InProjOrder, true, true>(lds + RING_OFF, g, O, E);
    }
    SEAM(1);
    if (IN(2)) {
        for (int task = blockIdx.x; task < 512 + 128; task += G) {
            if (task < 512) ret_kv_mfma(P, lds + RING_OFF, task);
            else memattn_mfma(P, lds + RING_OFF, task - 512);
        }
        for (int i = blockIdx.x; i < 256; i += G) {
#pragma unroll 1
            for (int k = 0; k < 4; ++k) { const int tile = (k == 0) ? i : (k == 1) ? 511 - i : (k == 2) ? 512 + i : 1023 - i; index_mfma(P, lds + RING_OFF, tile); }
        }
    }
    SEAM(2);
    if (IN(3)) {
        for (int task = blockIdx.x; task < 512; task += G) ret_scan(P, task);
        for (int i = blockIdx.x; i < 256; i += G) {
#pragma unroll 1
            for (int k = 0; k < 2; ++k) { const int u = k ? 511 - i : i; attn_mfma(P, lds + RING_OFF, u & 7, 63 - (u >> 3)); }
        }
    }
    SEAM(3);
    if (IN(4)) { for (int task = blockIdx.x; task < 512; task += G) ret_out_mfma(P, lds + RING_OFF, task); }
    SEAM(4);
    if (IN(5)) {
        pg8::MergeOrder O; O.init(ws, G, (int)blockIdx.x);
        pg8::EpiGateChain E{ws};
        pg8::gemm_phase_chain<pg8::EpiGateChain, pg8::MergeOrder, false, true>(lds + RING_OFF, O, E);
    }
    SEAM(5);
    if (IN(6)) {
        pg8::Gemm g{(const bf16_t*)(ws + WS_MIXEDB), (const bf16_t*)(ws + WS_WOUT), S, D, D}; pg8::StaticOrder O; O.init(S, D, G, (int)blockIdx.x);
        pg8::EpiF32 E{(float*)(ws + WS_Y), D};
        pg8::gemm_phase<pg8::EpiF32, pg8::StaticOrder, false, true>(lds + RING_OFF, g, O, E);
    }
    SEAM(6);
    if (IN(7)) { for (int r = blockIdx.x * NWAVES + wave; r < S; r += G * NWAVES) resnorm_row(P.x, (const float*)(ws + WS_Y), P.g_post_mix, P.g_pre_ffn, P.out, XN, r, lane); }
    SEAM(7);
    if (IN(8)) {
        pg8::Gemm g{XN, (const bf16_t*)(ws + WS_WFFIN), S, 2 * DFF, D}; pg8::StaticOrder O; O.init(S, 2 * DFF, G, (int)blockIdx.x);
        pg8::EpiSwiGLU E{(bf16_t*)(ws + WS_ACT), DFF};
        pg8::gemm_phase<pg8::EpiSwiGLU, pg8::StaticOrder, true, true>(lds + RING_OFF, g, O, E);
    }
    SEAM(8);
    if (IN(9)) {
        pg8::Gemm g{(const bf16_t*)(ws + WS_ACT), (const bf16_t*)(ws + WS_WFFOUT), S, D, DFF}; pg8::StaticOrder O; O.init(S, D, G, (int)blockIdx.x);
        pg8::EpiF32 E{(float*)(ws + WS_Y), D};
        pg8::gemm_phase<pg8::EpiF32, pg8::StaticOrder, false, true>(lds + RING_OFF, g, O, E);
    }
    SEAM(9);
    if (IN(10)) { for (int r = blockIdx.x * NWAVES + wave; r < S; r += G * NWAVES) resnorm_row(P.out, (const float*)(ws + WS_Y), P.g_post_ffn, nullptr, P.out, nullptr, r, lane); }
#undef IN
#undef SEAM
}

extern "C" void kernel_launch(void* const* d_in, const int* in_sizes, int n_in, void* d_out, int out_size, void* d_ws, size_t ws_size, hipStream_t stream) {
    static int grid = 0;
    if (grid == 0) {
        if (n_in != 16 || in_sizes[0] != S * D || out_size != S * D || ws_size < WS_END) { fprintf(stderr, "kernel_launch: unexpected shapes (n_in %d, ws %zu); nothing launched\n", n_in, ws_size); grid = -1; return; }
        int dev = 0, cus = 0, per_cu = 0;
        if (hipGetDevice(&dev) != hipSuccess || hipDeviceGetAttribute(&cus, hipDeviceAttributeMultiprocessorCount, dev) != hipSuccess) { grid = -1; return; }
        if (hipFuncSetAttribute((const void*)mk_fwd, hipFuncAttributeMaxDynamicSharedMemorySize, LDS_BYTES) != hipSuccess) { fprintf(stderr, "kernel_launch: hipFuncSetAttribute failed\n"); grid = -1; return; }
        if (hipOccupancyMaxActiveBlocksPerMultiprocessor(&per_cu, (const void*)mk_fwd, NT, LDS_BYTES) != hipSuccess || per_cu < 1) { fprintf(stderr, "kernel_launch: occupancy query says %d blocks per CU; nothing launched\n", per_cu); grid = -1; return; }
        (void)hipGetLastError();
        grid = cus;
    }
    if (grid < 0) return;
    if (hipMemsetAsync((char*)d_ws + WS_CTL, 0, CTL_ZERO_BYTES, stream) != hipSuccess) return;
    Args a{};
    a.p.x = (const float*)d_in[0]; a.p.mem = (const float*)d_in[1]; a.p.pos = (const int*)d_in[2]; a.p.g_pre_mix = (const float*)d_in[3]; a.p.g_mem = (const float*)d_in[4];
    a.p.w_in = (const float*)d_in[5]; a.p.w_mem_kv = (const float*)d_in[6]; a.p.w_a = (const float*)d_in[7]; a.p.w_b = (const float*)d_in[8]; a.p.w_c = (const float*)d_in[9];
    a.p.w_out = (const float*)d_in[10]; a.p.g_post_mix = (const float*)d_in[11]; a.p.g_pre_ffn = (const float*)d_in[12]; a.p.w_ffn_in = (const float*)d_in[13]; a.p.w_ffn_out = (const float*)d_in[14];
    a.p.g_post_ffn = (const float*)d_in[15]; a.p.out = (float*)d_out; a.p.ws = (unsigned char*)d_ws;
#if MK_PER_PHASE
    for (int ph = 0; ph < N_PHASES; ++ph) { a.ph_lo = ph; a.ph_hi = ph + 1; hipLaunchKernelGGL(mk_fwd, dim3(grid), dim3(NT), LDS_BYTES, stream, a); }
#else
    if (PROBE_REPEAT_PHASE >= 0) {
        a.ph_lo = 0; a.ph_hi = PROBE_REPEAT_PHASE + 1;
        hipLaunchKernelGGL(mk_fwd, dim3(grid), dim3(NT), LDS_BYTES, stream, a);
        (void)hipMemsetAsync((char*)d_ws + WS_CTL, 0, CTL_ZERO_BYTES, stream);
        a.ph_lo = PROBE_REPEAT_PHASE; a.ph_hi = N_PHASES;
        hipLaunchKernelGGL(mk_fwd, dim3(grid), dim3(NT), LDS_BYTES, stream, a);
    } else {
        a.ph_lo = 0; a.ph_hi = N_PHASES;
        hipLaunchKernelGGL(mk_fwd, dim3(grid), dim3(NT), LDS_BYTES, stream, a);
    }
#endif
}
```

```cpp
#include <hip/hip_runtime.h>
#include <cstdio>
#include <cstdint>


typedef unsigned short bf16_t;
typedef _Float16 f16_t;
#define LAS __attribute__((address_space(3)))
#define GAS __attribute__((address_space(1)))
constexpr int S = 8192, D = 2048, NMEM = 256;
constexpr int AW = 1024, IQW = 1024, IDXD = 64, NIH = 16, RQK = 1024, RVW = 2048, MW = 1024;
constexpr int INC = 17488, DFF = 5632;
constexpr int C_AQ = 0, C_AK = 1024, C_AV = 2048, C_IQ = 3072, C_IK = 4096, C_IW = 4160, C_RQ = 4176, C_RK = 5200, C_RV = 6224, C_RG = 8272, C_MQ = 10320, C_GT = 11344;
static_assert(C_GT + 3 * D == INC, "cols");
constexpr float EPS = 1e-6f;
constexpr int NP_IN = 69 * 256;
constexpr int NWAVES = 8, NT = NWAVES * 64;

constexpr size_t MiB = 1u << 20;
constexpr size_t WS_CTL = 0, CTL_ZERO_BYTES = 1 * MiB;
constexpr size_t WS_WIN = 2 * MiB, WS_WMEMKV = 71 * MiB, WS_WA = 79 * MiB, WS_WB = 83 * MiB, WS_WC = 91 * MiB, WS_WOUT = 95 * MiB, WS_WFFIN = 103 * MiB, WS_WFFOUT = 147 * MiB;
constexpr size_t WS_XN = 169 * MiB, WS_MEMN = 201 * MiB, WS_ROPE128 = 202 * MiB, WS_ROPE64 = 206 * MiB;
constexpr size_t WS_AQ = 208 * MiB, WS_AK = 224 * MiB, WS_AV = 240 * MiB, WS_IQ = 256 * MiB, WS_RQ = 272 * MiB, WS_RK = 288 * MiB, WS_MQ = 304 * MiB;
constexpr size_t WS_RV = 320 * MiB, WS_RG = 352 * MiB, WS_GATES = 384 * MiB;
constexpr size_t WS_IK = 480 * MiB, WS_IW = 481 * MiB, WS_MEMK = 482 * MiB, WS_MVT = 483 * MiB, WS_MASK = 484 * MiB, WS_PREV = 492 * MiB, WS_RKT = 524 * MiB;
constexpr size_t WS_AVT = 240 * MiB;
constexpr size_t WS_RVT = 320 * MiB;
constexpr size_t WS_OA = WS_IQ, WS_OC = WS_XN, WS_OB = WS_RG;
constexpr size_t WS_KVS = 2 * MiB;
constexpr size_t WS_MIXED = 2 * MiB, WS_MIXEDB = 208 * MiB, WS_Y = 272 * MiB, WS_ACT = 384 * MiB;
constexpr size_t WS_END = 540 * MiB;
static_assert(WS_WIN + (size_t)NP_IN * D * 2 == WS_WMEMKV, "in-proj and mem-kv weight copies must be contiguous");
static_assert(WS_XN + (size_t)S * D * 2 == WS_MEMN, "XN and MEMN must be contiguous");

__device__ __forceinline__ float bf2f(bf16_t b) { return __uint_as_float(((unsigned)b) << 16); }
__device__ __forceinline__ bf16_t f2bf(float f) { unsigned u = __float_as_uint(f); return (bf16_t)((u + 0x7fffu + ((u >> 16) & 1u)) >> 16); }
__device__ __forceinline__ unsigned pk2(float lo, float hi) { return (unsigned)f2bf(lo) | ((unsigned)f2bf(hi) << 16); }
__device__ __forceinline__ unsigned pkh2(float lo, float hi) { const f16_t a = (f16_t)lo, b = (f16_t)hi; return (unsigned)__builtin_bit_cast(unsigned short, a) | ((unsigned)__builtin_bit_cast(unsigned short, b) << 16); }
__device__ __forceinline__ float wave_sum(float v) {
#pragma unroll
    for (int o = 1; o < 64; o <<= 1) v += __shfl_xor(v, o);
    return v;
}
__device__ __forceinline__ float wave_max(float v) {
#pragma unroll
    for (int o = 1; o < 64; o <<= 1) v = fmaxf(v, __shfl_xor(v, o));
    return v;
}
__device__ __forceinline__ float sigmoidf_(float x) { return 1.0f / (1.0f + __expf(-x)); }
__device__ __forceinline__ float siluf_(float x) { return x / (1.0f + __expf(-x)); }

__constant__ double ROPE_FREQ[64] = {1.0, 0.8659643233600653, 0.7498942093324559, 0.6493816315762113, 0.5623413251903491, 0.4869675251658631, 0.4216965034285822, 0.3651741272548377, 0.31622776601683794, 0.27384196342643613, 0.23713737056616552, 0.2053525026457146, 0.1778279410038923, 0.1539926526059492, 0.1333521432163324, 0.11547819846894582, 0.1, 0.08659643233600653, 0.07498942093324558, 0.06493816315762113, 0.05623413251903491, 0.04869675251658631, 0.042169650342858224, 0.03651741272548377, 0.03162277660168379, 0.027384196342643614, 0.023713737056616554, 0.02053525026457146, 0.01778279410038923, 0.01539926526059492, 0.01333521432163324, 0.011547819846894581, 0.01, 0.008659643233600654, 0.007498942093324558, 0.006493816315762113, 0.005623413251903491, 0.004869675251658631, 0.004216965034285823, 0.003651741272548377, 0.0031622776601683794, 0.0027384196342643613, 0.0023713737056616554, 0.002053525026457146, 0.0017782794100389228, 0.001539926526059492, 0.001333521432163324, 0.0011547819846894581, 0.001, 0.0008659643233600654, 0.0007498942093324559, 0.0006493816315762113, 0.0005623413251903491, 0.0004869675251658631, 0.00042169650342858224, 0.0003651741272548377, 0.00031622776601683794, 0.0002738419634264361, 0.00023713737056616554, 0.0002053525026457146, 0.00017782794100389227, 0.0001539926526059492, 0.0001333521432163324, 0.00011547819846894582};

__device__ __forceinline__ void sincos_d(double a, float& s, float& c) {
    const double n = rint(a * 0.63661977236758134308);
    double r = fma(-n, 1.57079632679489655800, a);
    r = fma(-n, 6.12323399573676603587e-17, r);
    const double r2 = r * r;
    double sp = -7.6471637318198164759e-13;
    sp = fma(sp, r2, 1.6059043836821614599e-10); sp = fma(sp, r2, -2.5052108385441718775e-08); sp = fma(sp, r2, 2.7557319223985890653e-06);
    sp = fma(sp, r2, -1.9841269841269841270e-04); sp = fma(sp, r2, 8.3333333333333333333e-03); sp = fma(sp, r2, -1.6666666666666666667e-01);
    const double sn = fma(sp * r2, r, r);
    double cp = 4.7794773323873852974e-14;
    cp = fma(cp, r2, -1.1470745597729724714e-11); cp = fma(cp, r2, 2.0876756987868098979e-09); cp = fma(cp, r2, -2.7557319223985890653e-07);
    cp = fma(cp, r2, 2.4801587301587301587e-05); cp = fma(cp, r2, -1.3888888888888888889e-03); cp = fma(cp, r2, 4.1666666666666666667e-02); cp = fma(cp, r2, -0.5);
    const double cs = fma(cp, r2, 1.0);
    const int q = ((int)n) & 3;
    const double ss = (q == 0) ? sn : (q == 1) ? cs : (q == 2) ? -sn : -cs;
    const double cc = (q == 0) ? cs : (q == 1) ? -sn : (q == 2) ? -cs : sn;
    s = (float)ss; c = (float)cc;
}
namespace pg8 {
#define PG8_LAS __attribute__((address_space(3)))
typedef unsigned short bf16_t;
typedef short bf16x8 __attribute__((ext_vector_type(8)));
typedef float f32x4 __attribute__((ext_vector_type(4)));
typedef unsigned u32x4 __attribute__((ext_vector_type(4)));
constexpr int BM = 256, BK = 64, HALF = 128, HTB = HALF * BK * 2  , STAGE_BYTES = 8 * HTB, NXCD = 8, WGM = 8;

__host__ __device__ __forceinline__ int lds_byte(int r, int c) { const int st = (r >> 4) * 2 + (c >> 5), rr = r & 15, cc = c & 31, ob = rr * 64 + cc * 2; return st * 1024 + (ob ^ (((ob >> 9) & 1) << 5)); }
__host__ __device__ __forceinline__ void stage_rc(int b, int& R, int& C) { const int st = b / 1024, sb = b % 1024, swz = sb ^ (((sb >> 9) & 1) << 5); R = (st >> 1) * 16 + swz / 64; C = (st & 1) * 32 + (swz % 64) / 2; }
__host__ __device__ __forceinline__ int perm32(int rho) { const int n = rho >> 4, i = rho & 15; return 8 * (i >> 2) + 4 * n + (i & 3); }

struct Unit { int pm, pn, kd; };
struct Gemm { const bf16_t* A; const bf16_t* Bt; int M, N, K; };

struct StaticOrder {
    int nM, nN, nwg, G, c;
    __host__ __device__ void init(int M, int N, int G_, int c_) { nM = M / BM; nN = N / BM; nwg = nM * nN; G = G_; c = c_; }
    __host__ __device__ bool next(int i, Unit& u) const {
        const long L = (long)i * G + c; if (L >= nwg) return false;
        int wgid = (int)L; { const int q = nwg / NXCD, r = nwg % NXCD, xcd = wgid % NXCD, off = wgid / NXCD; wgid = (xcd < r ? xcd * (q + 1) : r * (q + 1) + (xcd - r) * q) + off; }
        const int nig = WGM * nN, gid = wgid / nig, fm = gid * WGM, gsz = (nM - fm) < WGM ? (nM - fm) : WGM;
        u.pm = fm + ((wgid % nig) % gsz); u.pn = (wgid % nig) / gsz; return true;
    }
    __device__ __forceinline__ void a_ready(const Unit&) const {}
    __device__ __forceinline__ void done(const Unit&) const {}
};

__device__ __forceinline__ unsigned cvt_pk_bf16(float lo, float hi) { unsigned r; asm volatile("v_cvt_pk_bf16_f32 %0, %1, %2" : "=v"(r) : "v"(lo), "v"(hi)); return r; }
__device__ __forceinline__ unsigned cvt_pk_f16(float lo, float hi) { const _Float16 a = (_Float16)lo, b = (_Float16)hi; return (unsigned)__builtin_bit_cast(unsigned short, a) | ((unsigned)__builtin_bit_cast(unsigned short, b) << 16); }
__device__ __forceinline__ bf16_t f2bf_dev(float f) { unsigned u = __float_as_uint(f); return (bf16_t)((u + 0x7fffu + ((u >> 16) & 1u)) >> 16); }
__device__ __forceinline__ int tokperm(int s) { return (s & ~12) | ((s & 4) << 1) | ((s & 8) >> 1); }
__device__ __forceinline__ float ret_l2gamma(int h) { return log1pf(-exp2f(-5.0f - (float)h)) * 1.4426950408889634f; }
__device__ __forceinline__ float ep_sigmoid(float x) { return __builtin_amdgcn_rcpf(1.0f + __builtin_amdgcn_exp2f(-1.4426950408889634f * x)); }
__device__ __forceinline__ float ep_silu(float x) { return x * ep_sigmoid(x); }

__device__ __forceinline__ void tr_store32(PG8_LAS unsigned char* tb, const float (&v)[2][8], bf16_t* dstT, size_t ld, int fr, int fq, int lane) {
    const int pos = (fr & 3) | ((fr & 4) << 1) | ((fr & 8) >> 1);
#pragma unroll
    for (int mm = 0; mm < 2; ++mm)
#pragma unroll
        for (int e = 0; e < 8; ++e) *(PG8_LAS bf16_t*)(tb + (8 * fq + e) * 68 + (16 * mm + pos) * 2) = f2bf_dev(v[mm][e]);
    asm volatile("s_waitcnt lgkmcnt(0)" ::: "memory");
    const int col = lane >> 1, half = lane & 1;
    unsigned w[8];
#pragma unroll
    for (int i = 0; i < 8; ++i) w[i] = *(const PG8_LAS unsigned*)(tb + col * 68 + half * 32 + 4 * i);
    bf16_t* o = dstT + (size_t)col * ld + 16 * half;
    *(u32x4*)o = (u32x4){w[0], w[1], w[2], w[3]}; *(u32x4*)(o + 8) = (u32x4){w[4], w[5], w[6], w[7]};
    asm volatile("s_waitcnt lgkmcnt(0)" ::: "memory");
}
struct EpiInProj {
    static constexpr bool PERM = true, AFTER_DRAIN = false;
    unsigned char* ws;
    PG8_LAS unsigned char* tbase;
    __device__ __forceinline__ void operator()(const f32x4 (&acc)[2][2][4][2], const Unit& u, int wr, int wc, int fr, int fq) const {
        const int pn = u.pn, row0 = u.pm * BM + wr * 64 + fr, lane_ = fq * 16 + fr;
        PG8_LAS unsigned char* trb = tbase + (wr * 4 + wc) * 4032;
        if (pn < 8 || (pn >= 16 && pn < 24)) {
            const size_t doff = pn < 8 ? WS_AQ + (size_t)(pn >> 2) * (16u << 20) : WS_RQ + (size_t)((pn - 16) >> 2) * (16u << 20);
            bf16_t* dst = (bf16_t*)(ws + doff); const float* R128 = (const float*)(ws + WS_ROPE128);
            const float sc0 = pn < 4 ? 0.08838834764831845f * 1.4426950408889634f : pn >= 20 ? 0.08838834764831845f : 1.0f;
            const int head = (pn & 3) * 2 + (wc >> 1), j0 = 32 * (wc & 1) + 8 * fq;
            const bool isrq = pn >= 16 && pn < 20, isrk = pn >= 20;
            const float l2g = ret_l2gamma(head);
            float yk1[2][8], yk2[2][8];
#pragma unroll
            for (int ai = 0; ai < 2; ++ai)
#pragma unroll
                for (int m = 0; m < 4; ++m) {
                    const int row = row0 + ai * HALF + m * 16;
                    const f32x4* tb = (const f32x4*)(R128 + ((size_t)row * 64 + j0) * 2);
                    const f32x4 t0 = tb[0], t1 = tb[1], t2 = tb[2], t3 = tb[3];
                    const f32x4 a0 = acc[ai][0][m][0], a1 = acc[ai][0][m][1], b0 = acc[ai][1][m][0], b1 = acc[ai][1][m][1];
                    float y1[8], y2[8];
                    y1[0] = a0[0] * t0[0] - b0[0] * t0[1]; y1[1] = a0[1] * t0[2] - b0[1] * t0[3]; y1[2] = a0[2] * t1[0] - b0[2] * t1[1]; y1[3] = a0[3] * t1[2] - b0[3] * t1[3];
                    y1[4] = a1[0] * t2[0] - b1[0] * t2[1]; y1[5] = a1[1] * t2[2] - b1[1] * t2[3]; y1[6] = a1[2] * t3[0] - b1[2] * t3[1]; y1[7] = a1[3] * t3[2] - b1[3] * t3[3];
                    y2[0] = b0[0] * t0[0] + a0[0] * t0[1]; y2[1] = b0[1] * t0[2] + a0[1] * t0[3]; y2[2] = b0[2] * t1[0] + a0[2] * t1[1]; y2[3] = b0[3] * t1[2] + a0[3] * t1[3];
                    y2[4] = b1[0] * t2[0] + a1[0] * t2[1]; y2[5] = b1[1] * t2[2] + a1[1] * t2[3]; y2[6] = b1[2] * t3[0] + a1[2] * t3[1]; y2[7] = b1[3] * t3[2] + a1[3] * t3[3];
                    const float fi = (float)(row & 127);
                    const float sc = isrq ? __builtin_amdgcn_exp2f(fi * l2g) : isrk ? sc0 * __builtin_amdgcn_exp2f(-fi * l2g) : sc0;
                    u32x4 w1, w2;
                    w1.x = cvt_pk_bf16(y1[0] * sc, y1[1] * sc); w1.y = cvt_pk_bf16(y1[2] * sc, y1[3] * sc); w1.z = cvt_pk_bf16(y1[4] * sc, y1[5] * sc); w1.w = cvt_pk_bf16(y1[6] * sc, y1[7] * sc);
                    w2.x = cvt_pk_bf16(y2[0] * sc, y2[1] * sc); w2.y = cvt_pk_bf16(y2[2] * sc, y2[3] * sc); w2.z = cvt_pk_bf16(y2[4] * sc, y2[5] * sc); w2.w = cvt_pk_bf16(y2[6] * sc, y2[7] * sc);
                    bf16_t* o = dst + (size_t)row * 1024 + head * 128 + j0;
                    *(u32x4*)o = w1; *(u32x4*)(o + 64) = w2;
                    if (isrk) {
                        const float kt = sc0 * __builtin_amdgcn_exp2f((127.0f - fi) * l2g);
#pragma unroll
                        for (int e = 0; e < 8; ++e) { yk1[m & 1][e] = y1[e] * kt; yk2[m & 1][e] = y2[e] * kt; }
                        if (m & 1) {
                            bf16_t* tp = (bf16_t*)(ws + WS_RKT) + ((size_t)head * 128 + 32 * (wc & 1)) * S + (row0 - fr + ai * HALF + (m - 1) * 16);
                            tr_store32(trb, yk1, tp, S, fr, fq, lane_); tr_store32(trb, yk2, tp + (size_t)64 * S, S, fr, fq, lane_);
                        }
                    }
                }
        } else if ((pn >= 12 && pn < 16) || pn == 68) {
            const bool isq = pn != 68;
            if (isq || wc == 0) {
                unsigned short* dst = (unsigned short*)(ws + (isq ? WS_IQ : WS_IK)); const float* R64 = (const float*)(ws + WS_ROPE64); const int ld = isq ? 1024 : 64, hoff = isq ? ((pn - 12) * 4 + wc) * 64 : 0, j0 = 8 * fq;
                const float sc = isq ? 0.125f : 1.0f;
#pragma unroll
                for (int ai = 0; ai < 2; ++ai)
#pragma unroll
                    for (int m = 0; m < 4; ++m) {
                        const int row = row0 + ai * HALF + m * 16;
                        const f32x4* tb = (const f32x4*)(R64 + ((size_t)row * 32 + j0) * 2);
                        const f32x4 t0 = tb[0], t1 = tb[1], t2 = tb[2], t3 = tb[3];
                        const f32x4 a0 = acc[ai][0][m][0], a1 = acc[ai][0][m][1], b0 = acc[ai][1][m][0], b1 = acc[ai][1][m][1];
                        u32x4 w1, w2;
                        w1.x = cvt_pk_f16((a0[0] * t0[0] - b0[0] * t0[1]) * sc, (a0[1] * t0[2] - b0[1] * t0[3]) * sc);
                        w1.y = cvt_pk_f16((a0[2] * t1[0] - b0[2] * t1[1]) * sc, (a0[3] * t1[2] - b0[3] * t1[3]) * sc);
                        w1.z = cvt_pk_f16((a1[0] * t2[0] - b1[0] * t2[1]) * sc, (a1[1] * t2[2] - b1[1] * t2[3]) * sc);
                        w1.w = cvt_pk_f16((a1[2] * t3[0] - b1[2] * t3[1]) * sc, (a1[3] * t3[2] - b1[3] * t3[3]) * sc);
                        w2.x = cvt_pk_f16((b0[0] * t0[0] + a0[0] * t0[1]) * sc, (b0[1] * t0[2] + a0[1] * t0[3]) * sc);
                        w2.y = cvt_pk_f16((b0[2] * t1[0] + a0[2] * t1[1]) * sc, (b0[3] * t1[2] + a0[3] * t1[3]) * sc);
                        w2.z = cvt_pk_f16((b1[0] * t2[0] + a1[0] * t2[1]) * sc, (b1[1] * t2[2] + a1[1] * t2[3]) * sc);
                        w2.w = cvt_pk_f16((b1[2] * t3[0] + a1[2] * t3[1]) * sc, (b1[3] * t3[2] + a1[3] * t3[3]) * sc);
                        unsigned short* o = dst + (size_t)row * ld + hoff + j0;
                        *(u32x4*)o = w1; *(u32x4*)(o + 32) = w2;
                    }
            } else if (wc == 1 && fq < 2) {
#pragma unroll
                for (int ai = 0; ai < 2; ++ai)
#pragma unroll
                    for (int m = 0; m < 4; ++m) {
                        const int row = row0 + ai * HALF + m * 16;
                        float* o = (float*)(ws + WS_IW) + (size_t)row * 16 + 8 * fq;
                        *(f32x4*)o = acc[ai][0][m][0] * 0.25f; *(f32x4*)(o + 4) = acc[ai][0][m][1] * 0.25f;
                    }
            }
        } else {
            size_t doff; int ld, pl, act = 0, roff = 0, tr = 0, tld = S; float sc = 1.0f;
            if (pn < 12) { doff = WS_AVT; ld = 1024; pl = pn - 8; tr = 1; }
            else if (pn < 32) { doff = WS_RVT; ld = 2048; pl = pn - 24; tr = 1; }
            else if (pn < 40) { doff = WS_RG; ld = 2048; pl = pn - 32; act = 1; }
            else if (pn < 44) { doff = WS_MQ; ld = 1024; pl = pn - 40; sc = 0.0625f * 1.4426950408889634f; }
            else if (pn < 68) { doff = WS_GATES; ld = 6144; pl = pn - 44; act = 2; }
            else if (pn < 73) { doff = WS_MEMK; ld = 1024; pl = pn - 69; roff = S; }
            else { doff = WS_MVT; ld = 1024; pl = pn - 73; roff = S; tr = 1; tld = NMEM; }
            bf16_t* dst = (bf16_t*)(ws + doff);
            const int col0 = pl * BM + wc * 32 + 8 * fq;
            if (tr) {
#pragma unroll
                for (int ai = 0; ai < 2; ++ai)
#pragma unroll
                    for (int mh = 0; mh < 2; ++mh)
#pragma unroll
                        for (int bj = 0; bj < 2; ++bj) {
                            float v[2][8];
#pragma unroll
                            for (int mm = 0; mm < 2; ++mm)
#pragma unroll
                                for (int e = 0; e < 4; ++e) { v[mm][e] = acc[ai][bj][2 * mh + mm][0][e]; v[mm][4 + e] = acc[ai][bj][2 * mh + mm][1][e]; }
                            tr_store32(trb, v, dst + (size_t)(pl * BM + bj * HALF + wc * 32) * tld + (row0 - fr - roff + ai * HALF + mh * 32), (size_t)tld, fr, fq, lane_);
                        }
                return;
            }
#pragma unroll
            for (int ai = 0; ai < 2; ++ai)
#pragma unroll
                for (int m = 0; m < 4; ++m) {
                    bf16_t* rowp = dst + (size_t)(row0 - roff + ai * HALF + m * 16) * ld + col0;
#pragma unroll
                    for (int bj = 0; bj < 2; ++bj) {
                        f32x4 v0 = acc[ai][bj][m][0], v1 = acc[ai][bj][m][1];
                        if (act == 1) { v0 = (f32x4){ep_silu(v0[0]), ep_silu(v0[1]), ep_silu(v0[2]), ep_silu(v0[3])}; v1 = (f32x4){ep_silu(v1[0]), ep_silu(v1[1]), ep_silu(v1[2]), ep_silu(v1[3])}; }
                        else if (act == 2) { v0 = (f32x4){ep_sigmoid(v0[0]), ep_sigmoid(v0[1]), ep_sigmoid(v0[2]), ep_sigmoid(v0[3])}; v1 = (f32x4){ep_sigmoid(v1[0]), ep_sigmoid(v1[1]), ep_sigmoid(v1[2]), ep_sigmoid(v1[3])}; }
                        else { v0 = v0 * sc; v1 = v1 * sc; }
                        u32x4 w; w.x = cvt_pk_bf16(v0[0], v0[1]); w.y = cvt_pk_bf16(v0[2], v0[3]); w.z = cvt_pk_bf16(v1[0], v1[1]); w.w = cvt_pk_bf16(v1[2], v1[3]);
                        *(u32x4*)(rowp + bj * HALF) = w;
                    }
                }
        }
    }
};

struct EpiGateAcc {
    static constexpr bool PERM = true, AFTER_DRAIN = false;
    float* F; bf16_t* OB; const bf16_t* G; int ldc, ldg, first, last;
    __device__ __forceinline__ void operator()(const f32x4 (&acc)[2][2][4][2], const Unit& u, int wr, int wc, int fr, int fq) const {
        const int row0 = u.pm * BM + wr * 64 + fr, col0 = u.pn * BM + wc * 32 + 8 * fq;
#pragma unroll
        for (int ai = 0; ai < 2; ++ai)
#pragma unroll
            for (int m = 0; m < 4; ++m) {
                const int row = row0 + ai * HALF + m * 16;
#pragma unroll
                for (int bj = 0; bj < 2; ++bj) {
                    const int col = col0 + bj * HALF;
                    const u32x4 gw = *(const u32x4*)(G + (size_t)row * ldg + col);
                    f32x4 g0, g1;
                    g0[0] = __uint_as_float(gw.x << 16); g0[1] = __uint_as_float(gw.x & 0xffff0000u); g0[2] = __uint_as_float(gw.y << 16); g0[3] = __uint_as_float(gw.y & 0xffff0000u);
                    g1[0] = __uint_as_float(gw.z << 16); g1[1] = __uint_as_float(gw.z & 0xffff0000u); g1[2] = __uint_as_float(gw.w << 16); g1[3] = __uint_as_float(gw.w & 0xffff0000u);
                    f32x4 v0 = acc[ai][bj][m][0] * g0, v1 = acc[ai][bj][m][1] * g1;
                    float* fp = F + (size_t)row * ldc + col;
                    if (!first) { v0 += *(const f32x4*)fp; v1 += *(const f32x4*)(fp + 4); }
                    if (last) { u32x4 w; w.x = cvt_pk_bf16(v0[0], v0[1]); w.y = cvt_pk_bf16(v0[2], v0[3]); w.z = cvt_pk_bf16(v1[0], v1[1]); w.w = cvt_pk_bf16(v1[2], v1[3]); *(u32x4*)(OB + (size_t)row * ldc + col) = w; }
                    else { *(f32x4*)fp = v0; *(f32x4*)(fp + 4) = v1; }
                }
            }
    }
};

struct EpiF32 {
    static constexpr bool PERM = true, AFTER_DRAIN = false;
    float* O; int ldc;
    __device__ __forceinline__ void operator()(const f32x4 (&acc)[2][2][4][2], const Unit& u, int wr, int wc, int fr, int fq) const {
        const int row0 = u.pm * BM + wr * 64 + fr, col0 = u.pn * BM + wc * 32 + 8 * fq;
#pragma unroll
        for (int ai = 0; ai < 2; ++ai)
#pragma unroll
            for (int m = 0; m < 4; ++m)
#pragma unroll
                for (int bj = 0; bj < 2; ++bj) { float* fp = O + (size_t)(row0 + ai * HALF + m * 16) * ldc + col0 + bj * HALF; *(f32x4*)fp = acc[ai][bj][m][0]; *(f32x4*)(fp + 4) = acc[ai][bj][m][1]; }
    }
};

struct EpiSwiGLU {
    static constexpr bool PERM = true, AFTER_DRAIN = false;
    bf16_t* O; int ldc;
    __device__ __forceinline__ void operator()(const f32x4 (&acc)[2][2][4][2], const Unit& u, int wr, int wc, int fr, int fq) const {
        const int row0 = u.pm * BM + wr * 64 + fr, col0 = u.pn * HALF + wc * 32 + 8 * fq;
#pragma unroll
        for (int ai = 0; ai < 2; ++ai)
#pragma unroll
            for (int m = 0; m < 4; ++m) {
                const f32x4 g0 = acc[ai][0][m][0], g1 = acc[ai][0][m][1], u0 = acc[ai][1][m][0], u1 = acc[ai][1][m][1];
                u32x4 w;
                w.x = cvt_pk_bf16(ep_silu(g0[0]) * u0[0], ep_silu(g0[1]) * u0[1]); w.y = cvt_pk_bf16(ep_silu(g0[2]) * u0[2], ep_silu(g0[3]) * u0[3]);
                w.z = cvt_pk_bf16(ep_silu(g1[0]) * u1[0], ep_silu(g1[1]) * u1[1]); w.w = cvt_pk_bf16(ep_silu(g1[2]) * u1[2], ep_silu(g1[3]) * u1[3]);
                *(u32x4*)(O + (size_t)(row0 + ai * HALF + m * 16) * ldc + col0) = w;
            }
    }
};

struct InProjOrder {
    StaticOrder so; int G, c;
    __device__ void init(int G_, int c_) { so.init(8192, 69 * 256, G_, c_); G = G_; c = c_; }
    __device__ bool next(int i, Unit& u) const {
        const long L = (long)i * G + c;
        if (L < so.nwg) return so.next(i, u);
        if (L < so.nwg + 8) { u.pm = 32; u.pn = 69 + (int)(L - so.nwg); return true; }
        return false;
    }
    __device__ __forceinline__ void a_ready(const Unit&) const {}
    __device__ __forceinline__ void done(const Unit&) const {}
};

template <class Epi, class Sched, bool ALIGN_EPI = false, bool SP2 = false>
__device__ __forceinline__ void gemm_phase(PG8_LAS unsigned char* lds, const Gemm g, const Sched& S, const Epi& E) {
    const int tid = threadIdx.x, wid = __builtin_amdgcn_readfirstlane(tid >> 6), lane = tid & 63, wr = wid >> 2, wc = wid & 3, fr = lane & 15, fq = lane >> 4;
    const int K = g.K, nt = K / BK;
    unsigned voffA[2], voffB[2];
#pragma unroll
    for (int i = 0; i < 2; ++i) { int R, C; stage_rc(tid * 16 + i * 8192, R, C); const int Rb = Epi::PERM ? ((R & ~31) + perm32(R & 31)) : R;
        voffA[i] = (unsigned)(R * K + C) * 2u; voffB[i] = (unsigned)(Rb * K + C) * 2u; }
    const size_t kstep = (size_t)(BK * 2);
    const size_t hstep = (size_t)HALF * K * 2;
    const size_t tstep = 2 * hstep;
    const unsigned ldsw = (unsigned)wid * 1024u;
    const int aoff = lds_byte(wr * 64 + fr, fq * 8), boff = lds_byte(wc * 32 + fr, fq * 8);
#define PG8_SA(b, h) (((b) * 2 + (h)) * HTB)
#define PG8_SB(b, h) ((4 + (b) * 2 + (h)) * HTB)
#define PG8_STAGE(bufoff, gbase, voff) do { _Pragma("unroll") for (int _i = 0; _i < 2; ++_i) \
        __builtin_amdgcn_global_load_lds((const unsigned*)((const char*)(gbase) + (voff)[_i]), (PG8_LAS unsigned*)(lds + (bufoff) + ldsw + _i * 8192), 16, 0, 0); } while (0)
#define PG8_LDA(dst, b, h) do { _Pragma("unroll") for (int m = 0; m < 4; ++m) _Pragma("unroll") for (int k = 0; k < 2; ++k) dst[m][k] = *(const PG8_LAS bf16x8*)(lds + PG8_SA(b, h) + aoff + m * 2048 + k * 1024); } while (0)
#define PG8_LDB(dst, b, h) do { _Pragma("unroll") for (int n = 0; n < 2; ++n) _Pragma("unroll") for (int k = 0; k < 2; ++k) dst[n][k] = *(const PG8_LAS bf16x8*)(lds + PG8_SB(b, h) + boff + n * 2048 + k * 1024); } while (0)
#define PG8_MMA(ai, bj, At, Bt) do { __builtin_amdgcn_s_setprio(1); _Pragma("unroll") for (int m = 0; m < 4; ++m) _Pragma("unroll") for (int n = 0; n < 2; ++n) _Pragma("unroll") for (int k = 0; k < 2; ++k) \
        acc[ai][bj][m][n] = __builtin_amdgcn_mfma_f32_16x16x32_bf16(Bt[n][k], At[m][k], acc[ai][bj][m][n], 0, 0, 0); __builtin_amdgcn_s_setprio(0); } while (0)
#define PG8_WAIT_V(n) asm volatile("s_waitcnt vmcnt(" #n ")" ::: "memory")
#define PG8_WAIT_L(n) asm volatile("s_waitcnt lgkmcnt(" #n ")" ::: "memory")
#define PG8_BAR __builtin_amdgcn_s_barrier()
#define PG8_SCHED __builtin_amdgcn_sched_barrier(0)
    Unit cur, nxt; int ui = 0;
    if (!S.next(0, cur)) return;
    f32x4 acc[2][2][4][2];
#pragma unroll
    for (int a = 0; a < 2; ++a)
#pragma unroll
        for (int b = 0; b < 2; ++b)
#pragma unroll
            for (int m = 0; m < 4; ++m)
#pragma unroll
                for (int n = 0; n < 2; ++n) acc[a][b][m][n] = (f32x4){0.f, 0.f, 0.f, 0.f};
    bf16x8 At[4][2], B0[2][2], B1[2][2];
    const char* cA = (const char*)g.A + (size_t)cur.pm * tstep; const char* cB = (const char*)g.Bt + (size_t)cur.pn * tstep;
    S.a_ready(cur);
    if constexpr (SP2) {
        PG8_STAGE(PG8_SB(0, 0), cB, voffB); PG8_STAGE(PG8_SB(0, 1), cB + hstep, voffB); PG8_STAGE(PG8_SA(0, 0), cA, voffA); PG8_STAGE(PG8_SA(0, 1), cA + hstep, voffA);
        if (wr == 1) PG8_BAR;
        PG8_WAIT_V(2); PG8_BAR;
        PG8_STAGE(PG8_SB(1, 0), cB + kstep, voffB); PG8_STAGE(PG8_SA(1, 0), cA + kstep, voffA); PG8_STAGE(PG8_SB(1, 1), cB + hstep + kstep, voffB);
        PG8_WAIT_V(6); PG8_BAR;
    } else {
        PG8_STAGE(PG8_SB(0, 0), cB, voffB); PG8_STAGE(PG8_SA(0, 0), cA, voffA); PG8_STAGE(PG8_SB(0, 1), cB + hstep, voffB); PG8_STAGE(PG8_SA(0, 1), cA + hstep, voffA);
        if (wr == 1) PG8_BAR;
        PG8_WAIT_V(4); PG8_BAR;
        PG8_STAGE(PG8_SB(1, 0), cB + kstep, voffB); PG8_STAGE(PG8_SA(1, 0), cA + kstep, voffA); PG8_STAGE(PG8_SB(1, 1), cB + hstep + kstep, voffB);
        PG8_WAIT_V(6); PG8_BAR;
    }
    for (;;) {
        const bool has_next = S.next(ui + 1, nxt);
        const char* nA = has_next ? (const char*)g.A + (size_t)nxt.pm * tstep : cA; const char* nB = has_next ? (const char*)g.Bt + (size_t)nxt.pn * tstep : cB;
        for (int t = 0; t < nt; t += 2) {
            const bool last = (t == nt - 2);
            const char* a1 = cA + (size_t)(t + 1) * kstep;
            const char* a2 = last ? nA : cA + (size_t)(t + 2) * kstep; const char* b2 = last ? nB : cB + (size_t)(t + 2) * kstep;
            const char* a3 = a2 + kstep; const char* b3 = b2 + kstep;
            if (last && has_next) S.a_ready(nxt);
            if constexpr (SP2) {
            PG8_LDB(B0, 0, 0); PG8_LDB(B1, 0, 1); PG8_SCHED; PG8_LDA(At, 0, 0); PG8_STAGE(PG8_SA(1, 1), a1 + hstep, voffA);
            PG8_WAIT_V(8); PG8_WAIT_L(0); PG8_BAR; PG8_MMA(0, 0, At, B0); PG8_MMA(0, 1, At, B1); PG8_BAR; PG8_SCHED;
            PG8_LDA(At, 0, 1); PG8_STAGE(PG8_SB(0, 0), b2, voffB); PG8_STAGE(PG8_SB(0, 1), b2 + hstep, voffB); PG8_STAGE(PG8_SA(0, 0), a2, voffA);
            PG8_WAIT_V(8); PG8_WAIT_L(0); PG8_BAR; PG8_MMA(1, 0, At, B0); PG8_MMA(1, 1, At, B1); PG8_BAR; PG8_SCHED;
            PG8_LDB(B0, 1, 0); PG8_LDB(B1, 1, 1); PG8_SCHED; PG8_LDA(At, 1, 0); PG8_STAGE(PG8_SA(0, 1), a2 + hstep, voffA);
            PG8_WAIT_V(8); PG8_WAIT_L(0); PG8_BAR; PG8_MMA(0, 0, At, B0); PG8_MMA(0, 1, At, B1); PG8_BAR; PG8_SCHED;
            PG8_LDA(At, 1, 1); PG8_STAGE(PG8_SB(1, 0), b3, voffB); PG8_STAGE(PG8_SB(1, 1), b3 + hstep, voffB); PG8_STAGE(PG8_SA(1, 0), a3, voffA);
            PG8_WAIT_V(8); PG8_WAIT_L(0); PG8_BAR; PG8_MMA(1, 0, At, B0); PG8_MMA(1, 1, At, B1); PG8_BAR; PG8_SCHED;
            } else {
            PG8_LDB(B0, 0, 0); PG8_SCHED; PG8_LDA(At, 0, 0); PG8_STAGE(PG8_SA(1, 1), a1 + hstep, voffA);
            PG8_WAIT_L(8); PG8_BAR; PG8_WAIT_L(0); PG8_MMA(0, 0, At, B0); PG8_BAR; PG8_SCHED;
            PG8_LDB(B1, 0, 1); PG8_STAGE(PG8_SB(0, 0), b2, voffB);
            PG8_BAR; PG8_WAIT_L(0); PG8_MMA(0, 1, At, B1); PG8_BAR;
            PG8_LDA(At, 0, 1); PG8_STAGE(PG8_SA(0, 0), a2, voffA);
            PG8_BAR; PG8_WAIT_L(0); PG8_MMA(1, 0, At, B0); PG8_BAR; PG8_SCHED;
            PG8_STAGE(PG8_SB(0, 1), b2 + hstep, voffB);
            PG8_WAIT_V(6); PG8_BAR; PG8_MMA(1, 1, At, B1); PG8_BAR;
            PG8_LDB(B0, 1, 0); PG8_SCHED; PG8_LDA(At, 1, 0); PG8_STAGE(PG8_SA(0, 1), a2 + hstep, voffA);
            PG8_WAIT_L(8); PG8_BAR; PG8_WAIT_L(0); PG8_MMA(0, 0, At, B0); PG8_BAR; PG8_SCHED;
            PG8_LDB(B1, 1, 1); PG8_STAGE(PG8_SB(1, 0), b3, voffB);
            PG8_BAR; PG8_WAIT_L(0); PG8_MMA(0, 1, At, B1); PG8_BAR;
            PG8_LDA(At, 1, 1); PG8_STAGE(PG8_SA(1, 0), a3, voffA);
            PG8_BAR; PG8_WAIT_L(0); PG8_MMA(1, 0, At, B0); PG8_BAR; PG8_SCHED;
            PG8_STAGE(PG8_SB(1, 1), b3 + hstep, voffB);
            PG8_WAIT_V(6); PG8_BAR; PG8_MMA(1, 1, At, B1); PG8_BAR;
            }
        }
        if constexpr (ALIGN_EPI) { if (wr == 0) PG8_BAR; }
        if constexpr (!Epi::AFTER_DRAIN) { E(acc, cur, wr, wc, fr, fq); S.done(cur); }
        if (!has_next) break;
#pragma unroll
        for (int a = 0; a < 2; ++a)
#pragma unroll
            for (int b = 0; b < 2; ++b)
#pragma unroll
                for (int m = 0; m < 4; ++m)
#pragma unroll
                    for (int n = 0; n < 2; ++n) acc[a][b][m][n] = (f32x4){0.f, 0.f, 0.f, 0.f};
        cur = nxt; cA = nA; cB = nB; ++ui;
        if constexpr (ALIGN_EPI) { if (wr == 1) PG8_BAR; }
    }
    PG8_WAIT_V(0);
    if constexpr (!ALIGN_EPI) { if (wr == 0) PG8_BAR; }
    PG8_BAR;
    if constexpr (Epi::AFTER_DRAIN) { E.fused(acc, cur, wr, wc, fr, fq, lds, wid, lane); S.done(cur); }
#undef PG8_SA
#undef PG8_SB
#undef PG8_STAGE
#undef PG8_LDA
#undef PG8_LDB
#undef PG8_MMA
#undef PG8_WAIT_V
#undef PG8_WAIT_L
#undef PG8_BAR
#undef PG8_SCHED
}
template <class Epi, class Sched, bool ALIGN_EPI = false, bool SP2 = false>
__device__ __forceinline__ void gemm_phase_chain(PG8_LAS unsigned char* lds, const Sched& S, const Epi& E) {
    const int tid = threadIdx.x, wid = __builtin_amdgcn_readfirstlane(tid >> 6), lane = tid & 63, wr = wid >> 2, wc = wid & 3, fr = lane & 15, fq = lane >> 4;
    unsigned rA, rB, cc;
    { int R, C; stage_rc(tid * 16, R, C); const int Rb = Epi::PERM ? ((R & ~31) + perm32(R & 31)) : R; rA = (unsigned)R; rB = (unsigned)Rb; cc = (unsigned)C * 2u; }
    const size_t kstep = (size_t)(BK * 2);
    const unsigned ldsw = (unsigned)wid * 1024u;
    const int aoff = lds_byte(wr * 64 + fr, fq * 8), boff = lds_byte(wc * 32 + fr, fq * 8);
#define PG8_SA(b, h) (((b) * 2 + (h)) * HTB)
#define PG8_SB(b, h) ((4 + (b) * 2 + (h)) * HTB)
#define PG8_STAGE(bufoff, gbase, rr, p2) do { _Pragma("unroll") for (int _i = 0; _i < 2; ++_i) \
        __builtin_amdgcn_global_load_lds((const unsigned*)((const char*)(gbase) + (size_t)(_i * 64) * (p2) + ((rr) * (unsigned)(p2) + cc)), (PG8_LAS unsigned*)(lds + (bufoff) + ldsw + _i * 8192), 16, 0, 0); } while (0)
#define PG8_LDA(dst, b, h) do { _Pragma("unroll") for (int m = 0; m < 4; ++m) _Pragma("unroll") for (int k = 0; k < 2; ++k) dst[m][k] = *(const PG8_LAS bf16x8*)(lds + PG8_SA(b, h) + aoff + m * 2048 + k * 1024); } while (0)
#define PG8_LDB(dst, b, h) do { _Pragma("unroll") for (int n = 0; n < 2; ++n) _Pragma("unroll") for (int k = 0; k < 2; ++k) dst[n][k] = *(const PG8_LAS bf16x8*)(lds + PG8_SB(b, h) + boff + n * 2048 + k * 1024); } while (0)
#define PG8_MMA(ai, bj, At, Bt) do { __builtin_amdgcn_s_setprio(1); _Pragma("unroll") for (int m = 0; m < 4; ++m) _Pragma("unroll") for (int n = 0; n < 2; ++n) _Pragma("unroll") for (int k = 0; k < 2; ++k) \
        acc[ai][bj][m][n] = __builtin_amdgcn_mfma_f32_16x16x32_bf16(Bt[n][k], At[m][k], acc[ai][bj][m][n], 0, 0, 0); __builtin_amdgcn_s_setprio(0); } while (0)
#define PG8_WAIT_V(n) asm volatile("s_waitcnt vmcnt(" #n ")" ::: "memory")
#define PG8_WAIT_L(n) asm volatile("s_waitcnt lgkmcnt(" #n ")" ::: "memory")
#define PG8_BAR __builtin_amdgcn_s_barrier()
#define PG8_SCHED __builtin_amdgcn_sched_barrier(0)
    Unit cur, nxt; int ui = 0;
    if (!S.next(0, cur)) return;
    f32x4 acc[2][2][4][2];
#pragma unroll
    for (int a = 0; a < 2; ++a)
#pragma unroll
        for (int b = 0; b < 2; ++b)
#pragma unroll
            for (int m = 0; m < 4; ++m)
#pragma unroll
                for (int n = 0; n < 2; ++n) acc[a][b][m][n] = (f32x4){0.f, 0.f, 0.f, 0.f};
    bf16x8 At[4][2], B0[2][2], B1[2][2];
    const char* cA; const char* cB; int cK; S.ptrs(cur, cA, cB, cK);
    int nt = cK / BK; unsigned cp2 = 2u * (unsigned)cK; size_t hstep = (size_t)HALF * cK * 2;
    S.a_ready(cur);
    if constexpr (SP2) {
        PG8_STAGE(PG8_SB(0, 0), cB, rB, cp2); PG8_STAGE(PG8_SB(0, 1), cB + hstep, rB, cp2); PG8_STAGE(PG8_SA(0, 0), cA, rA, cp2); PG8_STAGE(PG8_SA(0, 1), cA + hstep, rA, cp2);
        if (wr == 1) PG8_BAR;
        PG8_WAIT_V(2); PG8_BAR;
        PG8_STAGE(PG8_SB(1, 0), cB + kstep, rB, cp2); PG8_STAGE(PG8_SA(1, 0), cA + kstep, rA, cp2); PG8_STAGE(PG8_SB(1, 1), cB + hstep + kstep, rB, cp2);
        PG8_WAIT_V(6); PG8_BAR;
    } else {
        PG8_STAGE(PG8_SB(0, 0), cB, rB, cp2); PG8_STAGE(PG8_SA(0, 0), cA, rA, cp2); PG8_STAGE(PG8_SB(0, 1), cB + hstep, rB, cp2); PG8_STAGE(PG8_SA(0, 1), cA + hstep, rA, cp2);
        if (wr == 1) PG8_BAR;
        PG8_WAIT_V(4); PG8_BAR;
        PG8_STAGE(PG8_SB(1, 0), cB + kstep, rB, cp2); PG8_STAGE(PG8_SA(1, 0), cA + kstep, rA, cp2); PG8_STAGE(PG8_SB(1, 1), cB + hstep + kstep, rB, cp2);
        PG8_WAIT_V(6); PG8_BAR;
    }
    for (;;) {
        const bool has_next = S.next(ui + 1, nxt);
        const char* nA = cA; const char* nB = cB; int nK = cK; if (has_next) S.ptrs(nxt, nA, nB, nK);
        const unsigned np2 = 2u * (unsigned)nK; const size_t nhstep = (size_t)HALF * nK * 2;
        for (int t = 0; t < nt; t += 2) {
            const bool last = (t == nt - 2);
            const unsigned p2x = last ? np2 : cp2; const size_t hsx = last ? nhstep : hstep;
            const char* a1 = cA + (size_t)(t + 1) * kstep;
            const char* a2 = last ? nA : cA + (size_t)(t + 2) * kstep; const char* b2 = last ? nB : cB + (size_t)(t + 2) * kstep;
            const char* a3 = a2 + kstep; const char* b3 = b2 + kstep;
            if (last && has_next) S.a_ready(nxt);
            if constexpr (SP2) {
            PG8_LDB(B0, 0, 0); PG8_LDB(B1, 0, 1); PG8_SCHED; PG8_LDA(At, 0, 0); PG8_STAGE(PG8_SA(1, 1), a1 + hstep, rA, cp2);
            PG8_WAIT_V(8); PG8_WAIT_L(0); PG8_BAR; PG8_MMA(0, 0, At, B0); PG8_MMA(0, 1, At, B1); PG8_BAR; PG8_SCHED;
            PG8_LDA(At, 0, 1); PG8_STAGE(PG8_SB(0, 0), b2, rB, p2x); PG8_STAGE(PG8_SB(0, 1), b2 + hsx, rB, p2x); PG8_STAGE(PG8_SA(0, 0), a2, rA, p2x);
            PG8_WAIT_V(8); PG8_WAIT_L(0); PG8_BAR; PG8_MMA(1, 0, At, B0); PG8_MMA(1, 1, At, B1); PG8_BAR; PG8_SCHED;
            PG8_LDB(B0, 1, 0); PG8_LDB(B1, 1, 1); PG8_SCHED; PG8_LDA(At, 1, 0); PG8_STAGE(PG8_SA(0, 1), a2 + hsx, rA, p2x);
            PG8_WAIT_V(8); PG8_WAIT_L(0); PG8_BAR; PG8_MMA(0, 0, At, B0); PG8_MMA(0, 1, At, B1); PG8_BAR; PG8_SCHED;
            PG8_LDA(At, 1, 1); PG8_STAGE(PG8_SB(1, 0), b3, rB, p2x); PG8_STAGE(PG8_SB(1, 1), b3 + hsx, rB, p2x); PG8_STAGE(PG8_SA(1, 0), a3, rA, p2x);
            PG8_WAIT_V(8); PG8_WAIT_L(0); PG8_BAR; PG8_MMA(1, 0, At, B0); PG8_MMA(1, 1, At, B1); PG8_BAR; PG8_SCHED;
            } else {
            PG8_LDB(B0, 0, 0); PG8_SCHED; PG8_LDA(At, 0, 0); PG8_STAGE(PG8_SA(1, 1), a1 + hstep, rA, cp2);
            PG8_WAIT_L(8); PG8_BAR; PG8_WAIT_L(0); PG8_MMA(0, 0, At, B0); PG8_BAR; PG8_SCHED;
            PG8_LDB(B1, 0, 1); PG8_STAGE(PG8_SB(0, 0), b2, rB, p2x);
            PG8_BAR; PG8_WAIT_L(0); PG8_MMA(0, 1, At, B1); PG8_BAR;
            PG8_LDA(At, 0, 1); PG8_STAGE(PG8_SA(0, 0), a2, rA, p2x);
            PG8_BAR; PG8_WAIT_L(0); PG8_MMA(1, 0, At, B0); PG8_BAR; PG8_SCHED;
            PG8_STAGE(PG8_SB(0, 1), b2 + hsx, rB, p2x);
            PG8_WAIT_V(6); PG8_BAR; PG8_MMA(1, 1, At, B1); PG8_BAR;
            PG8_LDB(B0, 1, 0); PG8_SCHED; PG8_LDA(At, 1, 0); PG8_STAGE(PG8_SA(0, 1), a2 + hsx, rA, p2x);
            PG8_WAIT_L(8); PG8_BAR; PG8_WAIT_L(0); PG8_MMA(0, 0, At, B0); PG8_BAR; PG8_SCHED;
            PG8_LDB(B1, 1, 1); PG8_STAGE(PG8_SB(1, 0), b3, rB, p2x);
            PG8_BAR; PG8_WAIT_L(0); PG8_MMA(0, 1, At, B1); PG8_BAR;
            PG8_LDA(At, 1, 1); PG8_STAGE(PG8_SA(1, 0), a3, rA, p2x);
            PG8_BAR; PG8_WAIT_L(0); PG8_MMA(1, 0, At, B0); PG8_BAR; PG8_SCHED;
            PG8_STAGE(PG8_SB(1, 1), b3 + hsx, rB, p2x);
            PG8_WAIT_V(6); PG8_BAR; PG8_MMA(1, 1, At, B1); PG8_BAR;
            }
        }
        if constexpr (ALIGN_EPI) { if (wr == 0) PG8_BAR; }
        E(acc, cur, wr, wc, fr, fq); S.done(cur);
        if (!has_next) break;
        cur = nxt; cA = nA; cB = nB; cK = nK; nt = cK / BK; cp2 = np2; hstep = nhstep; ++ui;
        if constexpr (ALIGN_EPI) { if (wr == 1) PG8_BAR; }
    }
    PG8_WAIT_V(0);
    if constexpr (!ALIGN_EPI) { if (wr == 0) PG8_BAR; }
    PG8_BAR;
#undef PG8_SA
#undef PG8_SB
#undef PG8_STAGE
#undef PG8_LDA
#undef PG8_LDB
#undef PG8_MMA
#undef PG8_WAIT_V
#undef PG8_WAIT_L
#undef PG8_BAR
#undef PG8_SCHED
}


struct MergeOrder {
    StaticOrder so; unsigned char* ws;
    __device__ void init(unsigned char* ws_, int G_, int c_) { so.init(S, D, G_, c_); ws = ws_; }
    __device__ bool next(int i, Unit& u) const { if (i >= 3) return false; const bool ok = so.next(0, u); u.kd = i; return ok; }
    __device__ __forceinline__ void ptrs(const Unit& u, const char*& A, const char*& B, int& K) const {
        const size_t ao = u.kd == 0 ? WS_OB : u.kd == 1 ? WS_OA : WS_OC, bo = u.kd == 0 ? WS_WB : u.kd == 1 ? WS_WA : WS_WC;
        K = u.kd == 0 ? RVW : 1024;
        A = (const char*)ws + ao + (size_t)u.pm * BM * K * 2; B = (const char*)ws + bo + (size_t)u.pn * BM * K * 2;
    }
    __device__ __forceinline__ void a_ready(const Unit&) const {}
    __device__ __forceinline__ void done(const Unit&) const {}
};
struct EpiGateChain {
    static constexpr bool PERM = true, AFTER_DRAIN = false;
    unsigned char* ws;
    __device__ __forceinline__ bool keep(const Unit& u) const { return u.kd < 2; }
    __device__ __forceinline__ void operator()(f32x4 (&acc)[2][2][4][2], const Unit& u, int wr, int wc, int fr, int fq) const {
        const int row0 = u.pm * BM + wr * 64 + fr, col0 = u.pn * BM + wc * 32 + 8 * fq;
        const int gc = u.kd == 0 ? D : u.kd == 1 ? 0 : 2 * D, gn = u.kd == 0 ? 0 : 2 * D;
        const bf16_t* G = (const bf16_t*)(ws + WS_GATES); bf16_t* OB = (bf16_t*)(ws + WS_MIXEDB);
        const bool last = u.kd == 2;
#pragma unroll
        for (int ai = 0; ai < 2; ++ai) {
            u32x4 gw[4][2], hw[4][2];
#pragma unroll
            for (int m = 0; m < 4; ++m)
#pragma unroll
                for (int bj = 0; bj < 2; ++bj) {
                    const bf16_t* gp = G + (size_t)(row0 + ai * HALF + m * 16) * (3 * D) + col0 + bj * HALF;
                    gw[m][bj] = *(const u32x4*)(gp + gc);
                    hw[m][bj] = last ? gw[m][bj] : *(const u32x4*)(gp + gn);
                }
            asm volatile("" ::: "memory");
#pragma unroll
            for (int m = 0; m < 4; ++m) {
                const int row = row0 + ai * HALF + m * 16;
#pragma unroll
                for (int bj = 0; bj < 2; ++bj) {
                    const int col = col0 + bj * HALF;
                    const u32x4 g_ = gw[m][bj], h_ = hw[m][bj];
                    f32x4 g0, g1;
                    g0[0] = __uint_as_float(g_.x << 16); g0[1] = __uint_as_float(g_.x & 0xffff0000u); g0[2] = __uint_as_float(g_.y << 16); g0[3] = __uint_as_float(g_.y & 0xffff0000u);
                    g1[0] = __uint_as_float(g_.z << 16); g1[1] = __uint_as_float(g_.z & 0xffff0000u); g1[2] = __uint_as_float(g_.w << 16); g1[3] = __uint_as_float(g_.w & 0xffff0000u);
                    if (!last) {
                        f32x4 h0, h1;
                        h0[0] = __uint_as_float(h_.x << 16); h0[1] = __uint_as_float(h_.x & 0xffff0000u); h0[2] = __uint_as_float(h_.y << 16); h0[3] = __uint_as_float(h_.y & 0xffff0000u);
                        h1[0] = __uint_as_float(h_.z << 16); h1[1] = __uint_as_float(h_.z & 0xffff0000u); h1[2] = __uint_as_float(h_.w << 16); h1[3] = __uint_as_float(h_.w & 0xffff0000u);
#pragma unroll
                        for (int e = 0; e < 4; ++e) { g0[e] *= __builtin_amdgcn_rcpf(fmaxf(h0[e], 1e-30f)); g1[e] *= __builtin_amdgcn_rcpf(fmaxf(h1[e], 1e-30f)); }
                    }
                    acc[ai][bj][m][0] = acc[ai][bj][m][0] * g0; acc[ai][bj][m][1] = acc[ai][bj][m][1] * g1;
                    if (last) {
                        const f32x4 v0 = acc[ai][bj][m][0], v1 = acc[ai][bj][m][1];
                        u32x4 w; w.x = cvt_pk_bf16(v0[0], v0[1]); w.y = cvt_pk_bf16(v0[2], v0[3]); w.z = cvt_pk_bf16(v1[0], v1[1]); w.w = cvt_pk_bf16(v1[2], v1[3]);
                        *(u32x4*)(OB + (size_t)row * D + col) = w;
                    }
                }
            }
        }
    }
};
}

constexpr int RING_OFF = 0, RING_BYTES = 131072;
constexpr int TRB_OFF = RING_BYTES, TRB_WAVE = 4032;
constexpr int LDS_BYTES = 163840;
constexpr int LDSCTL_OFF = LDS_BYTES - 512, MISC_OFF = LDSCTL_OFF + 320;
static_assert(TRB_OFF + 8 * TRB_WAVE <= LDSCTL_OFF, "LDS map");
constexpr int CW_LATEQ = 64;
constexpr int CW_BAR = 4096;

typedef GAS unsigned gu32;
#define LDS_WAIT() asm volatile("s_waitcnt lgkmcnt(0)" ::: "memory")
#define XB_TMO      128
#define XB_XCNT(j)  (256  + 64 * (j))
#define XB_XSUB(j)  (1280 + 64 * (j))
#define XB_XGEN(j)  (2304 + 64 * (j))
#define XB_TOP      3328
#define XB_TOPGEN   3392
#define XCD_BAR_WORDS 3456
#define XB_SPIN_CAP (1u << 18)

__device__ __forceinline__ unsigned xb_ld(unsigned* p)              { return __hip_atomic_load(p, __ATOMIC_RELAXED, __HIP_MEMORY_SCOPE_AGENT); }
__device__ __forceinline__ unsigned xb_add(unsigned* p, unsigned v) { return __hip_atomic_fetch_add(p, v, __ATOMIC_RELAXED, __HIP_MEMORY_SCOPE_AGENT); }
__device__ __forceinline__ unsigned xb_xcc_id() { return (unsigned)__builtin_amdgcn_s_getreg((3 << 11) | 20) & 0xFu; }
#define XB_SPIN(cond, bar) do { unsigned _sp = 0; while (cond) { __builtin_amdgcn_s_sleep(1); \
    if ((++_sp & 255u) == 0u) { if (xb_ld(&(bar)[XB_TMO])) break; if (_sp > XB_SPIN_CAP) { atomicAdd(&(bar)[XB_TMO], 1u); break; } } } } while (0)

struct XcdBarrier {
    unsigned* bar; unsigned x;
    volatile LAS unsigned* st;
};

__device__ __forceinline__ XcdBarrier xcd_barrier_post(unsigned* bar, volatile LAS unsigned* st) {
    XcdBarrier b; b.bar = bar; b.x = xb_xcc_id(); b.st = st;
    if (threadIdx.x == 0) (void)xb_add(&bar[XB_XCNT(b.x)], 1u);
    return b;
}
__device__ __forceinline__ void xcd_barrier_complete(unsigned* bar, unsigned x, unsigned& nloc, unsigned& nx) {
    const unsigned G = gridDim.x * gridDim.y * gridDim.z;
    unsigned sum, cnt, mine, sp = 0u;
    for (;;) {
        sum = 0u; cnt = 0u; mine = 0u;
#pragma unroll
        for (unsigned j = 0; j < 16; ++j) { const unsigned c = xb_ld(&bar[XB_XCNT(j)]); sum += c; cnt += (c > 0u) ? 1u : 0u; mine = (j == x) ? c : mine; }
        if (sum == G) break;
        __builtin_amdgcn_s_sleep(1);
        if ((++sp & 255u) == 0u) { if (xb_ld(&bar[XB_TMO])) break; if (sp > XB_SPIN_CAP) { atomicAdd(&bar[XB_TMO], 1u); break; } }
    }
    nloc = mine > 0u ? mine : 1u; nx = cnt > 0u ? cnt : 1u;
}

__device__ __forceinline__ void xcd_barrier(const XcdBarrier& b) {
    asm volatile("s_waitcnt vmcnt(0)" ::: "memory");
    __syncthreads();
    if (threadIdx.x == 0) {
        unsigned* bar = b.bar;
        __builtin_amdgcn_s_waitcnt(0);
        unsigned nloc = b.st[0], nx = b.st[1];
        if (nloc == 0u) { xcd_barrier_complete(bar, b.x, nloc, nx); b.st[0] = nloc; b.st[1] = nx; }
        const unsigned old = xb_add(&bar[XB_XSUB(b.x)], 1u);
        const unsigned gen = old / nloc;
        if (old + 1u == (gen + 1u) * nloc) {
            __builtin_amdgcn_fence(__ATOMIC_RELEASE, "agent");
            asm volatile("s_waitcnt vmcnt(0)" ::: "memory");
            const unsigned og = xb_add(&bar[XB_TOP], 1u);
            const unsigned tg = og / nx;
            if (og + 1u == (tg + 1u) * nx) xb_add(&bar[XB_TOPGEN], 1u);
            else XB_SPIN(xb_ld(&bar[XB_TOPGEN]) == tg, bar);
            __builtin_amdgcn_fence(__ATOMIC_ACQUIRE, "agent");
            xb_add(&bar[XB_XGEN(b.x)], 1u);
            asm volatile("s_waitcnt vmcnt(0)" ::: "memory");
        } else {
            XB_SPIN(xb_ld(&bar[XB_XGEN(b.x)]) == gen, bar);
            __builtin_amdgcn_fence(__ATOMIC_ACQUIRE, "agent");
            asm volatile("s_waitcnt vmcnt(0)" ::: "memory");
        }
    }
    __syncthreads();
}

__device__ __forceinline__ int map_inproj(int np) {
    const int pn = np >> 8, p = np & 255, bj = p >> 7, q = p & 127;
    if (pn < 8 || (pn >= 16 && pn < 24)) { const int base = pn < 4 ? C_AQ : pn < 8 ? C_AK : pn < 20 ? C_RQ : C_RK; return base + ((pn & 3) * 2 + (q >> 6)) * 128 + bj * 64 + (q & 63); }
    if (pn >= 12 && pn < 16) return C_IQ + ((pn - 12) * 4 + (q >> 5)) * 64 + bj * 32 + (q & 31);
    if (pn == 68) { if (p < 32) return C_IK + p; if (p < 48) return C_IW + (p - 32); if (p >= 128 && p < 160) return C_IK + 32 + (p - 128); return -1; }
    int base, pl;
    if (pn < 12) { base = C_AV; pl = pn - 8; } else if (pn < 32) { base = C_RV; pl = pn - 24; } else if (pn < 40) { base = C_RG; pl = pn - 32; } else if (pn < 44) { base = C_MQ; pl = pn - 40; } else { base = C_GT; pl = pn - 44; }
    return base + pl * 256 + p;
}
__device__ __forceinline__ int map_ffin(int np) { return ((np >> 7) & 1) * DFF + (np >> 8) * 128 + (np & 127); }
template <int MAP> __device__ __forceinline__ void p0_transpose_item(const float* W, int K, int Nsrc, int Ndst, bf16_t* WT, LAS float* scr, int item, int lane) {
    const int nblk = Ndst / 32, kb = item / nblk, nb = item % nblk, k0 = 64 * kb, n0 = 32 * nb;
    const int np = n0 + (lane & 31);
    const int sc = MAP == 0 ? np : MAP == 1 ? map_inproj(np) : map_ffin(np);
    float tv[32];
    const float* wp = W + (size_t)(k0 + (lane >> 5)) * Nsrc + (sc >= 0 ? sc : 0);
#pragma unroll
    for (int i = 0; i < 32; ++i) tv[i] = wp[(size_t)(2 * i) * Nsrc];
#pragma unroll
    for (int i = 0; i < 32; ++i) { const int kk = 2 * i + (lane >> 5); scr[kk * 33 + (lane & 31)] = sc >= 0 ? tv[i] : 0.f; }
    LDS_WAIT(); asm volatile("" ::: "memory");
    const int c = lane & 7;
#pragma unroll
    for (int j = 0; j < 4; ++j) { const int n = (lane >> 3) + 8 * j; const LAS float* s = scr + (8 * c) * 33 + n;
        uint4 o; o.x = pk2(s[0 * 33], s[1 * 33]); o.y = pk2(s[2 * 33], s[3 * 33]); o.z = pk2(s[4 * 33], s[5 * 33]); o.w = pk2(s[6 * 33], s[7 * 33]);
        *(uint4*)(WT + (size_t)(n0 + n) * K + k0 + 8 * c) = o; }
    LDS_WAIT(); asm volatile("" ::: "memory");
}
__device__ __forceinline__ void rms_row_to_bf16(const float* src, const float* g, bf16_t* dst, int lane) {
    float v[32]; float ss = 0.f;
#pragma unroll
    for (int j = 0; j < 8; ++j) { const float4 t = *(const float4*)(src + j * 256 + lane * 4); v[4 * j] = t.x; v[4 * j + 1] = t.y; v[4 * j + 2] = t.z; v[4 * j + 3] = t.w; ss += t.x * t.x + t.y * t.y + t.z * t.z + t.w * t.w; }
    ss = wave_sum(ss);
    const float rs = rsqrtf(ss * (1.0f / D) + EPS);
#pragma unroll
    for (int j = 0; j < 8; ++j) { const float4 gg = *(const float4*)(g + j * 256 + lane * 4);
        uint2 o; o.x = pk2(v[4 * j] * rs * gg.x, v[4 * j + 1] * rs * gg.y); o.y = pk2(v[4 * j + 2] * rs * gg.z, v[4 * j + 3] * rs * gg.w);
        *(uint2*)(dst + j * 256 + lane * 4) = o; }
}

struct Ptrs {
    const float *x, *mem; const int* pos; const float *g_pre_mix, *g_mem, *w_in, *w_mem_kv, *w_a, *w_b, *w_c, *w_out, *g_post_mix, *g_pre_ffn, *w_ffn_in, *w_ffn_out, *g_post_ffn;
    float* out; unsigned char* ws;
};

__device__ __forceinline__ void p0_prologue(const Ptrs& P, LAS unsigned char* lds, int G) {
    const int tid = threadIdx.x, lane = tid & 63, wave = __builtin_amdgcn_readfirstlane(tid >> 6);
    LAS float* scr = (LAS float*)(lds + RING_OFF + wave * 16384);
    const int gw = blockIdx.x * NWAVES + wave, NGW = G * NWAVES;
    unsigned char* ws = P.ws;
    constexpr int I_IN = (D / 64) * (NP_IN / 32), I_MK = (D / 64) * (2048 / 32);
    for (int it = gw; it < I_IN + I_MK; it += NGW) {
        if (it < I_IN) p0_transpose_item<1>(P.w_in, D, INC, NP_IN, (bf16_t*)(ws + WS_WIN), scr, it, lane);
        else p0_transpose_item<0>(P.w_mem_kv, D, 2048, 2048, (bf16_t*)(ws + WS_WMEMKV), scr, it - I_IN, lane);
    }
    for (int r = gw; r < S + NMEM; r += NGW) {
        if (r < S) rms_row_to_bf16(P.x + (size_t)r * D, P.g_pre_mix, (bf16_t*)(ws + WS_XN) + (size_t)r * D, lane);
        else rms_row_to_bf16(P.mem + (size_t)(r - S) * D, P.g_mem, (bf16_t*)(ws + WS_MEMN) + (size_t)(r - S) * D, lane);
    }
    float* R128 = (float*)(ws + WS_ROPE128); float* R64 = (float*)(ws + WS_ROPE64);
    for (int i = blockIdx.x * NT + tid; i < S * 64; i += G * NT) {
        const int s = i >> 6, j = i & 63;
        const float ang = (float)P.pos[s] * (float)ROPE_FREQ[j];
        float sn, cs; sincos_d((double)ang, sn, cs);
        *(float2*)(R128 + 2 * i) = make_float2(cs, sn);
        if ((j & 1) == 0) { const int i2 = s * 32 + (j >> 1); *(float2*)(R64 + 2 * i2) = make_float2(cs, sn); }
    }
}

__device__ __forceinline__ void p0_late_weights(const Ptrs& P, LAS unsigned char* lds, unsigned* q) {
    const int tid = threadIdx.x, lane = tid & 63, wave = __builtin_amdgcn_readfirstlane(tid >> 6);
    LAS float* scr = (LAS float*)(lds + RING_OFF + wave * 16384);
    LAS unsigned* slot = (LAS unsigned*)(lds + RING_OFF + 131072 - 64);
    unsigned char* ws = P.ws;
    constexpr int I_A = (AW / 64) * (D / 32), I_B = (RVW / 64) * (D / 32), I_C = (MW / 64) * (D / 32), I_O = (D / 64) * (D / 32), I_FI = (D / 64) * (2 * DFF / 32), I_FO = (DFF / 64) * (D / 32);
    constexpr int NLATE = I_A + I_B + I_C + I_O + I_FI + I_FO, GRAB = 32;
    for (;;) {
        __syncthreads();
        if (tid == 0) slot[0] = __hip_atomic_fetch_add(q, (unsigned)GRAB, __ATOMIC_RELAXED, __HIP_MEMORY_SCOPE_AGENT);
        __syncthreads();
        const int base = (int)slot[0];
        if (base >= NLATE) break;
#pragma unroll 1
        for (int k = 0; k < GRAB / NWAVES; ++k) {
            int r = base + k * NWAVES + wave;
            if (r >= NLATE) break;
            if (r < I_A) { p0_transpose_item<0>(P.w_a, AW, D, D, (bf16_t*)(ws + WS_WA), scr, r, lane); continue; } r -= I_A;
            if (r < I_B) { p0_transpose_item<0>(P.w_b, RVW, D, D, (bf16_t*)(ws + WS_WB), scr, r, lane); continue; } r -= I_B;
            if (r < I_C) { p0_transpose_item<0>(P.w_c, MW, D, D, (bf16_t*)(ws + WS_WC), scr, r, lane); continue; } r -= I_C;
            if (r < I_O) { p0_transpose_item<0>(P.w_out, D, D, D, (bf16_t*)(ws + WS_WOUT), scr, r, lane); continue; } r -= I_O;
            if (r < I_FI) { p0_transpose_item<2>(P.w_ffn_in, D, 2 * DFF, 2 * DFF, (bf16_t*)(ws + WS_WFFIN), scr, r, lane); continue; } r -= I_FI;
            p0_transpose_item<0>(P.w_ffn_out, DFF, D, D, (bf16_t*)(ws + WS_WFFOUT), scr, r, lane);
        }
    }
}

__device__ __forceinline__ unsigned ordkey(float f) { const unsigned u = __float_as_uint(f); return (u & 0x80000000u) ? ~u : (u | 0x80000000u); }
__device__ __forceinline__ float ret_loggamma(int h) { return log1pf(-exp2f(-5.0f - (float)h)); }

__device__ __forceinline__ void naive_index(const Ptrs& P, unsigned char* lds, int t) {
    float* q = (float*)lds; float* w = q + NIH * IDXD; unsigned* keys = (unsigned*)(w + 16); int* red = (int*)(keys + S);
    const f16_t* IQ = (const f16_t*)(P.ws + WS_IQ); const f16_t* IK = (const f16_t*)(P.ws + WS_IK); const float* IW = (const float*)(P.ws + WS_IW); unsigned* MASK = (unsigned*)(P.ws + WS_MASK);
    const int tid = threadIdx.x, lane = tid & 63, wv = tid >> 6;
    __syncthreads();
    for (int i = tid; i < NIH * IDXD; i += NT) q[i] = (float)IQ[(size_t)t * (NIH * IDXD) + i];
    if (tid < NIH) w[tid] = IW[(size_t)t * NIH + tid];
    __syncthreads();
    const int n = t + 1;
    for (int k = tid; k < n; k += NT) {
        float kk[IDXD];
        const f16_t* kp = IK + (size_t)k * IDXD;
#pragma unroll
        for (int d = 0; d < IDXD; ++d) kk[d] = (float)kp[d];
        float sc = 0.f;
        for (int h = 0; h < NIH; ++h) {
            float x = 0.f;
#pragma unroll
            for (int d = 0; d < IDXD; ++d) x = fmaf(q[h * IDXD + d], kk[d], x);
            sc = fmaf(fmaxf(x, 0.f), w[h], sc);
        }
        keys[k] = ordkey(sc);
    }
    __syncthreads();
    unsigned tau = 0u;
    if (n > 256) {
        for (int b = 31; b >= 0; --b) {
            const unsigned cand = tau | (1u << b);
            int c = 0;
            for (int k = tid; k < n; k += NT) c += (keys[k] >= cand) ? 1 : 0;
#pragma unroll
            for (int o = 1; o < 64; o <<= 1) c += __shfl_xor(c, o);
            __syncthreads();
            if (lane == 0) red[wv] = c;
            __syncthreads();
            int tot = 0;
#pragma unroll
            for (int i = 0; i < NWAVES; ++i) tot += red[i];
            if (tot >= 256) tau = cand;
        }
    }
    for (int k0 = 0; k0 < S; k0 += NT) {
        const int k = k0 + tid;
        const bool sel = (k < n) && (keys[k] >= tau);
        const unsigned long long b = __ballot(sel);
        if (lane == 0) { MASK[(size_t)(k >> 5) * S + t] = (unsigned)b; MASK[(size_t)((k >> 5) + 1) * S + t] = (unsigned)(b >> 32); }
    }
}

typedef short bf16x8 __attribute__((ext_vector_type(8)));
typedef float f32x16 __attribute__((ext_vector_type(16)));
typedef float f32x4 __attribute__((ext_vector_type(4)));
typedef float f32x2_t __attribute__((ext_vector_type(2)));
typedef __bf16 bf16x2_t __attribute__((ext_vector_type(2)));
typedef unsigned u32x4 __attribute__((ext_vector_type(4)));
typedef unsigned u32x2 __attribute__((ext_vector_type(2)));
#define MFMA32(a, b, c) __builtin_amdgcn_mfma_f32_32x32x16_bf16((a), (b), (c), 0, 0, 0)
__device__ __forceinline__ int crow(int r, int hi) { return (r & 3) + 8 * (r >> 2) + 4 * hi; }
__device__ __forceinline__ bf16x8 ldg8(const bf16_t* p) { return *(const bf16x8*)p; }
__device__ __forceinline__ unsigned cvtpk(float lo, float hi) { f32x2_t v = {lo, hi}; bf16x2_t b = __builtin_convertvector(v, bf16x2_t); return __builtin_bit_cast(unsigned, b); }
__device__ __forceinline__ bf16x8 pack_step(const f32x16& x, int s) {
    u32x4 p; p.x = cvtpk(x[8 * s], x[8 * s + 1]); p.y = cvtpk(x[8 * s + 2], x[8 * s + 3]); p.z = cvtpk(x[8 * s + 4], x[8 * s + 5]); p.w = cvtpk(x[8 * s + 6], x[8 * s + 7]);
    return __builtin_bit_cast(bf16x8, p);
}
__device__ __forceinline__ f32x16 zero16() { f32x16 z; for (int i = 0; i < 16; ++i) z[i] = 0.f; return z; }

template <int RB, int NROWS> __device__ __forceinline__ void stage_rows(LAS unsigned char* dst, const unsigned char* src, size_t pitch) {
    constexpr int CPR = RB / 16, RPP = NT / CPR, NP = NROWS / RPP;
    const int tid = threadIdx.x, ch = tid % CPR, r0 = tid / CPR;
    u32x4 v[NP];
#pragma unroll
    for (int p = 0; p < NP; ++p) v[p] = *(const GAS u32x4*)(src + (size_t)(r0 + p * RPP) * pitch + ch * 16);
#pragma unroll
    for (int p = 0; p < NP; ++p) { const int row = r0 + p * RPP; *(LAS u32x4*)(dst + row * RB + ((ch ^ (row & 15)) << 4)) = v[p]; }
}
template <int RB> __device__ __forceinline__ bf16x8 lfrag(const LAS unsigned char* base, int row, int chunk) { return *(const LAS bf16x8*)(base + row * RB + ((chunk ^ (row & 15)) << 4)); }

__device__ __forceinline__ void ret_kv_mfma(const Ptrs& P, LAS unsigned char* lds, int nh) {
    const int lane = threadIdx.x & 63, w = __builtin_amdgcn_readfirstlane(threadIdx.x >> 6), n = nh >> 3, h = nh & 7, db = w & 3, eh = w >> 2;
    int r = lane & 31, hh = lane >> 5; asm volatile("" : "+v"(r), "+v"(hh));
    __syncthreads();
    stage_rows<256, 128>(lds, P.ws + WS_RKT + ((size_t)(h * 128) * S + n * 128) * 2, (size_t)S * 2);
    stage_rows<256, 256>(lds + 32768, P.ws + WS_RVT + ((size_t)(h * 256) * S + n * 128) * 2, (size_t)S * 2);
    __syncthreads();
    f32x16 acc[4];
#pragma unroll
    for (int eb = 0; eb < 4; ++eb) acc[eb] = zero16();
#pragma unroll
    for (int ks = 0; ks < 8; ++ks) {
        const bf16x8 a = lfrag<256>(lds, 32 * db + r, 2 * ks + hh);
#pragma unroll
        for (int eb = 0; eb < 4; ++eb) acc[eb] = MFMA32(a, lfrag<256>(lds + 32768, 128 * eh + 32 * eb + r, 2 * ks + hh), acc[eb]);
    }
    float* KVS = (float*)(P.ws + WS_KVS);
#pragma unroll
    for (int eb = 0; eb < 4; ++eb)
#pragma unroll
        for (int g = 0; g < 4; ++g) {
            const int e = 128 * eh + 32 * eb + r, d0 = 32 * db + 8 * g + 4 * hh;
            *(f32x4*)(KVS + ((size_t)nh * 256 + e) * 128 + d0) = (f32x4){acc[eb][4 * g], acc[eb][4 * g + 1], acc[eb][4 * g + 2], acc[eb][4 * g + 3]};
        }
}
__device__ __forceinline__ void ret_scan(const Ptrs& P, int task) {
    const float* KVS = (const float*)(P.ws + WS_KVS); bf16_t* PREV = (bf16_t*)(P.ws + WS_PREV);
    const int i = task * NT + threadIdx.x, h = i >> 15;
    const float lg = log1pf(-exp2f(-5.0f - (float)h)), cd = __expf(128.0f * lg), gm = __expf(lg);
    float st = 0.f;
#pragma unroll 8
    for (int n = 0; n < 64; ++n) { const size_t o = (size_t)n * (8 * 128 * 256) + i; PREV[o] = f2bf(st * gm); st = st * cd + KVS[o]; }
}
__device__ __forceinline__ void ret_out_mfma(const Ptrs& P, LAS unsigned char* lds, int nh) {
    const int lane = threadIdx.x & 63, w = __builtin_amdgcn_readfirstlane(threadIdx.x >> 6), n = nh >> 3, h = nh & 7, ib = w & 3, eh = w >> 2, tok0 = n * 128;
    int r = lane & 31, hh = lane >> 5; asm volatile("" : "+v"(r), "+v"(hh));
    LAS float* red = (LAS float*)(lds + 98304);
    __syncthreads();
    stage_rows<256, 128>(lds, P.ws + WS_RQ + ((size_t)tok0 * 1024 + h * 128) * 2, 2048);
    stage_rows<256, 128>(lds + 32768, P.ws + WS_RK + ((size_t)tok0 * 1024 + h * 128) * 2, 2048);
    stage_rows<256, 256>(lds + 65536, P.ws + WS_RVT + ((size_t)(h * 256) * S + tok0) * 2, (size_t)S * 2);
    __syncthreads();
    bf16x8 qf[8];
#pragma unroll
    for (int ks = 0; ks < 8; ++ks) qf[ks] = lfrag<256>(lds, 32 * ib + r, 2 * ks + hh);
    f32x16 acc[4];
#pragma unroll
    for (int eb = 0; eb < 4; ++eb) acc[eb] = zero16();
    for (int jb = 0; jb <= ib; ++jb) {
        f32x16 X = zero16();
#pragma unroll
        for (int ks = 0; ks < 8; ++ks) X = MFMA32(lfrag<256>(lds + 32768, 32 * jb + r, 2 * ks + hh), qf[ks], X);
        if (jb == ib) {
#pragma unroll
            for (int reg = 0; reg < 16; ++reg) if (crow(reg, hh) > r) X[reg] = 0.f;
        }
#pragma unroll
        for (int s = 0; s < 2; ++s) {
            const bf16x8 xs = pack_step(X, s);
#pragma unroll
            for (int eb = 0; eb < 4; ++eb) acc[eb] = MFMA32(lfrag<256>(lds + 65536, 128 * eh + 32 * eb + r, 4 * jb + 2 * s + hh), xs, acc[eb]);
        }
    }
    __syncthreads();
    stage_rows<256, 256>(lds + 32768, P.ws + WS_PREV + ((size_t)nh * 256 * 128) * 2, 256);
    __syncthreads();
#pragma unroll
    for (int ks = 0; ks < 8; ++ks)
#pragma unroll
        for (int eb = 0; eb < 4; ++eb) acc[eb] = MFMA32(lfrag<256>(lds + 32768, 128 * eh + 32 * eb + r, 2 * ks + hh), qf[ks], acc[eb]);
    float s1 = 0.f, s2 = 0.f;
#pragma unroll
    for (int eb = 0; eb < 4; ++eb)
#pragma unroll
        for (int reg = 0; reg < 16; ++reg) { const float v = acc[eb][reg]; s1 += v; s2 = fmaf(v, v, s2); }
    s1 += __shfl_xor(s1, 32); s2 += __shfl_xor(s2, 32);
    if (hh == 0) { red[(w * 32 + r) * 2] = s1; red[(w * 32 + r) * 2 + 1] = s2; }
    __syncthreads();
    { s1 += red[((w ^ 4) * 32 + r) * 2]; s2 += red[((w ^ 4) * 32 + r) * 2 + 1]; }
    const float mu = s1 * (1.0f / 256.0f), var = fmaxf(s2 * (1.0f / 256.0f) - mu * mu, 0.f), rs = rsqrtf(var + EPS);
    bf16_t* OB = (bf16_t*)(P.ws + WS_OB) + (size_t)(tok0 + 32 * ib + r) * 2048 + h * 256 + 128 * eh + 4 * hh;
#pragma unroll
    for (int eb = 0; eb < 4; ++eb)
#pragma unroll
        for (int g = 0; g < 4; ++g) {
            bf16_t* p = OB + 32 * eb + 8 * g;
            const u32x2 gw = *(const u32x2*)p;
            const float g0 = __uint_as_float(gw.x << 16), g1 = __uint_as_float(gw.x & 0xffff0000u), g2 = __uint_as_float(gw.y << 16), g3 = __uint_as_float(gw.y & 0xffff0000u);
            u32x2 o; o.x = cvtpk(g0 * (acc[eb][4 * g] - mu) * rs, g1 * (acc[eb][4 * g + 1] - mu) * rs); o.y = cvtpk(g2 * (acc[eb][4 * g + 2] - mu) * rs, g3 * (acc[eb][4 * g + 3] - mu) * rs);
            *(u32x2*)p = o;
        }
}
__device__ __forceinline__ void memattn_mfma(const Ptrs& P, LAS unsigned char* lds, int task) {
    const int lane = threadIdx.x & 63, w = __builtin_amdgcn_readfirstlane(threadIdx.x >> 6), h = task & 3, t0 = (task >> 2) * 256 + 32 * w;
    int r = lane & 31, hh = lane >> 5; asm volatile("" : "+v"(r), "+v"(hh));
    const bf16_t* MQ = (const bf16_t*)(P.ws + WS_MQ) + (size_t)(t0 + r) * 1024 + h * 256 + 8 * hh;
    __syncthreads();
    stage_rows<512, 256>(lds, P.ws + WS_MEMK + (size_t)(h * 256) * 2, 2048);
    __syncthreads();
    f32x16 X[8];
#pragma unroll
    for (int kb = 0; kb < 8; ++kb) X[kb] = zero16();
#pragma unroll 1
    for (int ks = 0; ks < 16; ++ks) {
        const bf16x8 qf = ldg8(MQ + 16 * ks);
#pragma unroll
        for (int kb = 0; kb < 8; ++kb) X[kb] = MFMA32(lfrag<512>(lds, 32 * kb + r, 2 * ks + hh), qf, X[kb]);
    }
    float mx = -INFINITY;
#pragma unroll
    for (int kb = 0; kb < 8; ++kb)
#pragma unroll
        for (int reg = 0; reg < 16; ++reg) mx = fmaxf(mx, X[kb][reg]);
    mx = fmaxf(mx, __shfl_xor(mx, 32));
    float l = 0.f;
    bf16x8 pf[16];
#pragma unroll
    for (int kb = 0; kb < 8; ++kb) {
#pragma unroll
        for (int reg = 0; reg < 16; ++reg) { const float p = __builtin_amdgcn_exp2f(X[kb][reg] - mx); X[kb][reg] = p; l += p; }
        pf[2 * kb] = pack_step(X[kb], 0); pf[2 * kb + 1] = pack_step(X[kb], 1);
    }
    l += __shfl_xor(l, 32);
    const float inv = 1.0f / l;
    __syncthreads();
    stage_rows<512, 256>(lds, P.ws + WS_MVT + (size_t)(h * 256) * 256 * 2, 512);
    __syncthreads();
    bf16_t* OC = (bf16_t*)(P.ws + WS_OC) + (size_t)(t0 + r) * 1024 + h * 256 + 4 * hh;
#pragma unroll
    for (int dh = 0; dh < 2; ++dh) {
        f32x16 O[4];
#pragma unroll
        for (int db = 0; db < 4; ++db) O[db] = zero16();
#pragma unroll
        for (int kk = 0; kk < 16; ++kk)
#pragma unroll
            for (int db = 0; db < 4; ++db) O[db] = MFMA32(lfrag<512>(lds, 128 * dh + 32 * db + r, 2 * kk + hh), pf[kk], O[db]);
#pragma unroll
        for (int db = 0; db < 4; ++db)
#pragma unroll
            for (int g = 0; g < 4; ++g) {
                u32x2 o; o.x = cvtpk(O[db][4 * g] * inv, O[db][4 * g + 1] * inv); o.y = cvtpk(O[db][4 * g + 2] * inv, O[db][4 * g + 3] * inv);
                *(u32x2*)(OC + 128 * dh + 32 * db + 8 * g) = o;
            }
    }
}
__device__ __forceinline__ float max3f(float a, float b, float c) { float r; asm("v_max3_f32 %0, %1, %2, %3" : "=v"(r) : "v"(a), "v"(b), "v"(c)); return r; }
__device__ __forceinline__ float mask_sel(unsigned w, int c, float x) { const int m = __builtin_amdgcn_sbfe((int)w, c, 1); return __uint_as_float((__float_as_uint(x) & (unsigned)m) | (0xff800000u & ~(unsigned)m)); }
__device__ __forceinline__ void attn_mfma(const Ptrs& P, LAS unsigned char* lds, int h, int qb) {
    const int tid = threadIdx.x, lane = tid & 63, w = __builtin_amdgcn_readfirstlane(tid >> 6), g = w >> 2, qs = w & 3;
    int r = lane & 31, hh = lane >> 5; asm volatile("" : "+v"(r), "+v"(hh));
    const int q0 = 128 * qb + 32 * qs, nst = qb + 1;
    const bf16_t* AK = (const bf16_t*)(P.ws + WS_AK) + h * 128; const bf16_t* AVT = (const bf16_t*)(P.ws + WS_AVT) + (size_t)h * 128 * S;
    const unsigned* MASKT = (const unsigned*)(P.ws + WS_MASK) + q0 + r;
    const int skey = tid >> 4, sch = tid & 15, sd = tid >> 3, svc = tid & 7;
    bf16x8 qf[8];
    { const bf16_t* AQ = (const bf16_t*)(P.ws + WS_AQ) + (size_t)(q0 + r) * 1024 + h * 128 + 8 * hh;
#pragma unroll
      for (int ks = 0; ks < 8; ++ks) qf[ks] = ldg8(AQ + 16 * ks); }
    f32x16 O[4];
#pragma unroll
    for (int db = 0; db < 4; ++db) O[db] = zero16();
    float m_run = -1e30f, l_run = 0.f;
    u32x4 sk[4], sv[4];
#define ATT_ISSUE(st) do { _Pragma("unroll") for (int i = 0; i < 4; ++i) { \
        sk[i] = *(const u32x4*)(AK + (size_t)(128 * (st) + 64 * (i >> 1) + skey + 32 * (i & 1)) * 1024 + sch * 8); \
        sv[i] = *(const u32x4*)(AVT + (size_t)(sd + 64 * (i & 1)) * S + 128 * (st) + 64 * (i >> 1) + svc * 8); } } while (0)
#define ATT_WRITE(buf) do { _Pragma("unroll") for (int i = 0; i < 4; ++i) { const int key = skey + 32 * (i & 1), d = sd + 64 * (i & 1); \
        *(LAS u32x4*)(lds + (buf) * 65536 + (i >> 1) * 32768 + key * 256 + ((sch ^ (key & 15)) << 4)) = sk[i]; \
        *(LAS u32x4*)(lds + (buf) * 65536 + (i >> 1) * 32768 + 16384 + d * 128 + ((svc ^ ((d >> 1) & 7)) << 4)) = sv[i]; } } while (0)
    __syncthreads();
    unsigned w0n = MASKT[(size_t)(2 * g) * S], w1n = MASKT[(size_t)(2 * g + 1) * S];
    ATT_ISSUE(0); ATT_WRITE(0);
    __syncthreads();
    for (int st = 0; st < nst; ++st) {
        const bool more = st + 1 < nst;
        unsigned w0 = w0n, w1 = w1n;
        if (more) {
            w0n = MASKT[(size_t)(4 * (st + 1) + 2 * g) * S]; w1n = MASKT[(size_t)(4 * (st + 1) + 2 * g + 1) * S];
            ATT_ISSUE(st + 1);
        }
        const LAS unsigned char* Kb = lds + (st & 1) * 65536 + g * 32768; const LAS unsigned char* Vb = Kb + 16384;
        f32x16 X0, X1;
        {
            bf16x8 kf[16];
#pragma unroll
            for (int ks = 0; ks < 8; ++ks) {
                kf[2 * ks] = *(const LAS bf16x8*)(Kb + r * 256 + (((2 * ks + hh) ^ (r & 15)) << 4));
                kf[2 * ks + 1] = *(const LAS bf16x8*)(Kb + (32 + r) * 256 + (((2 * ks + hh) ^ (r & 15)) << 4));
            }
            const f32x16 z = {0.f, 0.f, 0.f, 0.f, 0.f, 0.f, 0.f, 0.f, 0.f, 0.f, 0.f, 0.f, 0.f, 0.f, 0.f, 0.f};
            X0 = MFMA32(kf[0], qf[0], z); X1 = MFMA32(kf[1], qf[0], z);
#pragma unroll
            for (int ks = 1; ks < 8; ++ks) { X0 = MFMA32(kf[2 * ks], qf[ks], X0); X1 = MFMA32(kf[2 * ks + 1], qf[ks], X1); }
        }
        w0 >>= 4 * hh; w1 >>= 4 * hh;
#pragma unroll
        for (int reg = 0; reg < 16; ++reg) { const int c = (reg & 3) + 8 * (reg >> 2); X0[reg] = mask_sel(w0, c, X0[reg]); X1[reg] = mask_sel(w1, c, X1[reg]); }
        float tmax = max3f(X0[0], X0[1], X1[0]);
        tmax = max3f(tmax, X1[1], X0[2]); tmax = max3f(tmax, X0[3], X1[2]); tmax = max3f(tmax, X1[3], X0[4]);
#pragma unroll
        for (int reg = 4; reg < 16; reg += 2) { tmax = max3f(tmax, X0[reg], X0[reg + 1]); tmax = max3f(tmax, X1[reg], X1[reg + 1]); }
        tmax = max3f(tmax, X0[5], X1[4]);
        tmax = fmaxf(tmax, __shfl_xor(tmax, 32));
        if (__any(tmax > m_run + 8.0f)) {
            const float m_new = fmaxf(m_run, tmax), alpha = __builtin_amdgcn_exp2f(m_run - m_new);
            m_run = m_new; l_run *= alpha;
#pragma unroll
            for (int db = 0; db < 4; ++db) O[db] = O[db] * alpha;
        }
        float ps = 0.f;
#pragma unroll
        for (int reg = 0; reg < 16; ++reg) { X0[reg] = __builtin_amdgcn_exp2f(X0[reg] - m_run); X1[reg] = __builtin_amdgcn_exp2f(X1[reg] - m_run); ps += X0[reg] + X1[reg]; }
        l_run += ps;
        bf16x8 pf[4]; pf[0] = pack_step(X0, 0); pf[1] = pack_step(X0, 1); pf[2] = pack_step(X1, 0); pf[3] = pack_step(X1, 1);
#pragma unroll
        for (int s = 0; s < 4; ++s)
#pragma unroll
            for (int db = 0; db < 4; ++db) {
                const bf16x8 vf = *(const LAS bf16x8*)(Vb + (32 * db + r) * 128 + (((2 * s + hh) ^ ((r >> 1) & 7)) << 4));
                O[db] = MFMA32(vf, pf[s], O[db]);
            }
        if (more) ATT_WRITE((st + 1) & 1);
        __syncthreads();
    }
#undef ATT_ISSUE
#undef ATT_WRITE
    l_run += __shfl_xor(l_run, 32);
    LAS float* cb = (LAS float*)(lds + qs * 16896);
    if (g == 1) {
#pragma unroll
        for (int db = 0; db < 4; ++db)
#pragma unroll
            for (int reg = 0; reg < 16; ++reg) cb[(db * 16 + reg) * 64 + lane] = O[db][reg];
        cb[4096 + lane] = m_run; cb[4160 + lane] = l_run;
    }
    __syncthreads();
    if (g == 0) {
        const float m1 = cb[4096 + lane], l1 = cb[4160 + lane], mt = fmaxf(m_run, m1), a0 = __builtin_amdgcn_exp2f(m_run - mt), a1 = __builtin_amdgcn_exp2f(m1 - mt);
        const float inv = 1.0f / (l_run * a0 + l1 * a1), f0 = a0 * inv, f1 = a1 * inv;
        bf16_t* OA = (bf16_t*)(P.ws + WS_OA) + (size_t)(q0 + r) * 1024 + h * 128 + 4 * hh;
#pragma unroll
        for (int db = 0; db < 4; ++db)
#pragma unroll
            for (int gq = 0; gq < 4; ++gq) {
                float v[4];
#pragma unroll
                for (int e = 0; e < 4; ++e) v[e] = O[db][4 * gq + e] * f0 + cb[(db * 16 + 4 * gq + e) * 64 + lane] * f1;
                u32x2 o; o.x = cvtpk(v[0], v[1]); o.y = cvtpk(v[2], v[3]);
                *(u32x2*)(OA + 32 * db + 8 * gq) = o;
            }
    }
}
typedef _Float16 f16x8 __attribute__((ext_vector_type(8)));
__device__ __forceinline__ float key2f(unsigned k) { return __uint_as_float((k & 0x80000000u) ? (k & 0x7fffffffu) : ~k); }
__device__ __forceinline__ float relu_i(float x) { const int i = __float_as_int(x); return __int_as_float(i > 0 ? i : 0); }
__device__ __forceinline__ void index_mfma(const Ptrs& P, LAS unsigned char* lds, int tile) {
    const int tid = threadIdx.x, lane = tid & 63, w = __builtin_amdgcn_readfirstlane(tid >> 6), qp = w & 3, kh = w >> 2, t0 = 8 * tile;
    int r = lane & 31, hh = lane >> 5; asm volatile("" : "+v"(r), "+v"(hh));
    const int nkb = ((t0 + 7) >> 5) + 1, nst = (nkb + 7) >> 3, njb = 4 * nst, kbw = 4 * ((t0 >> 7) + 1), tq = t0 + 2 * qp + hh;
    LAS int* cnt = (LAS int*)lds;
    LAS unsigned char* ring = lds + 1024;
    const f16_t* IQ = (const f16_t*)(P.ws + WS_IQ) + (size_t)(t0 + 2 * qp + (r >> 4)) * 1024 + (r & 15) * 64 + 8 * hh;
    f16x8 af[4];
#pragma unroll
    for (int s = 0; s < 4; ++s) af[s] = *(const f16x8*)(IQ + 16 * s);
    float wq0[8], wq1[8];
    { const float* IW = (const float*)(P.ws + WS_IW) + (size_t)(t0 + 2 * qp) * 16 + 4 * hh;
#pragma unroll
      for (int reg = 0; reg < 8; ++reg) { const int hd = (reg & 3) + 8 * (reg >> 2); wq0[reg] = IW[hd]; wq1[reg] = IW[16 + hd]; } }
    typedef unsigned u32x32 __attribute__((ext_vector_type(32)));
    u32x32 sc[4];
#pragma unroll
    for (int g = 0; g < 4; ++g)
#pragma unroll
        for (int e = 0; e < 32; ++e) sc[g][e] = 0u;
    unsigned mxk = 0u, mnk = 0xffffffffu; int nzw = 0;
    const f16_t* IK = (const f16_t*)(P.ws + WS_IK) + (size_t)(tid >> 3) * 64 + (tid & 7) * 8;
    const int srow = tid >> 3, sch = tid & 7;
    u32x4 sk[4];
    const f16_t* ikp = IK;
#define IDX_ISSUE() do { asm volatile("" : "+v"(ikp)); _Pragma("unroll") for (int i = 0; i < 4; ++i) sk[i] = *(const GAS u32x4*)(ikp + (size_t)(64 * i) * 64); ikp += 256 * 64; } while (0)
#define IDX_WRITE(buf) do { _Pragma("unroll") for (int i = 0; i < 4; ++i) { const int row = srow + 64 * i; *(LAS u32x4*)(ring + (buf) * 32768 + row * 128 + ((sch ^ ((row >> 1) & 7)) << 4)) = sk[i]; } } while (0)
#ifndef PROBE_SCORE_REPS
#define PROBE_SCORE_REPS 1
#endif
#pragma unroll 1
    for (int rep = 0; rep < PROBE_SCORE_REPS; ++rep) {
    ikp = IK;
    __syncthreads();
    IDX_ISSUE(); IDX_WRITE(0);
    __syncthreads();
#pragma unroll
    for (int g = 0; g < 4; ++g) {
#pragma unroll 1
        for (int s8 = 0; s8 < 8; ++s8) {
            const int st = 8 * g + s8;
            if (st >= nst) break;
            if (st + 1 < nst) IDX_ISSUE();
            const LAS unsigned char* kbuf = ring + (s8 & 1) * 32768;
#pragma unroll
            for (int b = 0; b < 4; ++b) {
                const int kbl = 2 * b + kh, kb = 8 * st + kbl;
                const LAS unsigned char* kp = kbuf + (32 * kbl + r) * 128;
                f32x16 X = zero16();
#pragma unroll
                for (int s = 0; s < 4; ++s) X = __builtin_amdgcn_mfma_f32_32x32x16_f16(af[s], *(const LAS f16x8*)(kp + (((2 * s + hh) ^ ((r >> 1) & 7)) << 4)), X, 0, 0, 0);
                float p0 = 0.f, p1 = 0.f;
#pragma unroll
                for (int reg = 0; reg < 8; ++reg) { p0 = fmaf(relu_i(X[reg]), wq0[reg], p0); p1 = fmaf(relu_i(X[8 + reg]), wq1[reg], p1); }
                const auto rr = __builtin_amdgcn_permlane32_swap(__float_as_uint(p0), __float_as_uint(p1), false, false);
                const float score = __uint_as_float(rr[0]) + __uint_as_float(rr[1]);
                const unsigned key = (32 * kb + r <= tq) ? ordkey(score) : 0u;
                sc[g][4 * s8 + b] = key;
                mxk = key > mxk ? key : mxk; { const unsigned k2 = key ? key : 0xffffffffu; mnk = k2 < mnk ? k2 : mnk; } nzw += key ? 1 : 0;
            }
            if (st + 1 < nst) IDX_WRITE((s8 + 1) & 1);
            __syncthreads();
        }
    }
    }
#undef IDX_ISSUE
#undef IDX_WRITE
    unsigned tau = 0u;
    if (t0 + 8 > 256) {
#pragma unroll
        for (int o = 1; o < 32; o <<= 1) { const unsigned a = (unsigned)__shfl_xor((int)mxk, o), b = (unsigned)__shfl_xor((int)mnk, o); mxk = a > mxk ? a : mxk; mnk = b < mnk ? b : mnk; nzw += __shfl_xor(nzw, o); }
        LAS unsigned* xb = (LAS unsigned*)(cnt + 64);
        LAS unsigned* qinfo = (LAS unsigned*)(cnt + 128);
        LAS unsigned* taus = (LAS unsigned*)(cnt + 160);
        LAS int* wcnt = cnt + 176;
        LAS unsigned* lists = (LAS unsigned*)ring;
        __syncthreads();
        if (r == 0) { xb[(w * 2 + hh) * 2] = mxk; xb[(w * 2 + hh) * 2 + 1] = mnk; }
        __syncthreads();
        { const unsigned a = xb[((w ^ 4) * 2 + hh) * 2], b = xb[((w ^ 4) * 2 + hh) * 2 + 1]; mxk = a > mxk ? a : mxk; mnk = b < mnk ? b : mnk; }
        const int nvalid = tq + 1;
        unsigned kL = mnk, kH = mxk + 1u;
        int cLw = nzw, cHw = 0, cLt = nvalid, cHt = 0;
        const float lN = __log2f((float)nvalid);
        float lcL = lN, lcH = -1.0f;
        int done = nvalid <= 256 ? 1 : 0;
        int narrow = done, allnarrow = 0;
#pragma unroll 1
        for (int it = 0; it < 200; ++it) {
            unsigned cand;
            {
                const float fL = key2f(kL), fH = key2f(kH - 1u);
                const float zL = __builtin_sqrtf(fmaxf(lN - lcL, 0.f)), zH = __builtin_sqrtf(lN - lcH), zT = __builtin_sqrtf(fmaxf(lN - 8.0028f, 0.f));
                float t = (zT - zL) / fmaxf(zH - zL, 1e-6f);
                t = fminf(fmaxf(t, 0.03125f), 0.96875f);
                unsigned kc = ordkey(fL + t * (fH - fL));
                if ((it % 3) == 2) kc = kL + ((kH - kL) >> 1);
                const unsigned lo = kL + 1u, hi = kH - 1u;
                cand = kc < lo ? lo : (kc > hi ? hi : kc);
            }
            int c = 0;
#pragma unroll
            for (int g = 0; g < 4; ++g)
#pragma unroll
                for (int hf = 0; hf < 2; ++hf) {
                    if (32 * g + 16 * hf < njb) {
#pragma unroll
                        for (int e = 16 * hf; e < 16 * hf + 16; ++e) c += (sc[g][e] >= cand) ? 1 : 0;
                    }
                }
            c += __shfl_xor(c, 1); c += __shfl_xor(c, 2); c += __shfl_xor(c, 4); c += __shfl_xor(c, 8); c += __shfl_xor(c, 16);
            LAS int* cb = cnt + (it & 1) * 16; LAS int* fb = cnt + 32 + (it & 1) * 8;
            if (r == 0) cb[w * 2 + hh] = c;
            if (lane == 0) fb[w] = allnarrow;
            __syncthreads();
            if ((fb[0] & fb[1] & fb[2] & fb[3]) != 0) break;
            const int tot = c + cb[(w ^ 4) * 2 + hh];
            if (!narrow) {
                if (kH - kL <= 1u) { tau = kL; done = 1; }
                else if (tot == 256) { tau = cand; done = 1; }
                else if (tot > 256) { kL = cand; lcL = __log2f((float)tot); cLw = c; cLt = tot; }
                else { kH = cand; lcH = tot > 0 ? __log2f((float)tot) : -1.0f; cHw = c; cHt = tot; }
                narrow = done | ((cLt - cHt) <= 512 ? 1 : 0);
            }
            allnarrow = __all(narrow) ? 1 : 0;
        }
        if (done) { kL = 1u; kH = 1u; cLw = 0; cHw = 0; }
        if (r == 0) wcnt[w * 2 + hh] = cLw - cHw;
        if (kh == 0 && r == 0) { LAS unsigned* qi = qinfo + (2 * qp + hh) * 4; qi[0] = done ? tau : kL; qi[1] = kH; qi[2] = done ? 0u : (unsigned)(256 - cHt); qi[3] = done ? 0u : (unsigned)(cLt - cHt); }
        __syncthreads();
        {
            LAS unsigned* lst = lists + (2 * qp + hh) * 512 + (kh ? wcnt[(w ^ 4) * 2 + hh] : 0);
            int off0 = 0, off1 = 0;
#pragma unroll
            for (int g = 0; g < 4; ++g)
#pragma unroll
                for (int hf = 0; hf < 2; ++hf) {
                    if (32 * g + 16 * hf < njb) {
#pragma unroll
                        for (int e = 16 * hf; e < 16 * hf + 16; ++e) {
                            const unsigned k = sc[g][e];
                            const bool inb = k >= kL && k < kH;
                            const unsigned long long bm = __ballot(inb);
                            if (bm) {
                                const unsigned blo = (unsigned)bm, bhi = (unsigned)(bm >> 32);
                                const int pos = hh ? off1 + (int)__builtin_amdgcn_mbcnt_hi(bhi, 0u) : off0 + (int)__builtin_amdgcn_mbcnt_lo(blo, 0u);
                                if (inb) lst[pos] = k;
                                off0 += __builtin_popcount(blo); off1 += __builtin_popcount(bhi);
                            }
                        }
                    }
                }
        }
        __syncthreads();
        {
            const unsigned qL = qinfo[w * 4], qH = qinfo[w * 4 + 1], need = qinfo[w * 4 + 2], n = qinfo[w * 4 + 3];
            unsigned res = qL;
            if (need) {
                unsigned d[8];
#pragma unroll
                for (int i = 0; i < 8; ++i) { const unsigned idx = lane + 64 * i; d[i] = idx < n ? lists[w * 512 + idx] - qL + 1u : 0u; }
                unsigned delta = 0u;
                const unsigned span = qH - qL - 1u;
                for (int b = 31 - __builtin_clz(span | 1u); b >= 0; --b) {
                    const unsigned cd = delta | (1u << b);
                    int c = 0;
#pragma unroll
                    for (int i = 0; i < 8; ++i) c += __builtin_popcountll(__ballot(d[i] >= cd + 1u));
                    if (c >= (int)need) delta = cd;
                }
                res = qL + delta;
            }
            if (lane == 0) taus[w] = res;
        }
        __syncthreads();
        tau = taus[2 * qp + hh];
    }
    const unsigned thr = tau > 1u ? tau : 1u;
    LAS unsigned* mrow = (LAS unsigned*)(ring + 16384);
    __syncthreads();
#pragma unroll
    for (int g = 0; g < 4; ++g)
#pragma unroll
        for (int e = 0; e < 32; ++e) {
            const int j = 32 * g + e, kb = 8 * (j >> 2) + 2 * (j & 3) + kh;
            if (kb < kbw) {
                const unsigned long long bm = __ballot(sc[g][e] >= thr);
                if (lane == 0) { mrow[kb * 8 + 2 * qp] = (unsigned)bm; mrow[kb * 8 + 2 * qp + 1] = (unsigned)(bm >> 32); }
            }
        }
    __syncthreads();
    if (tid < 2 * kbw) {
        const int kb = tid >> 1, half = tid & 1;
        const u32x4 v = *(const LAS u32x4*)(mrow + kb * 8 + 4 * half);
        *(u32x4*)((unsigned*)(P.ws + WS_MASK) + (size_t)kb * S + t0 + 4 * half) = v;
    }
}
__device__ __forceinline__ void resnorm_row(const float* xin, const float* y, const float* g1, const float* g2, float* out, bf16_t* h2, int r, int lane) {
    float yv[32], xv[32]; float ss = 0.f;
#pragma unroll
    for (int j = 0; j < 8; ++j) { const float4 t = *(const float4*)(y + (size_t)r * D + j * 256 + lane * 4); yv[4 * j] = t.x; yv[4 * j + 1] = t.y; yv[4 * j + 2] = t.z; yv[4 * j + 3] = t.w; ss += t.x * t.x + t.y * t.y + t.z * t.z + t.w * t.w; }
    ss = wave_sum(ss);
    const float rs = rsqrtf(ss * (1.0f / D) + EPS);
    float s2 = 0.f;
#pragma unroll
    for (int j = 0; j < 8; ++j) {
        const float4 xx = *(const float4*)(xin + (size_t)r * D + j * 256 + lane * 4);
        const float4 gg = *(const float4*)(g1 + j * 256 + lane * 4);
        xv[4 * j] = xx.x + yv[4 * j] * rs * gg.x; xv[4 * j + 1] = xx.y + yv[4 * j + 1] * rs * gg.y; xv[4 * j + 2] = xx.z + yv[4 * j + 2] * rs * gg.z; xv[4 * j + 3] = xx.w + yv[4 * j + 3] * rs * gg.w;
        s2 += xv[4 * j] * xv[4 * j] + xv[4 * j + 1] * xv[4 * j + 1] + xv[4 * j + 2] * xv[4 * j + 2] + xv[4 * j + 3] * xv[4 * j + 3];
        *(float4*)(out + (size_t)r * D + j * 256 + lane * 4) = make_float4(xv[4 * j], xv[4 * j + 1], xv[4 * j + 2], xv[4 * j + 3]);
    }
    if (h2) {
        s2 = wave_sum(s2);
        const float r2 = rsqrtf(s2 * (1.0f / D) + EPS);
#pragma unroll
        for (int j = 0; j < 8; ++j) { const float4 gg = *(const float4*)(g2 + j * 256 + lane * 4);
            uint2 o; o.x = pk2(xv[4 * j] * r2 * gg.x, xv[4 * j + 1] * r2 * gg.y); o.y = pk2(xv[4 * j + 2] * r2 * gg.z, xv[4 * j + 3] * r2 * gg.w);
            *(uint2*)(h2 + (size_t)r * D + j * 256 + lane * 4) = o; }
    }
}

#ifndef PROBE_REPEAT_PHASE
#define PROBE_REPEAT_PHASE -1
#endif
#ifndef MK_PER_PHASE
#define MK_PER_PHASE 0
#endif
constexpr int N_PHASES = 11;
struct Args { Ptrs p; int ph_lo, ph_hi; };
__global__ void __launch_bounds__(NT, 2) mk_fwd(Args args) {
    extern __shared__ __attribute__((aligned(16))) unsigned char lds_raw[];
    LAS unsigned char* lds = (LAS unsigned char*)lds_raw;
    const Ptrs& P = args.p;
    const int tid = threadIdx.x, lane = tid & 63, wave = __builtin_amdgcn_readfirstlane(tid >> 6), G = gridDim.x;
    unsigned char* ws = P.ws;
    for (int u = tid; u < (LDS_BYTES - LDSCTL_OFF) / 4; u += NT) ((LAS unsigned*)(lds + LDSCTL_OFF))[u] = 0u;
    __syncthreads();
    XcdBarrier bar; bar.bar = (unsigned*)(ws + WS_CTL) + CW_BAR; bar.x = 0; bar.st = nullptr;
    if (!MK_PER_PHASE) bar = xcd_barrier_post((unsigned*)(ws + WS_CTL) + CW_BAR, (volatile LAS unsigned*)(lds + MISC_OFF) + 8);
    const int lo = args.ph_lo, hi = args.ph_hi;
#define IN(k) (lo <= (k) && (k) < hi)
#define SEAM(k) do { if (IN(k) && IN((k) + 1)) xcd_barrier(bar); } while (0)
    bf16_t* XN = (bf16_t*)(ws + WS_XN);

    if (IN(0)) { p0_prologue(P, lds, G); }
    SEAM(0);
    if (IN(1)) {
        pg8::Gemm g{XN, (const bf16_t*)(ws + WS_WIN), S + NMEM, NP_IN + 2048, D}; pg8::InProjOrder O; O.init(G, (int)blockIdx.x);
        pg8::EpiInProj E{ws, lds + TRB_OFF};
        pg8::gemm_phase<pg8::EpiInProj, pg8::InProjOrder, true, true>(lds + RING_OFF, g, O, E);
        p0_late_weights(P, lds, (unsigned*)(ws + WS_CTL) + CW_LATEQ);
    }
    SEAM(1);
    if (IN(2)) {
        for (int task = blockIdx.x; task < 512 + 128; task += G) {
            if (task < 512) ret_kv_mfma(P, lds + RING_OFF, task);
            else memattn_mfma(P, lds + RING_OFF, task - 512);
        }
        for (int i = blockIdx.x; i < 256; i += G) {
#pragma unroll 1
            for (int k = 0; k < 4; ++k) { const int tile = (k == 0) ? i : (k == 1) ? 511 - i : (k == 2) ? 512 + i : 1023 - i; index_mfma(P, lds + RING_OFF, tile); }
        }
    }
    SEAM(2);
    if (IN(3)) {
        for (int task = blockIdx.x; task < 512; task += G) ret_scan(P, task);
        for (int i = blockIdx.x; i < 256; i += G) {
#pragma unroll 1
            for (int k = 0; k < 2; ++k) { const int u = k ? 511 - i : i; attn_mfma(P, lds + RING_OFF, u & 7, 63 - (u >> 3)); }
        }
    }
    SEAM(3);
    if (IN(4)) { for (int task = blockIdx.x; task < 512; task += G) ret_out_mfma(P, lds + RING_OFF, task); }
    SEAM(4);
    if (IN(5)) {
        pg8::MergeOrder O; O.init(ws, G, (int)blockIdx.x);
        pg8::EpiGateChain E{ws};
        pg8::gemm_phase_chain<pg8::EpiGateChain, pg8::MergeOrder, false, true>(lds + RING_OFF, O, E);
    }
    SEAM(5);
    if (IN(6)) {
        pg8::Gemm g{(const bf16_t*)(ws + WS_MIXEDB), (const bf16_t*)(ws + WS_WOUT), S, D, D}; pg8::StaticOrder O; O.init(S, D, G, (int)blockIdx.x);
        pg8::EpiF32 E{(float*)(ws + WS_Y), D};
        pg8::gemm_phase<pg8::EpiF32, pg8::StaticOrder, false, true>(lds + RING_OFF, g, O, E);
    }
    SEAM(6);
    if (IN(7)) { for (int r = blockIdx.x * NWAVES + wave; r < S; r += G * NWAVES) resnorm_row(P.x, (const float*)(ws + WS_Y), P.g_post_mix, P.g_pre_ffn, P.out, XN, r, lane); }
    SEAM(7);
    if (IN(8)) {
        pg8::Gemm g{XN, (const bf16_t*)(ws + WS_WFFIN), S, 2 * DFF, D}; pg8::StaticOrder O; O.init(S, 2 * DFF, G, (int)blockIdx.x);
        pg8::EpiSwiGLU E{(bf16_t*)(ws + WS_ACT), DFF};
        pg8::gemm_phase<pg8::EpiSwiGLU, pg8::StaticOrder, true, true>(lds + RING_OFF, g, O, E);
    }
    SEAM(8);
    if (IN(9)) {
        pg8::Gemm g{(const bf16_t*)(ws + WS_ACT), (const bf16_t*)(ws + WS_WFFOUT), S, D, DFF}; pg8::StaticOrder O; O.init(S, D, G, (int)blockIdx.x);
        pg8::EpiF32 E{(float*)(ws + WS_Y), D};
        pg8::gemm_phase<pg8::EpiF32, pg8::StaticOrder, false, true>(lds + RING_OFF, g, O, E);
    }
    SEAM(9);
    if (IN(10)) { for (int r = blockIdx.x * NWAVES + wave; r < S; r += G * NWAVES) resnorm_row(P.out, (const float*)(ws + WS_Y), P.g_post_ffn, nullptr, P.out, nullptr, r, lane); }
#undef IN
#undef SEAM
}

extern "C" void kernel_launch(void* const* d_in, const int* in_sizes, int n_in, void* d_out, int out_size, void* d_ws, size_t ws_size, hipStream_t stream) {
    static int grid = 0;
    if (grid == 0) {
        if (n_in != 16 || in_sizes[0] != S * D || out_size != S * D || ws_size < WS_END) { fprintf(stderr, "kernel_launch: unexpected shapes (n_in %d, ws %zu); nothing launched\n", n_in, ws_size); grid = -1; return; }
        int dev = 0, cus = 0, per_cu = 0;
        if (hipGetDevice(&dev) != hipSuccess || hipDeviceGetAttribute(&cus, hipDeviceAttributeMultiprocessorCount, dev) != hipSuccess) { grid = -1; return; }
        if (hipFuncSetAttribute((const void*)mk_fwd, hipFuncAttributeMaxDynamicSharedMemorySize, LDS_BYTES) != hipSuccess) { fprintf(stderr, "kernel_launch: hipFuncSetAttribute failed\n"); grid = -1; return; }
        if (hipOccupancyMaxActiveBlocksPerMultiprocessor(&per_cu, (const void*)mk_fwd, NT, LDS_BYTES) != hipSuccess || per_cu < 1) { fprintf(stderr, "kernel_launch: occupancy query says %d blocks per CU; nothing launched\n", per_cu); grid = -1; return; }
        (void)hipGetLastError();
        grid = cus;
    }
    if (grid < 0) return;
    if (hipMemsetAsync((char*)d_ws + WS_CTL, 0, CTL_ZERO_BYTES, stream) != hipSuccess) return;
    Args a{};
    a.p.x = (const float*)d_in[0]; a.p.mem = (const float*)d_in[1]; a.p.pos = (const int*)d_in[2]; a.p.g_pre_mix = (const float*)d_in[3]; a.p.g_mem = (const float*)d_in[4];
    a.p.w_in = (const float*)d_in[5]; a.p.w_mem_kv = (const float*)d_in[6]; a.p.w_a = (const float*)d_in[7]; a.p.w_b = (const float*)d_in[8]; a.p.w_c = (const float*)d_in[9];
    a.p.w_out = (const float*)d_in[10]; a.p.g_post_mix = (const float*)d_in[11]; a.p.g_pre_ffn = (const float*)d_in[12]; a.p.w_ffn_in = (const float*)d_in[13]; a.p.w_ffn_out = (const float*)d_in[14];
    a.p.g_post_ffn = (const float*)d_in[15]; a.p.out = (float*)d_out; a.p.ws = (unsigned char*)d_ws;
#if MK_PER_PHASE
    for (int ph = 0; ph < N_PHASES; ++ph) { a.ph_lo = ph; a.ph_hi = ph + 1; hipLaunchKernelGGL(mk_fwd, dim3(grid), dim3(NT), LDS_BYTES, stream, a); }
#else
    if (PROBE_REPEAT_PHASE >= 0) {
        a.ph_lo = 0; a.ph_hi = PROBE_REPEAT_PHASE + 1;
        hipLaunchKernelGGL(mk_fwd, dim3(grid), dim3(NT), LDS_BYTES, stream, a);
        (void)hipMemsetAsync((char*)d_ws + WS_CTL, 0, CTL_ZERO_BYTES, stream);
        a.ph_lo = PROBE_REPEAT_PHASE; a.ph_hi = N_PHASES;
        hipLaunchKernelGGL(mk_fwd, dim3(grid), dim3(NT), LDS_BYTES, stream, a);
    } else {
        a.ph_lo = 0; a.ph_hi = N_PHASES;
        hipLaunchKernelGGL(mk_fwd, dim3(grid), dim3(NT), LDS_BYTES, stream, a);
    }
#endif
}
```
